# Optimizing an MI355X kernel written in HIP

```python
import math
import jax
import jax.numpy as jnp
from jax import lax
import numpy as np

D_MODEL = 1024
BATCH = 8
SEQ = 4096
DEPTH = 2

GRID_W = 64
CTX_LEN = 256
EPS = 1e-6
F32 = jnp.float32

DA_HEADS = 4
DA_HEAD_DIM = D_MODEL // 16
DA_V_DIM = 2 * DA_HEAD_DIM
DA_WIDTH = DA_HEADS * DA_V_DIM
ROPE_THETA = 10000.0
Q_BLOCK = 128

S5_WIDTH = D_MODEL // 4
S5_GROUP = 16
S5_GROUPS = S5_WIDTH // S5_GROUP
S5_STATE = 64
S5_DT_MIN = 0.001
S5_DT_MAX = 0.1

GDN_HEADS = 4
GDN_DK = D_MODEL // 16
GDN_DV = D_MODEL // 16
GDN_WIDTH = GDN_HEADS * GDN_DV
GDN_CONV = 5
GDN_CHUNK = 64

D_MIX = DA_WIDTH + S5_WIDTH + GDN_WIDTH

DA_QK_W = 2 * DA_HEADS * DA_HEAD_DIM
GDN_QKV_W = 2 * GDN_HEADS * GDN_DK + GDN_HEADS * GDN_DV
IN_SIZES = (DA_QK_W, DA_QK_W, DA_WIDTH, S5_WIDTH, GDN_QKV_W, GDN_WIDTH, 2 * GDN_HEADS, 2 * GDN_HEADS)
IN_WIDTH = sum(IN_SIZES)
IN_OFFSETS = tuple(int(o) for o in np.cumsum(IN_SIZES)[:-1])

N_EXPERTS = 64
TOP_K = 8
N_GROUPS = 8
TOPK_GROUPS = 4
MOE_FFN = D_MODEL // 4
ROUTED_SCALE = 2.5

kernel_name = 'hybrid_diffusion_block_da_s5_gdn_moe'


def rmsnorm(x, w):
    xf = x.astype(F32)
    y = xf * lax.rsqrt(jnp.mean(xf * xf, axis=-1, keepdims=True) + EPS)
    return (y * w.astype(F32)).astype(x.dtype)


def modulate(x, w, shift, scale):
    return rmsnorm(x, w) * (1 + scale) + shift


def l2norm(x):
    return x * lax.rsqrt(jnp.sum(x * x, axis=-1, keepdims=True) + EPS)


def axial_rope_tables(row, col, dim, dtype):
    nf = dim // 4
    inv = ROPE_THETA ** (-jnp.arange(nf, dtype=F32) / nf)
    ang_r = row.astype(F32)[:, None] * inv
    ang_c = col.astype(F32)[:, None] * inv
    shp = (row.shape[0], 1, 1, nf)
    return tuple(t.reshape(shp).astype(dtype) for t in (jnp.cos(ang_r), jnp.sin(ang_r), jnp.cos(ang_c), jnp.sin(ang_c)))


def _rotate_half(x, cos, sin):
    x1, x2 = jnp.split(x, 2, axis=-1)
    return jnp.concatenate([x1 * cos - x2 * sin, x1 * sin + x2 * cos], axis=-1)


def apply_axial_rope(x, rope):
    cr, sr, cc, sc = rope
    x_row, x_col = jnp.split(x, 2, axis=-1)
    return jnp.concatenate([_rotate_half(x_row, cr, sr), _rotate_half(x_col, cc, sc)], axis=-1)


def diff_attention(pq, pk, pv, cq, ck, cv, rope, lam_vecs, subln_w, lam_init, ctx_out):
    b, n = pq.shape[:2]
    nc = cq.shape[1]
    h, dh = DA_HEADS, DA_HEAD_DIM
    scale = dh ** -0.5
    q = apply_axial_rope(pq.reshape(b, n, h, 2, dh), rope) * scale
    k = apply_axial_rope(pk.reshape(b, n, h, 2, dh), rope)
    v = pv.reshape(b, n, h, DA_V_DIM)
    qc = cq.reshape(b, nc, h, 2, dh) * scale
    kc = ck.reshape(b, nc, h, 2, dh)
    vc = cv.reshape(b, nc, h, DA_V_DIM)
    lq1, lk1, lq2, lk2 = lam_vecs.astype(F32)
    lam = jnp.exp(jnp.sum(lq1 * lk1)) - jnp.exp(jnp.sum(lq2 * lk2)) + lam_init

    def attend(qb, kk, vv):
        s = jnp.einsum('bqhmd,bkhmd->bhmqk', qb, kk).astype(F32)
        p = jax.nn.softmax(s, axis=-1)
        w = (p[:, :, 0] - lam * p[:, :, 1]).astype(vv.dtype)
        return jnp.einsum('bhqk,bkhe->bqhe', w, vv)

    k_all = jnp.concatenate([kc, k], axis=1)
    v_all = jnp.concatenate([vc, v], axis=1)
    nb = n // Q_BLOCK
    q_blocks = jnp.moveaxis(q.reshape(b, nb, Q_BLOCK, h, 2, dh), 1, 0)
    o = lax.map(lambda qb: attend(qb, k_all, v_all), q_blocks)
    o = jnp.moveaxis(o, 0, 1).reshape(b, n, h, DA_V_DIM)
    out = (rmsnorm(o, subln_w) * (1 - lam_init)).reshape(b, n, DA_WIDTH)
    out_c = None
    if ctx_out:
        oc = attend(qc, kc, vc)
        out_c = (rmsnorm(oc, subln_w) * (1 - lam_init)).reshape(b, nc, DA_WIDTH)
    return out, out_c


def s5_discretize(lam_re, lam_im, log_step, b_re, b_im):
    lr, li = lam_re.astype(F32), lam_im.astype(F32)
    step = jnp.exp(log_step.astype(F32))[:, None]
    mag = jnp.exp(lr * step)
    ab_re, ab_im = mag * jnp.cos(li * step), mag * jnp.sin(li * step)
    den = lr * lr + li * li
    nr, ni = ab_re - 1.0, ab_im
    f_re = (nr * lr + ni * li) / den
    f_im = (ni * lr - nr * li) / den
    br, bi = b_re.astype(F32), b_im.astype(F32)
    bb_re = f_re[..., None] * br - f_im[..., None] * bi
    bb_im = f_re[..., None] * bi + f_im[..., None] * br
    return ab_re, ab_im, bb_re, bb_im


def _complex_affine_combine(e1, e2):
    a1r, a1i, b1r, b1i = e1
    a2r, a2i, b2r, b2i = e2
    return (a2r * a1r - a2i * a1i, a2r * a1i + a2i * a1r,
            a2r * b1r - a2i * b1i + b2r, a2r * b1i + a2i * b1r + b2i)


def s5_scan(u, ab_re, ab_im, bb_re, bb_im, s0, reverse):
    bu_re = jnp.einsum('gph,blgh->blgp', bb_re, u)
    bu_im = jnp.einsum('gph,blgh->blgp', bb_im, u)
    if s0 is not None:
        s_re, s_im = s0
        first = -1 if reverse else 0
        bu_re = bu_re.at[:, first].add(ab_re * s_re - ab_im * s_im)
        bu_im = bu_im.at[:, first].add(ab_re * s_im + ab_im * s_re)
    a_re = jnp.broadcast_to(ab_re, bu_re.shape)
    a_im = jnp.broadcast_to(ab_im, bu_im.shape)
    _, _, x_re, x_im = lax.associative_scan(_complex_affine_combine, (a_re, a_im, bu_re, bu_im), reverse=reverse, axis=1)
    return x_re, x_im


def s5_readout(c_re, c_im, x_re, x_im):
    return (jnp.einsum('ghp,blgp->blgh', c_re.astype(F32), x_re)
            - jnp.einsum('ghp,blgp->blgh', c_im.astype(F32), x_im))


def s5_mixer(u, uc, lam_re, lam_im, log_step, b_re, b_im, c_re, c_im, d_skip, w_glu, b_glu, ctx_out):
    b, n, _ = u.shape
    nc = uc.shape[1]
    uf = u.astype(F32).reshape(b, n, S5_GROUPS, S5_GROUP)
    ucf = uc.astype(F32).reshape(b, nc, S5_GROUPS, S5_GROUP)
    dsk = d_skip.astype(F32)
    y = uf * dsk
    yc = ucf * dsk if ctx_out else None
    for dirn in range(2):
        rev = dirn == 1
        disc = s5_discretize(lam_re[dirn], lam_im[dirn], log_step[dirn], b_re[dirn], b_im[dirn])
        xc_re, xc_im = s5_scan(ucf, *disc, None, rev)
        last = 0 if rev else -1
        x_re, x_im = s5_scan(uf, *disc, (xc_re[:, last], xc_im[:, last]), rev)
        y = y + s5_readout(c_re[dirn], c_im[dirn], x_re, x_im)
        if ctx_out:
            yc = yc + s5_readout(c_re[dirn], c_im[dirn], xc_re, xc_im)

    def glu(yy, m):
        z = jax.nn.gelu(yy.reshape(b, m, S5_WIDTH)).astype(u.dtype)
        return z * jax.nn.sigmoid(z @ w_glu + b_glu)

    return glu(y, n), (glu(yc, nc) if ctx_out else None)


def short_conv(x, w):
    ch, kw = x.shape[-1], w.shape[0]
    return lax.conv_general_dilated(x, w.reshape(kw, 1, ch).astype(x.dtype), window_strides=(1,),
                                    padding=[(kw // 2, kw // 2)], dimension_numbers=('NWC', 'WIO', 'NWC'),
                                    feature_group_count=ch)


def _to_chunks(t, n_chunks):
    b, n, h = t.shape[:3]
    t = t.reshape((b, n_chunks, n // n_chunks, h) + t.shape[3:])
    return jnp.moveaxis(jnp.swapaxes(t, 2, 3), 1, 0)


def gated_delta_chunked(q, k, v, beta, g, s0):
    b, n, h, dk = q.shape
    dv = v.shape[-1]
    c = GDN_CHUNK
    nch = n // c
    qc, kc, vc = _to_chunks(q, nch), _to_chunks(k, nch), _to_chunks(v, nch)
    bc, gc = _to_chunks(beta, nch), _to_chunks(g, nch)
    gcum = jnp.cumsum(gc, axis=-1)
    tri = jnp.tril(jnp.ones((c, c), dtype=bool))
    strict = jnp.tril(jnp.ones((c, c), dtype=bool), -1)
    diff = gcum[..., :, None] - gcum[..., None, :]
    decay = jnp.where(tri, jnp.exp(jnp.where(tri, diff, 0.0)), 0.0)
    kb = kc * bc[..., None]
    a = jnp.where(strict, jnp.einsum('nbhid,nbhjd->nbhij', kb, kc) * decay, 0.0)
    rhs = jnp.concatenate([vc * bc[..., None], kb * jnp.exp(gcum)[..., None]], axis=-1)
    sol = lax.linalg.triangular_solve(a + jnp.eye(c, dtype=F32), rhs, left_side=True, lower=True, unit_diagonal=True)
    u, w = sol[..., :dv], sol[..., dv:]
    qk = jnp.einsum('nbhid,nbhjd->nbhij', qc, kc) * decay
    q_dec = qc * jnp.exp(gcum)[..., None]
    k_dec = kc * jnp.exp(gcum[..., -1:] - gcum)[..., None]
    g_last = jnp.exp(gcum[..., -1])

    def step(s, xs):
        u_i, w_i, qk_i, qd_i, kd_i, gl_i = xs
        v_new = u_i - jnp.einsum('bhcd,bhde->bhce', w_i, s)
        o_i = jnp.einsum('bhcd,bhde->bhce', qd_i, s) + jnp.einsum('bhij,bhje->bhie', qk_i, v_new)
        s = s * gl_i[..., None, None] + jnp.einsum('bhcd,bhce->bhde', kd_i, v_new)
        return s, o_i

    s_fin, o = lax.scan(step, s0, (u, w, qk, q_dec, k_dec, g_last))
    o = jnp.swapaxes(jnp.moveaxis(o, 0, 1), 2, 3).reshape(b, n, h, dv)
    return s_fin, o


def _gdn_prepare(qkv, b_logit, a_logit, conv_w, a_log, dt_bias):
    b, n = qkv.shape[:2]
    hq = jax.nn.silu(short_conv(qkv, conv_w)).astype(F32)
    q, k, v = jnp.split(hq, (GDN_HEADS * GDN_DK, 2 * GDN_HEADS * GDN_DK), axis=-1)
    q = l2norm(q.reshape(b, n, GDN_HEADS, GDN_DK)) * GDN_DK ** -0.5
    k = l2norm(k.reshape(b, n, GDN_HEADS, GDN_DK))
    v = v.reshape(b, n, GDN_HEADS, GDN_DV)
    beta = jax.nn.sigmoid(b_logit.astype(F32).reshape(b, n, 2, GDN_HEADS))
    g = -jnp.exp(a_log.astype(F32)) * jax.nn.softplus(a_logit.astype(F32).reshape(b, n, 2, GDN_HEADS) + dt_bias.astype(F32))
    return q, k, v, beta, g


def gdn_mixer(p_qkv, p_z, p_b, p_a, c_qkv, c_z, c_b, c_a, conv_w, a_log, dt_bias, norm_w, ctx_out):
    q, k, v, beta, g = _gdn_prepare(p_qkv, p_b, p_a, conv_w, a_log, dt_bias)
    qc, kc, vc, bc, gc = _gdn_prepare(c_qkv, c_b, c_a, conv_w, a_log, dt_bias)
    s_zero = jnp.zeros((q.shape[0], GDN_HEADS, GDN_DK, GDN_DV), F32)
    outs, outs_c = [], []
    for dirn in range(2):
        fl = (lambda t: jnp.flip(t, axis=1)) if dirn == 1 else (lambda t: t)
        s_ctx, o_ctx = gated_delta_chunked(fl(qc), fl(kc), fl(vc), fl(bc[:, :, dirn]), fl(gc[:, :, dirn]), s_zero)
        _, o_lat = gated_delta_chunked(fl(q), fl(k), fl(v), fl(beta[:, :, dirn]), fl(g[:, :, dirn]), s_ctx)
        outs.append(fl(o_lat))
        outs_c.append(fl(o_ctx))

    def finish(o, z):
        b, n = o.shape[:2]
        zz = jax.nn.silu(z.astype(F32).reshape(b, n, GDN_HEADS, GDN_DV))
        return (rmsnorm(o, norm_w) * zz).reshape(b, n, GDN_WIDTH).astype(p_qkv.dtype)

    out = finish(outs[0] + outs[1], p_z)
    out_c = finish(outs_c[0] + outs_c[1], c_z) if ctx_out else None
    return out, out_c


def moe_ffn(h, w_router, router_bias, w1, w3, w2, ws1, ws3, ws2):
    t = h.shape[0]
    scores = jax.nn.sigmoid((h @ w_router).astype(F32))
    biased = scores + router_bias.astype(F32)
    grp_score = lax.top_k(biased.reshape(t, N_GROUPS, N_EXPERTS // N_GROUPS), 2)[0].sum(-1)
    _, top_groups = lax.top_k(grp_score, TOPK_GROUPS)
    gmask = jnp.any(top_groups[:, :, None] == jnp.arange(N_GROUPS)[None, None, :], axis=1)
    emask = jnp.repeat(gmask, N_EXPERTS // N_GROUPS, axis=-1)
    _, top_idx = lax.top_k(jnp.where(emask, biased, -jnp.inf), TOP_K)
    top_w = jnp.take_along_axis(scores, top_idx, axis=-1)
    top_w = top_w / jnp.sum(top_w, axis=-1, keepdims=True) * ROUTED_SCALE
    gates = jnp.zeros((t, N_EXPERTS), F32).at[jnp.arange(t)[:, None], top_idx].set(top_w)
    shared = (jax.nn.silu(h @ ws1) * (h @ ws3)) @ ws2

    def add_expert(acc, p):
        e1, e3, e2, gate = p
        hid = jax.nn.silu(h @ e1) * (h @ e3) * gate[:, None]
        return acc + hid @ e2, None

    y, _ = lax.scan(add_expert, shared, (w1, w3, w2, gates.T.astype(h.dtype)))
    return y


def setup_inputs(seed: int = 0) -> dict:
    key = jax.random.key(seed)
    keys = iter(jax.random.split(key, 48))

    def nrm(shape, std):
        return jax.random.normal(next(keys), shape, F32) * std

    def unif(shape, lo, hi):
        return jax.random.uniform(next(keys), shape, F32, lo, hi)

    d, e, f = D_MODEL, N_EXPERTS, MOE_FFN
    g, p, hg = S5_GROUPS, S5_STATE, S5_GROUP
    x = nrm((BATCH, SEQ, d), 1.0)
    c = nrm((BATCH, d), 1.0)
    ctx = nrm((BATCH, CTX_LEN, d), 1.0)
    c_ctx = nrm((d,), 1.0)
    norm1_w = 1.0 + nrm((DEPTH, d), 0.02)
    norm2_w = 1.0 + nrm((DEPTH, d), 0.02)
    w_mod = nrm((DEPTH, d, 6 * d), 0.5 * d ** -0.5)
    b_mod = nrm((DEPTH, 6 * d), 0.02)
    w_in = nrm((DEPTH, d, IN_WIDTH), d ** -0.5)
    w_out = nrm((DEPTH, D_MIX, d), D_MIX ** -0.5)
    da_lambda = nrm((DEPTH, 4, DA_HEAD_DIM), 0.1)
    da_subln_w = 1.0 + nrm((DEPTH, DA_V_DIM), 0.02)
    s5_lam_re = -0.5 + nrm((DEPTH, 2, g, p), 0.02)
    s5_lam_im = math.pi * jnp.arange(p, dtype=F32) + nrm((DEPTH, 2, g, p), 0.02)
    s5_log_step = unif((DEPTH, 2, g), math.log(S5_DT_MIN), math.log(S5_DT_MAX))
    s5_b_re = nrm((DEPTH, 2, g, p, hg), (2 * hg) ** -0.5)
    s5_b_im = nrm((DEPTH, 2, g, p, hg), (2 * hg) ** -0.5)
    s5_c_re = nrm((DEPTH, 2, g, hg, p), 0.5)
    s5_c_im = nrm((DEPTH, 2, g, hg, p), 0.5)
    s5_d = nrm((DEPTH, g, hg), 1.0)
    s5_w_glu = nrm((DEPTH, S5_WIDTH, S5_WIDTH), S5_WIDTH ** -0.5)
    s5_b_glu = nrm((DEPTH, S5_WIDTH), 0.02)
    gdn_conv_w = nrm((DEPTH, GDN_CONV, GDN_QKV_W), GDN_CONV ** -0.5)
    gdn_a_log = jnp.log(unif((DEPTH, 2, GDN_HEADS), 1.0, 16.0))
    dt = jnp.exp(unif((DEPTH, 2, GDN_HEADS), math.log(0.001), math.log(0.1)))
    gdn_dt_bias = dt + jnp.log(-jnp.expm1(-dt))
    gdn_norm_w = 1.0 + nrm((DEPTH, GDN_DV), 0.02)
    moe_w_router = nrm((DEPTH, d, e), d ** -0.5)
    moe_router_bias = nrm((DEPTH, e), 0.01)
    moe_w1 = nrm((DEPTH, e, d, f), d ** -0.5)
    moe_w3 = nrm((DEPTH, e, d, f), d ** -0.5)
    moe_w2 = nrm((DEPTH, e, f, d), f ** -0.5)
    moe_ws1 = nrm((DEPTH, d, f), d ** -0.5)
    moe_ws3 = nrm((DEPTH, d, f), d ** -0.5)
    moe_ws2 = nrm((DEPTH, f, d), f ** -0.5)
    final_norm_w = 1.0 + nrm((d,), 0.02)
    return {'x': x, 'c': c, 'ctx': ctx, 'c_ctx': c_ctx,
            'norm1_w': norm1_w, 'norm2_w': norm2_w, 'w_mod': w_mod, 'b_mod': b_mod,
            'w_in': w_in, 'w_out': w_out, 'da_lambda': da_lambda, 'da_subln_w': da_subln_w,
            's5_lam_re': s5_lam_re, 's5_lam_im': s5_lam_im, 's5_log_step': s5_log_step,
            's5_b_re': s5_b_re, 's5_b_im': s5_b_im, 's5_c_re': s5_c_re, 's5_c_im': s5_c_im,
            's5_d': s5_d, 's5_w_glu': s5_w_glu, 's5_b_glu': s5_b_glu,
            'gdn_conv_w': gdn_conv_w, 'gdn_a_log': gdn_a_log, 'gdn_dt_bias': gdn_dt_bias, 'gdn_norm_w': gdn_norm_w,
            'moe_w_router': moe_w_router, 'moe_router_bias': moe_router_bias,
            'moe_w1': moe_w1, 'moe_w3': moe_w3, 'moe_w2': moe_w2,
            'moe_ws1': moe_ws1, 'moe_ws3': moe_ws3, 'moe_ws2': moe_ws2,
            'final_norm_w': final_norm_w}


def reference(x, c, ctx, c_ctx, norm1_w, norm2_w, w_mod, b_mod, w_in, w_out, da_lambda, da_subln_w,
              s5_lam_re, s5_lam_im, s5_log_step, s5_b_re, s5_b_im, s5_c_re, s5_c_im, s5_d, s5_w_glu, s5_b_glu,
              gdn_conv_w, gdn_a_log, gdn_dt_bias, gdn_norm_w,
              moe_w_router, moe_router_bias, moe_w1, moe_w3, moe_w2, moe_ws1, moe_ws3, moe_ws2,
              final_norm_w):
    b, n, d = x.shape
    nc = ctx.shape[1]
    rows = n // GRID_W
    row = jnp.repeat(jnp.arange(rows, dtype=jnp.int32), GRID_W)
    col = jnp.tile(jnp.arange(GRID_W, dtype=jnp.int32), rows)
    rope = axial_rope_tables(row, col, DA_HEAD_DIM, x.dtype)
    c_act = jax.nn.silu(c)
    cc_act = jax.nn.silu(c_ctx)
    xc = ctx
    for i in range(DEPTH):
        ctx_out = i < DEPTH - 1
        lam_init = 0.8 - 0.6 * math.exp(-0.3 * i)
        mod = (c_act @ w_mod[i] + b_mod[i]).reshape(b, 1, 6, d)
        modc = (cc_act @ w_mod[i] + b_mod[i]).reshape(6, d)
        sh1, sc1, g1, sh2, sc2, g2 = (mod[:, :, j] for j in range(6))
        csh1, csc1, cg1, csh2, csc2, cg2 = (modc[j] for j in range(6))

        h = modulate(x, norm1_w[i], sh1, sc1)
        hc = modulate(xc, norm1_w[i], csh1, csc1)
        pq, pk, pv, pu, pqkv, pz, pb, pa = jnp.split(h @ w_in[i], IN_OFFSETS, axis=-1)
        cq, ck, cv, cu, cqkv, cz, cb, ca = jnp.split(hc @ w_in[i], IN_OFFSETS, axis=-1)
        da_o, da_oc = diff_attention(pq, pk, pv, cq, ck, cv, rope, da_lambda[i], da_subln_w[i], lam_init, ctx_out)
        s5_o, s5_oc = s5_mixer(pu, cu, s5_lam_re[i], s5_lam_im[i], s5_log_step[i], s5_b_re[i], s5_b_im[i],
                               s5_c_re[i], s5_c_im[i], s5_d[i], s5_w_glu[i], s5_b_glu[i], ctx_out)
        gdn_o, gdn_oc = gdn_mixer(pqkv, pz, pb, pa, cqkv, cz, cb, ca, gdn_conv_w[i], gdn_a_log[i],
                                  gdn_dt_bias[i], gdn_norm_w[i], ctx_out)
        x = x + g1 * (jnp.concatenate([da_o, s5_o, gdn_o], axis=-1) @ w_out[i])
        if ctx_out:
            xc = xc + cg1 * (jnp.concatenate([da_oc, s5_oc, gdn_oc], axis=-1) @ w_out[i])

        h2 = modulate(x, norm2_w[i], sh2, sc2).reshape(b * n, d)
        moe_args = (moe_w_router[i], moe_router_bias[i], moe_w1[i], moe_w3[i], moe_w2[i],
                    moe_ws1[i], moe_ws3[i], moe_ws2[i])
        if ctx_out:
            h2c = modulate(xc, norm2_w[i], csh2, csc2).reshape(b * nc, d)
            f_all = moe_ffn(jnp.concatenate([h2, h2c], axis=0), *moe_args)
            xc = xc + cg2 * f_all[b * n:].reshape(b, nc, d)
            f_lat = f_all[:b * n]
        else:
            f_lat = moe_ffn(h2, *moe_args)
        x = x + g2 * f_lat.reshape(b, n, d)
    return rmsnorm(x, final_norm_w)
```

```cpp
#include <hip/hip_runtime.h>
#include <cstdio>
#include <cstdint>

#define ABL_ZERO_S5 0
#define ABL_ZERO_GDN 0
#define ABL_ZERO_ATT 0
#define ABL_NOCTXKEYS 0
#define ABL_CTXORIG 0
#define DBG_CHECK 0
#ifndef ONE_LAUNCH
#define ONE_LAUNCH 0
#endif

#define LAS __attribute__((address_space(3)))
typedef unsigned short bf16_t;
typedef short bf16x8 __attribute__((ext_vector_type(8)));
typedef float f32x4 __attribute__((ext_vector_type(4)));
typedef float f32x2 __attribute__((ext_vector_type(2)));
typedef unsigned u32x4 __attribute__((ext_vector_type(4)));
typedef unsigned u32x2 __attribute__((ext_vector_type(2)));

constexpr int NB = 8, SEQ = 4096, DM = 1024, NCTX = 256;
constexpr int TL = NB * SEQ, TC = NB * NCTX, MT = TL + TC;
constexpr int NIN = 2832, NINP = 3072;
constexpr int NE1 = 65;
constexpr int PAIRS_PAD = 329728;
constexpr float EPS = 1e-6f;

constexpr size_t MiB = 1u << 20;
constexpr size_t WS_CTL = 0, CTL_BYTES = 1 * MiB;
constexpr size_t WS_MODS = 1 * MiB;
constexpr size_t WS_ROPE = 1 * MiB + 512 * 1024;
constexpr size_t WS_WIN = 2 * MiB;
constexpr size_t WS_WOUT = 8 * MiB;
constexpr size_t WS_W13 = 10 * MiB;
constexpr size_t WS_W2 = 75 * MiB;
constexpr size_t WS_HB = 108 * MiB;
constexpr size_t WS_XC = 176 * MiB;
constexpr size_t WS_LOG = 184 * MiB;
constexpr size_t WS_TKI = 193 * MiB;
constexpr size_t WS_TKW = 195 * MiB;
constexpr size_t WS_POS = 197 * MiB;
constexpr size_t WS_LTOK = 199 * MiB;
constexpr size_t WS_LGATE = 201 * MiB;
constexpr size_t WS_PROJ = 204 * MiB;
constexpr size_t WS_Q = WS_PROJ, WS_K = WS_Q + 34 * MiB, WS_V = WS_K + 34 * MiB, WS_U = WS_V + 34 * MiB, WS_G = WS_U + 17 * MiB,
                 WS_Z = WS_G + 51 * MiB, WS_BA = WS_Z + 17 * MiB;
constexpr size_t WS_HID = WS_PROJ;
constexpr size_t WS_MIX = 394 * MiB;
constexpr size_t WS_YS5 = WS_MIX;
constexpr size_t WS_GQ = WS_YS5 + 34 * MiB;
constexpr size_t WS_GBG = WS_GQ + 102 * MiB;
constexpr size_t WS_GO = WS_GBG + 3 * MiB;
constexpr size_t WS_PAIR = WS_MIX;
constexpr size_t WS_END = WS_GO + 34 * MiB;
static_assert(WS_BA + (size_t)MT * 16 * 4 <= WS_MIX, "proj region");
static_assert(WS_HID + (size_t)PAIRS_PAD * 512 <= WS_MIX, "hid region");
static_assert(WS_PAIR + (size_t)PAIRS_PAD * 512 <= WS_END, "pair region");
static_assert(WS_END <= 600 * MiB, "ws");

constexpr int CW_BAR = 4096;
constexpr int CW_CNT = 16384;
constexpr int CW_FILL = 16384 + 256;

constexpr int LDS_BYTES = 147456;
constexpr int LDS_MISC = 144 * 1024 - 256;

__device__ __forceinline__ float wave_sum(float v) {
#pragma unroll
    for (int o = 32; o > 0; o >>= 1) v += __shfl_xor(v, o);
    return v;
}
__device__ __forceinline__ unsigned f2bf(float f) { unsigned u = __builtin_bit_cast(unsigned, f); return (u + 0x7fffu + ((u >> 16) & 1u)) >> 16; }
__device__ __forceinline__ unsigned pk2(float lo, float hi) { return f2bf(lo) | (f2bf(hi) << 16); }
__device__ __forceinline__ float bf2f(unsigned short b) { return __builtin_bit_cast(float, ((unsigned)b) << 16); }
__device__ __forceinline__ float siluf(float x) { return x / (1.f + __expf(-x)); }
__device__ __forceinline__ float sigmf(float x) { return 1.f / (1.f + __expf(-x)); }
__device__ __forceinline__ int dimperm(int r) { return 16 * ((r >> 2) & 1) + 4 * (r >> 3) + (r & 3); }
#define LDS_WAIT() asm volatile("s_waitcnt lgkmcnt(0)" ::: "memory")

struct Params {
    const float* in[35];
    float* out;
    unsigned char* ws;
};
enum { I_X = 0, I_C, I_CTX, I_CCTX, I_N1W, I_N2W, I_WMOD, I_BMOD, I_WIN, I_WOUT, I_DALAM, I_DASUB, I_S5LRE, I_S5LIM, I_S5STEP, I_S5BRE, I_S5BIM,
       I_S5CRE, I_S5CIM, I_S5D, I_S5WGLU, I_S5BGLU, I_GCONV, I_GALOG, I_GDT, I_GNORM, I_WR, I_RB, I_W1, I_W3, I_W2, I_WS1, I_WS3, I_WS2, I_FNW };

#define XB_TMO      128
#define XB_XCNT(j)  (256  + 64 * (j))
#define XB_XSUB(j)  (1280 + 64 * (j))
#define XB_XGEN(j)  (2304 + 64 * (j))
#define XB_TOP      3328
#define XB_TOPGEN   3392
#define XCD_BAR_WORDS 3456
#define XB_SPIN_CAP (1u << 22)
__device__ __forceinline__ unsigned xb_ld(unsigned* p)              { return __hip_atomic_load(p, __ATOMIC_RELAXED, __HIP_MEMORY_SCOPE_AGENT); }
__device__ __forceinline__ unsigned xb_add(unsigned* p, unsigned v) { return __hip_atomic_fetch_add(p, v, __ATOMIC_RELAXED, __HIP_MEMORY_SCOPE_AGENT); }
__device__ __forceinline__ unsigned xb_xcc_id() { return (unsigned)__builtin_amdgcn_s_getreg((3 << 11) | 20) & 0xFu; }
#define XB_SPIN(cond, bar) do { unsigned _sp = 0; while (cond) { __builtin_amdgcn_s_sleep(1); \
    if ((++_sp & 255u) == 0u) { if (xb_ld(&(bar)[XB_TMO])) break; if (_sp > XB_SPIN_CAP) { atomicAdd(&(bar)[XB_TMO], 1u); break; } } } } while (0)
struct XcdBarrier { unsigned* bar; unsigned x; volatile LAS unsigned* st; };
__device__ __forceinline__ XcdBarrier xcd_barrier_post(unsigned* bar, volatile LAS unsigned* st) {
    XcdBarrier b; b.bar = bar; b.x = xb_xcc_id(); b.st = st;
    if (threadIdx.x == 0) (void)xb_add(&bar[XB_XCNT(b.x)], 1u);
    return b;
}
__device__ __forceinline__ void xcd_barrier_complete(unsigned* bar, unsigned x, unsigned& nloc, unsigned& nx) {
    const unsigned G = gridDim.x * gridDim.y * gridDim.z;
    unsigned sum, cnt, mine, sp = 0u;
    for (;;) {
        sum = 0u; cnt = 0u; mine = 0u;
#pragma unroll
        for (unsigned j = 0; j < 16; ++j) { const unsigned c = xb_ld(&bar[XB_XCNT(j)]); sum += c; cnt += (c > 0u) ? 1u : 0u; mine = (j == x) ? c : mine; }
        if (sum == G) break;
        __builtin_amdgcn_s_sleep(1);
        if ((++sp & 255u) == 0u) { if (xb_ld(&bar[XB_TMO])) break; if (sp > XB_SPIN_CAP) { atomicAdd(&bar[XB_TMO], 1u); break; } }
    }
    nloc = mine > 0u ? mine : 1u; nx = cnt > 0u ? cnt : 1u;
}
__device__ __forceinline__ void xcd_barrier(const XcdBarrier& b) {
    asm volatile("s_waitcnt vmcnt(0)" ::: "memory");
    __syncthreads();
    if (threadIdx.x == 0) {
        unsigned* bar = b.bar;
        __builtin_amdgcn_s_waitcnt(0);
        unsigned nloc = b.st[0], nx = b.st[1];
        if (nloc == 0u) { xcd_barrier_complete(bar, b.x, nloc, nx); b.st[0] = nloc; b.st[1] = nx; }
        const unsigned old = xb_add(&bar[XB_XSUB(b.x)], 1u);
        const unsigned gen = old / nloc;
        if (old + 1u == (gen + 1u) * nloc) {
            __builtin_amdgcn_fence(__ATOMIC_RELEASE, "agent");
            asm volatile("s_waitcnt vmcnt(0)" ::: "memory");
            const unsigned og = xb_add(&bar[XB_TOP], 1u);
            const unsigned tg = og / nx;
            if (og + 1u == (tg + 1u) * nx) xb_add(&bar[XB_TOPGEN], 1u);
            else XB_SPIN(xb_ld(&bar[XB_TOPGEN]) == tg, bar);
            __builtin_amdgcn_fence(__ATOMIC_ACQUIRE, "agent");
            xb_add(&bar[XB_XGEN(b.x)], 1u);
            asm volatile("s_waitcnt vmcnt(0)" ::: "memory");
        } else {
            XB_SPIN(xb_ld(&bar[XB_XGEN(b.x)]) == gen, bar);
            __builtin_amdgcn_fence(__ATOMIC_ACQUIRE, "agent");
            asm volatile("s_waitcnt vmcnt(0)" ::: "memory");
        }
    }
    __syncthreads();
}

namespace pg8 {
constexpr int BM = 256, BK = 64, HALF = 128, HTB = HALF * BK * 2, STAGE_BYTES = 8 * HTB, NXCD = 8, WGM = 8;
__device__ __forceinline__ int lds_byte(int r, int c) { const int st = (r >> 4) * 2 + (c >> 5), rr = r & 15, cc = c & 31, ob = rr * 64 + cc * 2; return st * 1024 + (ob ^ (((ob >> 9) & 1) << 5)); }
__device__ __forceinline__ void stage_rc(int b, int& R, int& C) { const int st = b / 1024, sb = b % 1024, swz = sb ^ (((sb >> 9) & 1) << 5); R = (st >> 1) * 16 + swz / 64; C = (st & 1) * 32 + (swz % 64) / 2; }
__device__ __forceinline__ int perm32(int rho) { const int n = rho >> 4, i = rho & 15; return 8 * (i >> 2) + 4 * n + (i & 3); }
__device__ __forceinline__ unsigned cvt_pk_bf16(float lo, float hi) { unsigned r; asm volatile("v_cvt_pk_bf16_f32 %0, %1, %2" : "=v"(r) : "v"(lo), "v"(hi)); return r; }

struct Unit { int pm, pn, e, row0; };

__device__ __forceinline__ int xcd_remap(int wgid, int nwg) { const int q = nwg / NXCD, r = nwg % NXCD, xcd = wgid % NXCD, off = wgid / NXCD; return (xcd < r ? xcd * (q + 1) : r * (q + 1) + (xcd - r) * q) + off; }

template <int K, class Epi, class Sched>
__device__ __forceinline__ void gemm_phase(LAS unsigned char* lds, const Sched& S, const Epi& E) {
    const int tid = threadIdx.x, wid = __builtin_amdgcn_readfirstlane(tid >> 6), lane = tid & 63, wr = wid >> 2, wc = wid & 3, fr = lane & 15, fq = lane >> 4;
    constexpr int nt = K / BK;
    unsigned voffB[2];
#pragma unroll
    for (int i = 0; i < 2; ++i) { int R, C; stage_rc(tid * 16 + i * 8192, R, C); const int Rb = Epi::PERM ? ((R & ~31) + perm32(R & 31)) : R; voffB[i] = (unsigned)(Rb * K + C) * 2u; }
    constexpr size_t kstep = (size_t)(BK * 2);
    constexpr size_t hstep = (size_t)HALF * K * 2;
    const unsigned ldsw = (unsigned)wid * 1024u;
    const int aoff = lds_byte(wr * 64 + fr, fq * 8), boff = lds_byte(wc * 32 + fr, fq * 8);
#define PG8_SA(b, h) (((b) * 2 + (h)) * HTB)
#define PG8_SB(b, h) ((4 + (b) * 2 + (h)) * HTB)
#define PG8_STAGE2(bufoff, gbase, v0, v1) do { \
        __builtin_amdgcn_global_load_lds((const unsigned*)((const char*)(gbase) + (v0)), (LAS unsigned*)(lds + (bufoff) + ldsw), 16, 0, 0); \
        __builtin_amdgcn_global_load_lds((const unsigned*)((const char*)(gbase) + (v1)), (LAS unsigned*)(lds + (bufoff) + ldsw + 8192), 16, 0, 0); } while (0)
#define PG8_STAGEB(bufoff, gbase) PG8_STAGE2(bufoff, gbase, voffB[0], voffB[1])
#define PG8_LDA(dst, b, h) do { _Pragma("unroll") for (int m = 0; m < 4; ++m) _Pragma("unroll") for (int k = 0; k < 2; ++k) dst[m][k] = *(const LAS bf16x8*)(lds + PG8_SA(b, h) + aoff + m * 2048 + k * 1024); } while (0)
#define PG8_LDB(dst, b, h) do { _Pragma("unroll") for (int n = 0; n < 2; ++n) _Pragma("unroll") for (int k = 0; k < 2; ++k) dst[n][k] = *(const LAS bf16x8*)(lds + PG8_SB(b, h) + boff + n * 2048 + k * 1024); } while (0)
#define PG8_MMA(ai, bj, At, Bt) do { __builtin_amdgcn_s_setprio(1); _Pragma("unroll") for (int m = 0; m < 4; ++m) _Pragma("unroll") for (int n = 0; n < 2; ++n) _Pragma("unroll") for (int k = 0; k < 2; ++k) \
        acc[ai][bj][m][n] = __builtin_amdgcn_mfma_f32_16x16x32_bf16(Bt[n][k], At[m][k], acc[ai][bj][m][n], 0, 0, 0); __builtin_amdgcn_s_setprio(0); } while (0)
#define PG8_WAIT_V(n) asm volatile("s_waitcnt vmcnt(" #n ")" ::: "memory")
#define PG8_WAIT_L(n) asm volatile("s_waitcnt lgkmcnt(" #n ")" ::: "memory")
#define PG8_BAR __builtin_amdgcn_s_barrier()
#define PG8_SCHED __builtin_amdgcn_sched_barrier(0)
    Unit cur, nxt; int ui = 0;
    if (!S.next(0, cur)) return;
    f32x4 acc[2][2][4][2];
#pragma unroll
    for (int a = 0; a < 2; ++a)
#pragma unroll
        for (int b = 0; b < 2; ++b)
#pragma unroll
            for (int m = 0; m < 4; ++m)
#pragma unroll
                for (int n = 0; n < 2; ++n) acc[a][b][m][n] = (f32x4){0.f, 0.f, 0.f, 0.f};
    bf16x8 At[4][2], B0[2][2], B1[2][2];
    unsigned vA[2][2], nvA[2][2];
    S.a_voff(cur, tid, vA);
    const char* cA = S.a_base(cur); const char* cB = S.b_base(cur);
    PG8_STAGEB(PG8_SB(0, 0), cB); PG8_STAGE2(PG8_SA(0, 0), cA, vA[0][0], vA[0][1]); PG8_STAGEB(PG8_SB(0, 1), cB + hstep); PG8_STAGE2(PG8_SA(0, 1), cA, vA[1][0], vA[1][1]);
    if (wr == 1) PG8_BAR;
    PG8_WAIT_V(4); PG8_BAR;
    PG8_STAGEB(PG8_SB(1, 0), cB + kstep); PG8_STAGE2(PG8_SA(1, 0), cA + kstep, vA[0][0], vA[0][1]); PG8_STAGEB(PG8_SB(1, 1), cB + hstep + kstep);
    PG8_WAIT_V(6); PG8_BAR;
    for (;;) {
        const bool has_next = S.next(ui + 1, nxt);
        const char* nA = cA; const char* nB = cB;
#pragma unroll
        for (int h = 0; h < 2; ++h)
#pragma unroll
            for (int i = 0; i < 2; ++i) nvA[h][i] = vA[h][i];
        if (has_next) { S.a_voff(nxt, tid, nvA); nA = S.a_base(nxt); nB = S.b_base(nxt); }
#pragma unroll 1
        for (int t = 0; t < nt; t += 2) {
            const bool last = (t == nt - 2);
            const char* a1 = cA + (size_t)(t + 1) * kstep;
            const char* a2 = last ? nA : cA + (size_t)(t + 2) * kstep; const char* b2 = last ? nB : cB + (size_t)(t + 2) * kstep;
            const char* a3 = a2 + kstep; const char* b3 = b2 + kstep;
            const unsigned s00 = last ? nvA[0][0] : vA[0][0], s01 = last ? nvA[0][1] : vA[0][1], s10 = last ? nvA[1][0] : vA[1][0], s11 = last ? nvA[1][1] : vA[1][1];
            PG8_LDB(B0, 0, 0); PG8_SCHED; PG8_LDA(At, 0, 0); PG8_STAGE2(PG8_SA(1, 1), a1, vA[1][0], vA[1][1]);
            PG8_WAIT_L(8); PG8_BAR; PG8_WAIT_L(0); PG8_MMA(0, 0, At, B0); PG8_BAR; PG8_SCHED;
            PG8_LDB(B1, 0, 1); PG8_STAGEB(PG8_SB(0, 0), b2);
            PG8_BAR; PG8_WAIT_L(0); PG8_MMA(0, 1, At, B1); PG8_BAR;
            PG8_LDA(At, 0, 1); PG8_STAGE2(PG8_SA(0, 0), a2, s00, s01);
            PG8_BAR; PG8_WAIT_L(0); PG8_MMA(1, 0, At, B0); PG8_BAR; PG8_SCHED;
            PG8_STAGEB(PG8_SB(0, 1), b2 + hstep);
            PG8_WAIT_V(6); PG8_BAR; PG8_MMA(1, 1, At, B1); PG8_BAR;
            PG8_LDB(B0, 1, 0); PG8_SCHED; PG8_LDA(At, 1, 0); PG8_STAGE2(PG8_SA(0, 1), a2, s10, s11);
            PG8_WAIT_L(8); PG8_BAR; PG8_WAIT_L(0); PG8_MMA(0, 0, At, B0); PG8_BAR; PG8_SCHED;
            PG8_LDB(B1, 1, 1); PG8_STAGEB(PG8_SB(1, 0), b3);
            PG8_BAR; PG8_WAIT_L(0); PG8_MMA(0, 1, At, B1); PG8_BAR;
            PG8_LDA(At, 1, 1); PG8_STAGE2(PG8_SA(1, 0), a3, s00, s01);
            PG8_BAR; PG8_WAIT_L(0); PG8_MMA(1, 0, At, B0); PG8_BAR; PG8_SCHED;
            PG8_STAGEB(PG8_SB(1, 1), b3 + hstep);
            PG8_WAIT_V(6); PG8_BAR; PG8_MMA(1, 1, At, B1); PG8_BAR;
        }
        E(acc, cur, wr, wc, fr, fq);
        if (!has_next) break;
#pragma unroll
        for (int a = 0; a < 2; ++a)
#pragma unroll
            for (int b = 0; b < 2; ++b)
#pragma unroll
                for (int m = 0; m < 4; ++m)
#pragma unroll
                    for (int n = 0; n < 2; ++n) acc[a][b][m][n] = (f32x4){0.f, 0.f, 0.f, 0.f};
        cur = nxt; cA = nA; cB = nB; ++ui;
#pragma unroll
        for (int h = 0; h < 2; ++h)
#pragma unroll
            for (int i = 0; i < 2; ++i) vA[h][i] = nvA[h][i];
    }
    PG8_WAIT_V(0);
    if (wr == 0) PG8_BAR;
    PG8_BAR;
#undef PG8_SA
#undef PG8_SB
#undef PG8_STAGE2
#undef PG8_STAGEB
#undef PG8_LDA
#undef PG8_LDB
#undef PG8_MMA
#undef PG8_WAIT_V
#undef PG8_WAIT_L
#undef PG8_BAR
#undef PG8_SCHED
}

template <int K> struct DenseSched {
    const char* A; const char* Bt; int nM, nN, nwg, G, c;
    __device__ __forceinline__ void init(const void* A_, const void* Bt_, int M, int N, int G_, int c_) { A = (const char*)A_; Bt = (const char*)Bt_; nM = M / BM; nN = N / BM; nwg = nM * nN; G = G_; c = c_; }
    __device__ __forceinline__ bool next(int i, Unit& u) const {
        const long L = (long)i * G + c; if (L >= nwg) return false;
        const int wgid = xcd_remap((int)L, nwg);
        const int nig = WGM * nN, gid = wgid / nig, fm = gid * WGM, gsz = (nM - fm) < WGM ? (nM - fm) : WGM;
        u.pm = fm + ((wgid % nig) % gsz); u.pn = (wgid % nig) / gsz; u.e = 0; u.row0 = u.pm * BM; return true;
    }
    __device__ __forceinline__ const char* a_base(const Unit& u) const { return A + (size_t)u.pm * BM * K * 2; }
    __device__ __forceinline__ const char* b_base(const Unit& u) const { return Bt + (size_t)u.pn * BM * K * 2; }
    __device__ __forceinline__ void a_voff(const Unit&, int tid, unsigned (&v)[2][2]) const {
#pragma unroll
        for (int i = 0; i < 2; ++i) { int R, C; stage_rc(tid * 16 + i * 8192, R, C); v[0][i] = (unsigned)(R * K + C) * 2u; v[1][i] = (unsigned)((R + HALF) * K + C) * 2u; }
    }
};
template <int K, bool GATHER> struct MoeSched {
    const char* A; const char* Bt; const int* ltok; const LAS int* tstart; int ntiles, nN, nwg, G, c; size_t bstride_e; int bcol0;
    __device__ __forceinline__ bool next(int i, Unit& u) const {
        const long L = (long)i * G + c; if (L >= nwg) return false;
        const int wgid = xcd_remap((int)L, nwg);
        const int rt = wgid / nN; u.pn = wgid % nN; u.pm = rt; u.row0 = rt * BM;
        int lo = 0, hi = NE1;
        while (hi - lo > 1) { const int mid = (lo + hi) >> 1; if (tstart[mid] <= rt) lo = mid; else hi = mid; }
        u.e = lo; return true;
    }
    __device__ __forceinline__ const char* a_base(const Unit& u) const { return GATHER ? A : A + (size_t)u.row0 * K * 2; }
    __device__ __forceinline__ const char* b_base(const Unit& u) const { return Bt + (size_t)u.e * bstride_e + (size_t)(bcol0 + u.pn * BM) * K * 2; }
    __device__ __forceinline__ void a_voff(const Unit& u, int tid, unsigned (&v)[2][2]) const {
#pragma unroll
        for (int i = 0; i < 2; ++i) { int R, C; stage_rc(tid * 16 + i * 8192, R, C);
            if (GATHER) { const int t0 = ltok[u.row0 + R], t1 = ltok[u.row0 + HALF + R]; v[0][i] = (unsigned)(t0 * K + C) * 2u; v[1][i] = (unsigned)(t1 * K + C) * 2u; }
            else { v[0][i] = (unsigned)(R * K + C) * 2u; v[1][i] = (unsigned)((R + HALF) * K + C) * 2u; } }
    }
};
}
using pg8::Unit;

struct EpiInProj {
    static constexpr bool PERM = true;
    unsigned char* ws; const f32x2* rope;
    __device__ __forceinline__ void operator()(const f32x4 (&acc)[2][2][4][2], const Unit& u, int wr, int wc, int fr, int fq) const {
        const int pn = u.pn; const int row0 = u.pm * 256 + wr * 64 + fr;
        bf16_t* dst; int ld, colt;
        if (pn < 2) { dst = (bf16_t*)(ws + WS_Q); ld = 512; colt = pn * 256; }
        else if (pn < 4) { dst = (bf16_t*)(ws + WS_K); ld = 512; colt = (pn - 2) * 256; }
        else if (pn < 6) { dst = (bf16_t*)(ws + WS_V); ld = 512; colt = (pn - 4) * 256; }
        else if (pn == 6) { dst = (bf16_t*)(ws + WS_U); ld = 256; colt = 0; }
        else if (pn < 10) { dst = (bf16_t*)(ws + WS_G); ld = 768; colt = (pn - 7) * 256; }
        else { dst = (bf16_t*)(ws + WS_Z); ld = 256; colt = 0; }
        const bool rope_on = (pn < 4) && (u.pm < TL / 256);
        const float qs = pn < 2 ? 0.125f : 1.f;
        float* BA = (float*)(ws + WS_BA);
#pragma unroll
        for (int ai = 0; ai < 2; ++ai)
#pragma unroll
            for (int m = 0; m < 4; ++m) {
                const int r = row0 + ai * 128 + m * 16;
                if (pn == 11) {
                    if (wc == 0 && fq < 2) { *(f32x4*)(BA + (size_t)r * 16 + 8 * fq) = acc[ai][0][m][0]; *(f32x4*)(BA + (size_t)r * 16 + 8 * fq + 4) = acc[ai][0][m][1]; }
                } else {
                    f32x4 cs0 = {1.f, 0.f, 1.f, 0.f}, cs1 = {1.f, 0.f, 1.f, 0.f};
                    if (rope_on) { const int t = r & (SEQ - 1); const int pos = (wc & 1) ? (t & 63) : (t >> 6); const f32x4* rp = (const f32x4*)(rope + pos * 16 + 4 * fq); cs0 = rp[0]; cs1 = rp[1]; }
#pragma unroll
                    for (int bj = 0; bj < 2; ++bj) {
                        f32x4 v0 = acc[ai][bj][m][0], v1 = acc[ai][bj][m][1];
                        if (rope_on) {
                            const f32x4 c = {cs0[0], cs0[2], cs1[0], cs1[2]}, s = {cs0[1], cs0[3], cs1[1], cs1[3]};
                            const f32x4 x1 = v0, x2 = v1; v0 = x1 * c - x2 * s; v1 = x1 * s + x2 * c;
                        }
                        v0 = v0 * qs; v1 = v1 * qs;
                        u32x4 w; w.x = pg8::cvt_pk_bf16(v0[0], v0[1]); w.y = pg8::cvt_pk_bf16(v0[2], v0[3]); w.z = pg8::cvt_pk_bf16(v1[0], v1[1]); w.w = pg8::cvt_pk_bf16(v1[2], v1[3]);
                        *(u32x4*)(dst + (size_t)r * ld + colt + bj * 128 + wc * 32 + 8 * fq) = w;
                    }
                }
            }
    }
};
struct EpiResid {
    static constexpr bool PERM = false;
    const float* xin_lat; const float* xin_ctx; float* xo_lat; float* xo_ctx; const float* mod; int gidx;
    __device__ __forceinline__ void operator()(const f32x4 (&acc)[2][2][4][2], const Unit& u, int wr, int wc, int fr, int fq) const {
        const bool lat = u.pm < TL / 256;
        const int j = lat ? (u.pm >> 4) : 8  ;
        const float* gv = mod + j * 6144 + gidx * 1024;
        const float* src = lat ? xin_lat + (size_t)u.pm * 256 * DM : xin_ctx + (size_t)(u.pm - TL / 256) * 256 * DM;
        float* dst = lat ? xo_lat + (size_t)u.pm * 256 * DM : xo_ctx + (size_t)(u.pm - TL / 256) * 256 * DM;
#pragma unroll
        for (int ai = 0; ai < 2; ++ai)
#pragma unroll
            for (int m = 0; m < 4; ++m) {
                const int r = wr * 64 + fr + ai * 128 + m * 16;
#pragma unroll
                for (int bj = 0; bj < 2; ++bj)
#pragma unroll
                    for (int n = 0; n < 2; ++n) {
                        const int c = u.pn * 256 + bj * 128 + wc * 32 + n * 16 + 4 * fq;
                        const f32x4 x = *(const f32x4*)(src + (size_t)r * DM + c), g = *(const f32x4*)(gv + c);
                        *(f32x4*)(dst + (size_t)r * DM + c) = x + g * acc[ai][bj][m][n];
                    }
            }
    }
};
struct EpiMoeUp {
    static constexpr bool PERM = true;
    bf16_t* hid; const float* lgate;
    __device__ __forceinline__ void operator()(const f32x4 (&acc)[2][2][4][2], const Unit& u, int wr, int wc, int fr, int fq) const {
#pragma unroll
        for (int ai = 0; ai < 2; ++ai)
#pragma unroll
            for (int m = 0; m < 4; ++m) {
                const int r = u.row0 + wr * 64 + fr + ai * 128 + m * 16;
                const float gt = lgate[r];
                f32x4 h0, h1;
#pragma unroll
                for (int j = 0; j < 4; ++j) { const float a0 = acc[ai][0][m][0][j], a1 = acc[ai][0][m][1][j]; h0[j] = siluf(a0) * acc[ai][1][m][0][j] * gt; h1[j] = siluf(a1) * acc[ai][1][m][1][j] * gt; }
                u32x4 w; w.x = pg8::cvt_pk_bf16(h0[0], h0[1]); w.y = pg8::cvt_pk_bf16(h0[2], h0[3]); w.z = pg8::cvt_pk_bf16(h1[0], h1[1]); w.w = pg8::cvt_pk_bf16(h1[2], h1[3]);
                *(u32x4*)(hid + (size_t)r * 256 + u.pn * 128 + wc * 32 + 8 * fq) = w;
            }
    }
};
struct EpiMoeDown {
    static constexpr bool PERM = true;
    bf16_t* pair;
    __device__ __forceinline__ void operator()(const f32x4 (&acc)[2][2][4][2], const Unit& u, int wr, int wc, int fr, int fq) const {
#pragma unroll
        for (int ai = 0; ai < 2; ++ai)
#pragma unroll
            for (int m = 0; m < 4; ++m) {
                const int r = u.row0 + wr * 64 + fr + ai * 128 + m * 16;
#pragma unroll
                for (int bj = 0; bj < 2; ++bj) {
                    const f32x4 v0 = acc[ai][bj][m][0], v1 = acc[ai][bj][m][1];
                    u32x4 w; w.x = pg8::cvt_pk_bf16(v0[0], v0[1]); w.y = pg8::cvt_pk_bf16(v0[2], v0[3]); w.z = pg8::cvt_pk_bf16(v1[0], v1[1]); w.w = pg8::cvt_pk_bf16(v1[2], v1[3]);
                    *(u32x4*)(pair + (size_t)r * 256 + bj * 128 + wc * 32 + 8 * fq) = w;
                }
            }
    }
};

struct Ctx {
    Params p; LAS unsigned char* lds; int tid, lane, wave, G, bid, gw, NGW;
    __device__ __forceinline__ const float* in(int i) const { return p.in[i]; }
    template <class T> __device__ __forceinline__ T* wsp(size_t off) const { return (T*)(p.ws + off); }
};

__device__ __forceinline__ void ph_pre(const Ctx& c) {
    LAS float* act = (LAS float*)c.lds;
    LAS float* red = act + 9216;
    const float* cv = c.in(I_C); const float* cc = c.in(I_CCTX);
    for (int i = c.tid; i < 9216; i += 512) { const int j = i >> 10, k = i & 1023; const float v = j < 8 ? cv[j * 1024 + k] : cc[k]; act[i] = siluf(v); }
    __syncthreads();
    float* mods = c.wsp<float>(WS_MODS);
    for (int item = c.bid; item < 96; item += c.G) {
        const int l = item / 48, n0 = (item % 48) * 128, kq = c.tid >> 7, n = c.tid & 127;
        float a[9];
#pragma unroll
        for (int j = 0; j < 9; ++j) a[j] = 0.f;
        const float* w = c.in(I_WMOD) + ((size_t)l * 1024 + kq * 256) * 6144 + n0 + n;
        for (int k = 0; k < 256; ++k) { const float wv = w[(size_t)k * 6144];
#pragma unroll
            for (int j = 0; j < 9; ++j) a[j] += act[j * 1024 + kq * 256 + k] * wv; }
#pragma unroll
        for (int j = 0; j < 9; ++j) red[(kq * 9 + j) * 128 + n] = a[j];
        __syncthreads();
        if (kq == 0) {
#pragma unroll
            for (int j = 0; j < 9; ++j) { const float s = red[(0 * 9 + j) * 128 + n] + red[(1 * 9 + j) * 128 + n] + red[(2 * 9 + j) * 128 + n] + red[(3 * 9 + j) * 128 + n];
                mods[((size_t)l * 9 + j) * 6144 + n0 + n] = s + c.in(I_BMOD)[l * 6144 + n0 + n]; }
        }
        __syncthreads();
    }
    if (c.bid == c.G - 1) {
        f32x2* rope = c.wsp<f32x2>(WS_ROPE);
        for (int i = c.tid; i < 1024; i += 512) { const int pos = i >> 4, f = i & 15; const float inv = exp2f(-(float)f * (13.287712379549449f / 16.f)); const float a = (float)pos * inv;
            rope[i] = (f32x2){__cosf(a), __sinf(a)}; }
    }
}

__device__ __forceinline__ void tr_item(const float* W, int ldw, int ncols, int k0, int n0, bf16_t* WT, int Kdim, int drow0, bool perm, LAS float* scr, int lane) {
#pragma unroll 8
    for (int i = 0; i < 32; ++i) { const int kk = 2 * i + (lane >> 5); const int col = n0 + (lane & 31); scr[kk * 33 + (lane & 31)] = col < ncols ? W[(size_t)(k0 + kk) * ldw + col] : 0.f; }
    LDS_WAIT(); asm volatile("" ::: "memory");
    const int cch = lane & 7;
#pragma unroll
    for (int j = 0; j < 4; ++j) { const int n = (lane >> 3) + 8 * j; const int sn = perm ? dimperm(n) : n; const LAS float* s = scr + (8 * cch) * 33 + sn;
        u32x4 o; o.x = pk2(s[0 * 33], s[1 * 33]); o.y = pk2(s[2 * 33], s[3 * 33]); o.z = pk2(s[4 * 33], s[5 * 33]); o.w = pk2(s[6 * 33], s[7 * 33]);
        *(u32x4*)(WT + (size_t)(drow0 + n) * Kdim + k0 + 8 * cch) = o; }
    LDS_WAIT(); asm volatile("" ::: "memory");
}
__device__ __forceinline__ void ph_wprep(const Ctx& c, int l) {
    LAS float* scr = (LAS float*)(c.lds + c.wave * 16384);
    constexpr int I_IN = 16 * 96, I_OUT = 16 * 32, I_EXP = 384;
    constexpr int NITEMS = I_IN + I_OUT + NE1 * I_EXP;
    for (int it = c.gw; it < NITEMS; it += c.NGW) {
        int r = it;
        if (r < I_IN) { const int kb = r / 96, nb = r % 96; tr_item(c.in(I_WIN) + (size_t)l * 1024 * NIN, NIN, NIN, kb * 64, nb * 32, c.wsp<bf16_t>(WS_WIN), 1024, nb * 32, nb * 32 < 1024, scr, c.lane); continue; }
        r -= I_IN;
        if (r < I_OUT) { const int kb = r / 32, nb = r % 32; tr_item(c.in(I_WOUT) + (size_t)l * 1024 * 1024, 1024, 1024, kb * 64, nb * 32, c.wsp<bf16_t>(WS_WOUT), 1024, nb * 32, false, scr, c.lane); continue; }
        r -= I_OUT;
        const int e = r / I_EXP; int q = r % I_EXP;
        if (q < 256) {
            const bool is3 = q >= 128; q &= 127; const int kb = q / 8, nb = q % 8, n0 = nb * 32;
            const float* src = e < 64 ? c.in(is3 ? I_W3 : I_W1) + ((size_t)l * 64 + e) * 1024 * 256 : c.in(is3 ? I_WS3 : I_WS1) + (size_t)l * 1024 * 256;
            tr_item(src, 256, 256, kb * 64, n0, c.wsp<bf16_t>(WS_W13) + (size_t)e * 512 * 1024, 1024, (n0 >> 7) * 256 + (n0 & 127) + (is3 ? 128 : 0), false, scr, c.lane);
        } else {
            q -= 256; const int kb = q / 32, nb = q % 32;
            const float* src = e < 64 ? c.in(I_W2) + ((size_t)l * 64 + e) * 256 * 1024 : c.in(I_WS2) + (size_t)l * 256 * 1024;
            tr_item(src, 1024, 1024, kb * 64, nb * 32, c.wsp<bf16_t>(WS_W2) + (size_t)e * 1024 * 256, 256, nb * 32, false, scr, c.lane);
        }
    }
}

template <bool COPY> __device__ __forceinline__ void norm_mod_row(const float* xrow, const float* nw, const float* sc, const float* sh, bf16_t* orow, LAS float* h2s, int lane) {
    f32x4 v[4]; float ss = 0.f;
#pragma unroll
    for (int j = 0; j < 4; ++j) { v[j] = ((const f32x4*)xrow)[lane + 64 * j]; ss += (v[j][0] * v[j][0] + v[j][1] * v[j][1]) + (v[j][2] * v[j][2] + v[j][3] * v[j][3]); }
    ss = wave_sum(ss);
    const float rstd = rsqrtf(ss * (1.f / DM) + EPS);
#pragma unroll
    for (int j = 0; j < 4; ++j) { const int col = 4 * lane + 256 * j;
        const f32x4 w = *(const f32x4*)(nw + col), a = *(const f32x4*)(sc + col), s = *(const f32x4*)(sh + col);
        const f32x4 y = (v[j] * rstd) * w * (a + 1.f) + s;
        u32x2 o; o.x = pk2(y[0], y[1]); o.y = pk2(y[2], y[3]);
        *(u32x2*)(orow + col) = o;
        if (COPY) *(LAS f32x4*)(h2s + col) = y; }
}
__device__ __forceinline__ const float* xrow_ptr(const Ctx& c, int l, int m) {
    if (m < TL) return (l == 0 ? c.in(I_X) : c.p.out) + (size_t)m * DM;
    return ((l == 0 || ABL_CTXORIG) ? c.in(I_CTX) : c.wsp<float>(WS_XC)) + (size_t)(m - TL) * DM;
}
__device__ __forceinline__ void ph_norm1(const Ctx& c, int l) {
    const float* mods = c.wsp<float>(WS_MODS) + (size_t)l * 9 * 6144;
    bf16_t* hb = c.wsp<bf16_t>(WS_HB);
    for (int m = c.gw; m < MT; m += c.NGW) {
        const int j = m < TL ? m / SEQ : 8;
        norm_mod_row<false>(xrow_ptr(c, l, m), c.in(I_N1W) + l * DM, mods + j * 6144 + 1 * 1024, mods + j * 6144 + 0 * 1024, hb + (size_t)m * DM, nullptr, c.lane);
    }
}

__device__ __forceinline__ void ph_attn_naive(const Ctx& c, int l) {
    LAS float* Ks = (LAS float*)c.lds;
    LAS float* Vs = Ks + 32 * 128;
    LAS float* ob = Vs + 32 * 128;
    LAS float* ssb = ob + 2 * 2 * 64 * 64;
    LAS float* lamp = ssb + 256;
    const bf16_t* Q = c.wsp<bf16_t>(WS_Q); const bf16_t* Kb = c.wsp<bf16_t>(WS_K); const bf16_t* Vb = c.wsp<bf16_t>(WS_V);
    bf16_t* hb = c.wsp<bf16_t>(WS_HB);
    const float lam_init = 0.8f - 0.6f * __expf(-0.3f * (float)l);
    if (c.wave == 0) { const float* dl = c.in(I_DALAM) + l * 256; const float s1 = wave_sum(dl[c.lane] * dl[64 + c.lane]), s2 = wave_sum(dl[128 + c.lane] * dl[192 + c.lane]);
        if (c.lane == 0) lamp[0] = __expf(s1) - __expf(s2) + lam_init; }
    __syncthreads();
    const float lam = lamp[0];
    const int rg = c.wave >> 2, map = (c.wave >> 1) & 1, vh = c.wave & 1;
    const int nitems_lat = NB * 4 * 32, nitems = nitems_lat + (l == 0 ? NB * 4 * 2 : 0);
    for (int item = c.bid; item < nitems; item += c.G) {
        int b, h, qrow0, nkt;
        if (item < nitems_lat) { b = item >> 7; h = (item >> 5) & 3; qrow0 = b * SEQ + (item & 31) * 128; nkt = (SEQ + NCTX) / 32; }
        else { const int it = item - nitems_lat; b = it >> 3; h = (it >> 1) & 3; qrow0 = TL + b * NCTX + (it & 1) * 128; nkt = NCTX / 32; }
        const int qrow = qrow0 + rg * 64 + c.lane;
        float q[64];
        { const bf16x8* qp = (const bf16x8*)(Q + (size_t)qrow * 512 + h * 128 + map * 64);
#pragma unroll
          for (int i = 0; i < 8; ++i) { const bf16x8 t = qp[i];
#pragma unroll
              for (int j = 0; j < 8; ++j) q[8 * i + j] = bf2f((unsigned short)t[j]); } }
        const int skey = c.tid >> 4, scol = (c.tid & 15) * 8;
        float mx = -3.0e38f;
        for (int pass = 0; pass < 2; ++pass) {
            float lsum = 0.f; float o[64];
#pragma unroll
            for (int e = 0; e < 64; ++e) o[e] = 0.f;
            for (int kt = (ABL_NOCTXKEYS && item < nitems_lat) ? NCTX / 32 : 0; kt < nkt; ++kt) {
                const int krow = (kt < NCTX / 32) ? TL + b * NCTX + kt * 32 + skey : b * SEQ + (kt - NCTX / 32) * 32 + skey;
                { const bf16x8 kv = *(const bf16x8*)(Kb + (size_t)krow * 512 + h * 128 + scol);
#pragma unroll
                  for (int j = 0; j < 8; ++j) Ks[skey * 128 + scol + j] = bf2f((unsigned short)kv[j]);
                  if (pass == 1) { const bf16x8 vv = *(const bf16x8*)(Vb + (size_t)krow * 512 + h * 128 + scol);
#pragma unroll
                      for (int j = 0; j < 8; ++j) Vs[skey * 128 + scol + j] = bf2f((unsigned short)vv[j]); } }
                __syncthreads();
                for (int key = 0; key < 32; ++key) {
                    const LAS f32x4* kr = (const LAS f32x4*)(Ks + key * 128 + map * 64);
                    float s = 0.f;
#pragma unroll
                    for (int i = 0; i < 16; ++i) { const f32x4 kk = kr[i]; s += q[4 * i] * kk[0] + q[4 * i + 1] * kk[1] + q[4 * i + 2] * kk[2] + q[4 * i + 3] * kk[3]; }
                    if (pass == 0) mx = fmaxf(mx, s);
                    else {
                        const float pr = __expf(s - mx); lsum += pr;
                        const LAS f32x4* vr = (const LAS f32x4*)(Vs + key * 128 + vh * 64);
#pragma unroll
                        for (int i = 0; i < 16; ++i) { const f32x4 vv = vr[i]; o[4 * i] += pr * vv[0]; o[4 * i + 1] += pr * vv[1]; o[4 * i + 2] += pr * vv[2]; o[4 * i + 3] += pr * vv[3]; }
                    }
                }
                __syncthreads();
            }
            if (pass == 1) {
                const float il = 1.f / lsum;
                if (map == 1) {
#pragma unroll
                    for (int e = 0; e < 64; ++e) ob[((rg * 2 + vh) * 64 + e) * 64 + c.lane] = o[e] * il;
                }
                __syncthreads();
                float ss = 0.f;
                if (map == 0) {
#pragma unroll
                    for (int e = 0; e < 64; ++e) { o[e] = o[e] * il - lam * ob[((rg * 2 + vh) * 64 + e) * 64 + c.lane]; ss += o[e] * o[e]; }
                    ssb[(rg * 2 + vh) * 64 + c.lane] = ss;
                }
                __syncthreads();
                if (map == 0) {
                    const float tot = ssb[(rg * 2 + 0) * 64 + c.lane] + ssb[(rg * 2 + 1) * 64 + c.lane];
                    const float r = rsqrtf(tot * (1.f / 128.f) + EPS) * (1.f - lam_init);
                    const float* sw = c.in(I_DASUB) + l * 128 + vh * 64;
                    bf16_t* op = hb + (size_t)qrow * DM + h * 128 + vh * 64;
#pragma unroll
                    for (int e = 0; e < 64; e += 8) { u32x4 w; w.x = pk2(o[e] * r * sw[e], o[e + 1] * r * sw[e + 1]); w.y = pk2(o[e + 2] * r * sw[e + 2], o[e + 3] * r * sw[e + 3]);
                        w.z = pk2(o[e + 4] * r * sw[e + 4], o[e + 5] * r * sw[e + 5]); w.w = pk2(o[e + 6] * r * sw[e + 6], o[e + 7] * r * sw[e + 7]); if (ABL_ZERO_ATT) w = (u32x4){0u,0u,0u,0u}; *(u32x4*)(op + e) = w; }
                }
                __syncthreads();
            }
        }
    }
}

__device__ __forceinline__ void ph_s5_naive(const Ctx& c, int l) {
    const bf16_t* U = c.wsp<bf16_t>(WS_U); float* Y = c.wsp<float>(WS_YS5);
    for (int item = c.gw; item < NB * 16; item += c.NGW) {
        const int b = item >> 4, g = item & 15, p = c.lane;
        const float dsk = c.lane < 16 ? c.in(I_S5D)[l * 256 + g * 16 + c.lane] : 0.f;
        for (int dir = 0; dir < 2; ++dir) {
            const int pi = ((l * 2 + dir) * 16 + g) * 64 + p;
            const float lr = c.in(I_S5LRE)[pi], li = c.in(I_S5LIM)[pi], step = __expf(c.in(I_S5STEP)[(l * 2 + dir) * 16 + g]);
            const float mag = __expf(lr * step); const float are = mag * cosf(li * step), aim = mag * sinf(li * step);
            const float den = lr * lr + li * li, nr = are - 1.f, ni = aim;
            const float fre = (nr * lr + ni * li) / den, fim = (ni * lr - nr * li) / den;
            float bre[16], bim[16], cre[16], cim[16];
#pragma unroll
            for (int h = 0; h < 16; ++h) { const float br = c.in(I_S5BRE)[(size_t)pi * 16 + h], bi = c.in(I_S5BIM)[(size_t)pi * 16 + h];
                bre[h] = fre * br - fim * bi; bim[h] = fre * bi + fim * br;
                const size_t ci = ((size_t)((l * 2 + dir) * 16 + g) * 16 + h) * 64 + p; cre[h] = c.in(I_S5CRE)[ci]; cim[h] = c.in(I_S5CIM)[ci]; }
            float xr = 0.f, xi = 0.f;
            for (int s = 0; s < NCTX + SEQ; ++s) {
                int row;
                if (dir == 0) row = s < NCTX ? TL + b * NCTX + s : b * SEQ + (s - NCTX);
                else row = s < NCTX ? TL + b * NCTX + (NCTX - 1 - s) : b * SEQ + (SEQ - 1 - (s - NCTX));
                const bf16x8* up = (const bf16x8*)(U + (size_t)row * 256 + g * 16);
                const bf16x8 u0 = up[0], u1 = up[1];
                float u[16];
#pragma unroll
                for (int j = 0; j < 8; ++j) { u[j] = bf2f((unsigned short)u0[j]); u[8 + j] = bf2f((unsigned short)u1[j]); }
                float br = 0.f, bi = 0.f;
#pragma unroll
                for (int h = 0; h < 16; ++h) { br += bre[h] * u[h]; bi += bim[h] * u[h]; }
                const float nxr = are * xr - aim * xi + br, nxi = are * xi + aim * xr + bi; xr = nxr; xi = nxi;
                float mine = 0.f;
#pragma unroll
                for (int h = 0; h < 16; ++h) { const float v = wave_sum(cre[h] * xr - cim[h] * xi); mine = (c.lane == h) ? v : mine; }
                if (c.lane < 16) {
                    float* yp = Y + (size_t)row * 256 + g * 16 + c.lane;
                    float um = 0.f;
#pragma unroll
                    for (int h = 0; h < 16; ++h) um = (c.lane == h) ? u[h] : um;
                    if (dir == 0) *yp = um * dsk + mine; else *yp += mine;
                }
            }
        }
    }
}
__device__ __forceinline__ float gelu_tanh(float x) { const float t = 0.7978845608028654f * (x + 0.044715f * x * x * x); return 0.5f * x * (1.f + tanhf(t)); }
__device__ __forceinline__ void ph_s5_glu(const Ctx& c, int l, int nrows) {
    LAS float* zs = (LAS float*)(c.lds + c.wave * 4096);
    const float* Y = c.wsp<float>(WS_YS5); bf16_t* hb = c.wsp<bf16_t>(WS_HB);
    const float* W = c.in(I_S5WGLU) + (size_t)l * 65536; const float* bg = c.in(I_S5BGLU) + l * 256;
    for (int r0 = c.gw * 4; r0 < nrows; r0 += c.NGW * 4) {
#pragma unroll
        for (int r = 0; r < 4; ++r) { const f32x4 y = *(const f32x4*)(Y + (size_t)(r0 + r) * 256 + 4 * c.lane);
            f32x4 z; z[0] = gelu_tanh(y[0]); z[1] = gelu_tanh(y[1]); z[2] = gelu_tanh(y[2]); z[3] = gelu_tanh(y[3]); *(LAS f32x4*)(zs + r * 256 + 4 * c.lane) = z; }
        LDS_WAIT(); asm volatile("" ::: "memory");
        float a[4][4];
#pragma unroll
        for (int r = 0; r < 4; ++r)
#pragma unroll
            for (int i = 0; i < 4; ++i) a[r][i] = 0.f;
        for (int k = 0; k < 256; ++k) {
            float w[4];
#pragma unroll
            for (int i = 0; i < 4; ++i) w[i] = W[(size_t)k * 256 + c.lane + 64 * i];
#pragma unroll
            for (int r = 0; r < 4; ++r) { const float z = zs[r * 256 + k];
#pragma unroll
                for (int i = 0; i < 4; ++i) a[r][i] += z * w[i]; }
        }
#pragma unroll
        for (int r = 0; r < 4; ++r)
#pragma unroll
            for (int i = 0; i < 4; ++i) { const int col = c.lane + 64 * i; const float z = zs[r * 256 + col];
                hb[(size_t)(r0 + r) * DM + 512 + col] = ABL_ZERO_S5 ? (bf16_t)0 : (bf16_t)f2bf(z * sigmf(a[r][i] + bg[col])); }
        LDS_WAIT(); asm volatile("" ::: "memory");
    }
}

__device__ __forceinline__ void ph_gdn_prep(const Ctx& c, int l) {
    const bf16_t* Gq = c.wsp<bf16_t>(WS_G); float* GQ = c.wsp<float>(WS_GQ); float* GBG = c.wsp<float>(WS_GBG); const float* BA = c.wsp<float>(WS_BA);
    const float* cw = c.in(I_GCONV) + (size_t)l * 5 * 768;
    for (int m = c.gw; m < MT; m += c.NGW) {
        int t, len, base;
        if (m < TL) { t = m & (SEQ - 1); len = SEQ; base = m - t; } else { t = (m - TL) & (NCTX - 1); len = NCTX; base = m - t; }
        float v[12];
#pragma unroll
        for (int i = 0; i < 12; ++i) { const int ch = c.lane + 64 * i; float s = 0.f;
#pragma unroll
            for (int j = 0; j < 5; ++j) { const int tt = t + j - 2; if (tt >= 0 && tt < len) s += cw[j * 768 + ch] * bf2f(Gq[(size_t)(base + tt) * 768 + ch]); }
            v[i] = siluf(s); }
#pragma unroll
        for (int i = 0; i < 8; ++i) { const float ss = wave_sum(v[i] * v[i]); const float r = rsqrtf(ss + EPS) * (i < 4 ? 0.125f : 1.f); v[i] *= r; }
#pragma unroll
        for (int i = 0; i < 12; ++i) GQ[(size_t)m * 768 + c.lane + 64 * i] = v[i];
        if (c.lane < 16) {
            const float x = BA[(size_t)m * 16 + c.lane]; float o;
            if (c.lane < 8) o = sigmf(x);
            else { const int dh = c.lane - 8; const float xx = x + c.in(I_GDT)[l * 8 + dh]; const float sp = xx > 20.f ? xx : log1pf(__expf(xx)); o = __expf(-__expf(c.in(I_GALOG)[l * 8 + dh]) * sp); }
            GBG[(size_t)m * 16 + c.lane] = o;
        }
    }
}
__device__ __forceinline__ void ph_gdn_naive(const Ctx& c, int l) {
    const float* GQ = c.wsp<float>(WS_GQ); const float* GBG = c.wsp<float>(WS_GBG); float* GO = c.wsp<float>(WS_GO);
    const bf16_t* Z = c.wsp<bf16_t>(WS_Z); bf16_t* hb = c.wsp<bf16_t>(WS_HB);
    for (int item = c.gw; item < NB * 4; item += c.NGW) {
        const int b = item >> 2, h = item & 3, e = c.lane;
        const float nw = c.in(I_GNORM)[l * 64 + e];
        for (int dir = 0; dir < 2; ++dir) {
            float S[64];
#pragma unroll
            for (int d = 0; d < 64; ++d) S[d] = 0.f;
            for (int s = 0; s < NCTX + SEQ; ++s) {
                int row;
                if (dir == 0) row = s < NCTX ? TL + b * NCTX + s : b * SEQ + (s - NCTX);
                else row = s < NCTX ? TL + b * NCTX + (NCTX - 1 - s) : b * SEQ + (SEQ - 1 - (s - NCTX));
                const float* gp = GQ + (size_t)row * 768 + h * 64 + e;
                const float qd = gp[0], kd = gp[256], ve = gp[512];
                const float beta = GBG[(size_t)row * 16 + dir * 4 + h], a = GBG[(size_t)row * 16 + 8 + dir * 4 + h];
                float kS = 0.f;
#pragma unroll
                for (int d = 0; d < 64; ++d) kS += __builtin_bit_cast(float, __builtin_amdgcn_readlane(__builtin_bit_cast(int, kd), d)) * S[d];
                const float delta = beta * (ve - a * kS);
                float o = 0.f;
#pragma unroll
                for (int d = 0; d < 64; ++d) { const float kk = __builtin_bit_cast(float, __builtin_amdgcn_readlane(__builtin_bit_cast(int, kd), d));
                    const float qq = __builtin_bit_cast(float, __builtin_amdgcn_readlane(__builtin_bit_cast(int, qd), d));
                    S[d] = a * S[d] + kk * delta; o += qq * S[d]; }
                float* op = GO + (size_t)row * 256 + h * 64 + e;
                if (dir == 0) *op = o;
                else {
                    const float os = *op + o;
                    const float ms = wave_sum(os * os) * (1.f / 64.f);
                    const float z = bf2f(Z[(size_t)row * 256 + h * 64 + e]);
                    hb[(size_t)row * DM + 768 + h * 64 + e] = ABL_ZERO_GDN ? (bf16_t)0 : (bf16_t)f2bf(os * rsqrtf(ms + EPS) * nw * siluf(z));
                }
            }
        }
    }
}

__device__ __forceinline__ void ph_norm2(const Ctx& c, int l, int nrows) {
    LAS float* h2s = (LAS float*)(c.lds + c.wave * 16384);
    const float* mods = c.wsp<float>(WS_MODS) + (size_t)l * 9 * 6144;
    bf16_t* hb = c.wsp<bf16_t>(WS_HB); float* lg = c.wsp<float>(WS_LOG);
    const float* Wr = c.in(I_WR) + (size_t)l * 65536;
    for (int r0 = c.gw * 4; r0 < nrows; r0 += c.NGW * 4) {
#pragma unroll 1
        for (int r = 0; r < 4; ++r) { const int m = r0 + r; const int j = m < TL ? m / SEQ : 8;
            const float* xr = m < TL ? c.p.out + (size_t)m * DM : c.wsp<float>(WS_XC) + (size_t)(m - TL) * DM;
            norm_mod_row<true>(xr, c.in(I_N2W) + l * DM, mods + j * 6144 + 4 * 1024, mods + j * 6144 + 3 * 1024, hb + (size_t)m * DM, h2s + r * 1024, c.lane); }
        LDS_WAIT(); asm volatile("" ::: "memory");
        float a[4] = {0.f, 0.f, 0.f, 0.f};
        for (int k = 0; k < 1024; ++k) { const float w = Wr[k * 64 + c.lane];
#pragma unroll
            for (int r = 0; r < 4; ++r) a[r] += h2s[r * 1024 + k] * w; }
#pragma unroll
        for (int r = 0; r < 4; ++r) lg[(size_t)(r0 + r) * 64 + c.lane] = a[r];
        LDS_WAIT(); asm volatile("" ::: "memory");
    }
}
__device__ __forceinline__ void ph_topk(const Ctx& c, int l, int nrows) {
    LAS float* bz = (LAS float*)c.lds;
    LAS int* hist = (LAS int*)(c.lds + 64 * 512 * 4);
    const float* lg = c.wsp<float>(WS_LOG); const float* rb = c.in(I_RB) + l * 64;
    int* tki = c.wsp<int>(WS_TKI); float* tkw = c.wsp<float>(WS_TKW);
    unsigned* cnt = c.wsp<unsigned>(WS_CTL) + CW_CNT + l * 128;
    if (c.tid < 64) hist[c.tid] = 0;
    __syncthreads();
    for (int t0 = c.bid * 512; t0 < nrows; t0 += c.G * 512) {
        const int t = t0 + c.tid;
        if (t < nrows) {
            for (int e = 0; e < 64; ++e) bz[e * 512 + c.tid] = sigmf(lg[(size_t)t * 64 + e]) + rb[e];
            float gs[8];
#pragma unroll
            for (int g = 0; g < 8; ++g) { float m1 = -3.0e38f, m2 = -3.0e38f;
#pragma unroll
                for (int j = 0; j < 8; ++j) { const float v = bz[(g * 8 + j) * 512 + c.tid]; if (v > m1) { m2 = m1; m1 = v; } else if (v > m2) m2 = v; }
                gs[g] = m1 + m2; }
            unsigned gmask = 0;
#pragma unroll
            for (int it = 0; it < 4; ++it) { float best = -3.0e38f; int bi = 0;
#pragma unroll
                for (int g = 0; g < 8; ++g) if (!((gmask >> g) & 1u) && gs[g] > best) { best = gs[g]; bi = g; }
                gmask |= 1u << bi; }
            unsigned long long chosen = 0ull; int idx[8]; float wv[8]; float wsum = 0.f;
#pragma unroll
            for (int k = 0; k < 8; ++k) { float best = -3.0e38f; int bi = 0;
                for (int e = 0; e < 64; ++e) { const float v = bz[e * 512 + c.tid]; const bool ok = ((gmask >> (e >> 3)) & 1u) && !((chosen >> e) & 1ull); if (ok && v > best) { best = v; bi = e; } }
                chosen |= 1ull << bi; idx[k] = bi; wv[k] = sigmf(lg[(size_t)t * 64 + bi]); wsum += wv[k]; }
            const float sc = 2.5f / wsum;
#pragma unroll
            for (int k = 0; k < 8; ++k) { tki[(size_t)t * 8 + k] = idx[k]; tkw[(size_t)t * 8 + k] = wv[k] * sc; __hip_atomic_fetch_add(&hist[idx[k]], 1, __ATOMIC_RELAXED, __HIP_MEMORY_SCOPE_WORKGROUP); }
        }
    }
    __syncthreads();
    if (c.tid < 64 && hist[c.tid] > 0) atomicAdd(&cnt[c.tid], (unsigned)hist[c.tid]);
}
__device__ __forceinline__ int moe_tstart(const Ctx& c, int l, int nrows, LAS int* tstart) {
    const unsigned* cnt = c.wsp<unsigned>(WS_CTL) + CW_CNT + l * 128;
    if (c.tid == 0) { int acc = 0; for (int e = 0; e < NE1; ++e) { tstart[e] = acc; const int n = e < 64 ? (int)__hip_atomic_load(cnt + e, __ATOMIC_RELAXED, __HIP_MEMORY_SCOPE_AGENT) : nrows; acc += (n + 255) >> 8; } tstart[NE1] = acc; }
    __syncthreads();
    return tstart[NE1];
}
__device__ __forceinline__ void ph_lists(const Ctx& c, int l, int nrows) {
    LAS int* tstart = (LAS int*)(c.lds + LDS_MISC - 1024);
    moe_tstart(c, l, nrows, tstart);
    const unsigned* cnt = c.wsp<unsigned>(WS_CTL) + CW_CNT + l * 128;
    unsigned* fill = c.wsp<unsigned>(WS_CTL) + CW_FILL + l * 128;
    const int* tki = c.wsp<int>(WS_TKI); const float* tkw = c.wsp<float>(WS_TKW);
    int* pos = c.wsp<int>(WS_POS); int* ltok = c.wsp<int>(WS_LTOK); float* lgate = c.wsp<float>(WS_LGATE);
    for (int t = c.bid * 512 + c.tid; t < nrows; t += c.G * 512) {
#pragma unroll
        for (int k = 0; k < 8; ++k) { const int e = tki[(size_t)t * 8 + k]; const int p = tstart[e] * 256 + (int)atomicAdd(&fill[e], 1u);
            ltok[p] = t; lgate[p] = tkw[(size_t)t * 8 + k]; pos[(size_t)t * 8 + k] = p; }
        const int ps = tstart[64] * 256 + t; ltok[ps] = t; lgate[ps] = 1.f;
    }
    for (int e = c.bid; e < NE1; e += c.G) {
        const int n = e < 64 ? (int)__hip_atomic_load(cnt + e, __ATOMIC_RELAXED, __HIP_MEMORY_SCOPE_AGENT) : nrows; const int np = ((n + 255) >> 8) << 8;
        for (int j = n + c.tid; j < np; j += 512) { ltok[tstart[e] * 256 + j] = 0; lgate[tstart[e] * 256 + j] = 0.f; }
    }
}
__device__ __forceinline__ void ph_moe_reduce(const Ctx& c, int l, int q, int nrows) {
    LAS int* tstart = (LAS int*)(c.lds + LDS_MISC - 1024);
    moe_tstart(c, l, nrows, tstart);
    const int sbase = tstart[64] * 256;
    const bf16_t* pair = c.wsp<bf16_t>(WS_PAIR); const int* pos = c.wsp<int>(WS_POS);
    const float* mods = c.wsp<float>(WS_MODS) + (size_t)l * 9 * 6144;
    for (int m = c.gw; m < nrows; m += c.NGW) {
        const int j = m < TL ? m / SEQ : 8;
        float* xr = (m < TL ? c.p.out + (size_t)m * DM : c.wsp<float>(WS_XC) + (size_t)(m - TL) * DM) + q * 256 + 4 * c.lane;
        f32x4 s = {0.f, 0.f, 0.f, 0.f};
#pragma unroll
        for (int k = 0; k < 9; ++k) { const int p = k < 8 ? pos[(size_t)m * 8 + k] : sbase + m; const u32x2 w = *(const u32x2*)(pair + (size_t)p * 256 + 4 * c.lane);
            s[0] += __builtin_bit_cast(float, w.x << 16); s[1] += __builtin_bit_cast(float, w.x & 0xffff0000u); s[2] += __builtin_bit_cast(float, w.y << 16); s[3] += __builtin_bit_cast(float, w.y & 0xffff0000u); }
        const f32x4 g = *(const f32x4*)(mods + j * 6144 + 5 * 1024 + q * 256 + 4 * c.lane);
        *(f32x4*)xr = *(const f32x4*)xr + g * s;
    }
}
__device__ __forceinline__ void ph_final(const Ctx& c) {
    const float* fw = c.in(I_FNW);
    for (int m = c.gw; m < TL; m += c.NGW) {
        float* xr = c.p.out + (size_t)m * DM; f32x4 v[4]; float ss = 0.f;
#pragma unroll
        for (int j = 0; j < 4; ++j) { v[j] = ((const f32x4*)xr)[c.lane + 64 * j]; ss += (v[j][0] * v[j][0] + v[j][1] * v[j][1]) + (v[j][2] * v[j][2] + v[j][3] * v[j][3]); }
        const float rstd = rsqrtf(wave_sum(ss) * (1.f / DM) + EPS);
#pragma unroll
        for (int j = 0; j < 4; ++j) { const f32x4 w = *(const f32x4*)(fw + 4 * c.lane + 256 * j); ((f32x4*)xr)[c.lane + 64 * j] = v[j] * rstd * w; }
    }
}

enum { PH_PRE = 0, PH_B, PH_INP, PH_D, PH_E, PH_OUTP, PH_N2, PH_TOPK, PH_LISTS, PH_UP, PH_DOWN, PH_RED, PH_FINAL, PH_COUNT };

template <int PH> __device__ __forceinline__ void run_phase(const Ctx& c, int l, int q) {
    const int nrows_out = (l == 0) ? MT : TL;
    if constexpr (PH == PH_PRE) { ph_pre(c); }
    if constexpr (PH == PH_B) { ph_wprep(c, l); ph_norm1(c, l); }
    if constexpr (PH == PH_INP) {
        pg8::DenseSched<1024> S; S.init(c.wsp<void>(WS_HB), c.wsp<void>(WS_WIN), MT, NINP, c.G, c.bid);
        EpiInProj E{c.p.ws, c.wsp<f32x2>(WS_ROPE)};
        pg8::gemm_phase<1024>(c.lds, S, E);
    }
    if constexpr (PH == PH_D) { ph_gdn_prep(c, l); ph_s5_naive(c, l); ph_attn_naive(c, l); }
    if constexpr (PH == PH_E) { ph_gdn_naive(c, l); ph_s5_glu(c, l, nrows_out); }
    if constexpr (PH == PH_OUTP) {
        pg8::DenseSched<1024> S; S.init(c.wsp<void>(WS_HB), c.wsp<void>(WS_WOUT), nrows_out, 1024, c.G, c.bid);
        EpiResid E{l == 0 ? c.in(I_X) : c.p.out, l == 0 ? c.in(I_CTX) : c.wsp<float>(WS_XC), c.p.out, c.wsp<float>(WS_XC), c.wsp<float>(WS_MODS) + (size_t)l * 9 * 6144, 2};
        pg8::gemm_phase<1024>(c.lds, S, E);
    }
    if constexpr (PH == PH_N2) { ph_norm2(c, l, nrows_out); }
    if constexpr (PH == PH_TOPK) { ph_topk(c, l, nrows_out); }
    if constexpr (PH == PH_LISTS) { ph_lists(c, l, nrows_out); }
    if constexpr (PH == PH_UP) {
        LAS int* tstart = (LAS int*)(c.lds + LDS_MISC - 1024);
        const int ntiles = moe_tstart(c, l, nrows_out, tstart);
        pg8::MoeSched<1024, true> S; S.A = c.wsp<char>(WS_HB); S.Bt = c.wsp<char>(WS_W13); S.ltok = c.wsp<int>(WS_LTOK); S.tstart = tstart; S.ntiles = ntiles; S.nN = 2; S.nwg = ntiles * 2; S.G = c.G; S.c = c.bid;
        S.bstride_e = (size_t)512 * 1024 * 2; S.bcol0 = 0;
        EpiMoeUp E{c.wsp<bf16_t>(WS_HID), c.wsp<float>(WS_LGATE)};
        pg8::gemm_phase<1024>(c.lds, S, E);
    }
    if constexpr (PH == PH_DOWN) {
        LAS int* tstart = (LAS int*)(c.lds + LDS_MISC - 1024);
        const int ntiles = moe_tstart(c, l, nrows_out, tstart);
        pg8::MoeSched<256, false> S; S.A = c.wsp<char>(WS_HID); S.Bt = c.wsp<char>(WS_W2); S.ltok = nullptr; S.tstart = tstart; S.ntiles = ntiles; S.nN = 1; S.nwg = ntiles; S.G = c.G; S.c = c.bid;
        S.bstride_e = (size_t)1024 * 256 * 2; S.bcol0 = q * 256;
        EpiMoeDown E{c.wsp<bf16_t>(WS_PAIR)};
        pg8::gemm_phase<256>(c.lds, S, E);
    }
    if constexpr (PH == PH_RED) { ph_moe_reduce(c, l, q, nrows_out); }
    if constexpr (PH == PH_FINAL) { ph_final(c); }
}

__device__ __forceinline__ Ctx make_ctx(const Params& p, unsigned char* lds) {
    Ctx c; c.p = p; c.lds = (LAS unsigned char*)lds; c.tid = threadIdx.x; c.lane = c.tid & 63; c.wave = __builtin_amdgcn_readfirstlane(c.tid >> 6);
    c.G = gridDim.x; c.bid = blockIdx.x; c.gw = c.bid * 8 + c.wave; c.NGW = c.G * 8; return c;
}

template <int PH> __global__ void __launch_bounds__(512, 2) k_phase(Params p, int l, int q) {
    extern __shared__ __attribute__((aligned(16))) unsigned char lds[];
    const Ctx c = make_ctx(p, lds);
    run_phase<PH>(c, l, q);
}

#if ONE_LAUNCH
__global__ void __launch_bounds__(512, 2) k_mega(Params p) {
    extern __shared__ __attribute__((aligned(16))) unsigned char lds[];
    const Ctx c = make_ctx(p, lds);
    volatile LAS unsigned* misc = (volatile LAS unsigned*)(c.lds + LDS_MISC);
    if (c.tid < 4) misc[c.tid] = 0u;
    __syncthreads();
    XcdBarrier bar = xcd_barrier_post(c.wsp<unsigned>(WS_CTL) + CW_BAR, misc);
#define GB() xcd_barrier(bar)
    run_phase<PH_PRE>(c, 0, 0); GB();
#pragma unroll 1
    for (int l = 0; l < 2; ++l) {
        run_phase<PH_B>(c, l, 0); GB();
        run_phase<PH_INP>(c, l, 0); GB();
        run_phase<PH_D>(c, l, 0); GB();
        run_phase<PH_E>(c, l, 0); GB();
        run_phase<PH_OUTP>(c, l, 0); GB();
        run_phase<PH_N2>(c, l, 0); GB();
        run_phase<PH_TOPK>(c, l, 0); GB();
        run_phase<PH_LISTS>(c, l, 0); GB();
        run_phase<PH_UP>(c, l, 0); GB();
#pragma unroll 1
        for (int q = 0; q < 4; ++q) { run_phase<PH_DOWN>(c, l, q); GB(); run_phase<PH_RED>(c, l, q); GB(); }
    }
    run_phase<PH_FINAL>(c, 0, 0);
#undef GB
}
#endif


#if DBG_CHECK
constexpr int CW_ERR = 20000;
__device__ __forceinline__ float dot_bf16(const bf16_t* a, const bf16_t* b, int K) { float s = 0.f; for (int k = 0; k < K; ++k) s += bf2f(a[k]) * bf2f(b[k]); return s; }
__device__ __forceinline__ bool bad(float got, float ref) { return !(fabsf(got - ref) <= 0.02f * fabsf(ref) + 0.02f); }
template <int ID> __global__ void __launch_bounds__(512, 2) k_check(Params p, int l, int q) {
    unsigned* err = (unsigned*)(p.ws + WS_CTL) + CW_ERR;
    const bf16_t* HB = (const bf16_t*)(p.ws + WS_HB);
    const long gtid = (long)blockIdx.x * 512 + threadIdx.x, gstride = (long)gridDim.x * 512;
    if (ID == 0) {
        const bf16_t* W = (const bf16_t*)(p.ws + WS_WIN);
        for (long idx = gtid; idx < (long)MT * 4; idx += gstride) { const int r = (int)(idx >> 2), sidx = (int)(idx & 3); const int col = 1024 + (int)(((long)sidx * 461 + (long)r * 7) % 1808);
            const float ref = dot_bf16(HB + (size_t)r * DM, W + (size_t)col * DM, DM); float got;
            if (col < 1536) got = bf2f(((const bf16_t*)(p.ws + WS_V))[(size_t)r * 512 + col - 1024]);
            else if (col < 1792) got = bf2f(((const bf16_t*)(p.ws + WS_U))[(size_t)r * 256 + col - 1536]);
            else if (col < 2560) got = bf2f(((const bf16_t*)(p.ws + WS_G))[(size_t)r * 768 + col - 1792]);
            else if (col < 2816) got = bf2f(((const bf16_t*)(p.ws + WS_Z))[(size_t)r * 256 + col - 2560]);
            else got = ((const float*)(p.ws + WS_BA))[(size_t)r * 16 + col - 2816];
            if (bad(got, ref)) atomicAdd(err + 0, 1u); }
    }
    if (ID == 1) {
        const bf16_t* W = (const bf16_t*)(p.ws + WS_WOUT); const float* mods = (const float*)(p.ws + WS_MODS);
        for (long idx = gtid; idx < (long)MT * 4; idx += gstride) { const int r = (int)(idx >> 2), sidx = (int)(idx & 3); const int col = (int)(((long)sidx * 261 + (long)r * 5) % 1024);
            const float d = dot_bf16(HB + (size_t)r * DM, W + (size_t)col * DM, DM);
            const float xin = r < TL ? p.in[I_X][(size_t)r * DM + col] : p.in[I_CTX][(size_t)(r - TL) * DM + col];
            const int j = r < TL ? r / SEQ : 8; const float ref = xin + mods[j * 6144 + 2 * 1024 + col] * d;
            const float got = r < TL ? p.out[(size_t)r * DM + col] : ((const float*)(p.ws + WS_XC))[(size_t)(r - TL) * DM + col];
            if (bad(got, ref)) atomicAdd(err + 1, 1u); }
    }
    if (ID == 2 || ID == 3) {
        const unsigned* cnt = (const unsigned*)(p.ws + WS_CTL) + CW_CNT + l * 128; const int nrows = l == 0 ? MT : TL;
        const int* ltok = (const int*)(p.ws + WS_LTOK); const float* lgate = (const float*)(p.ws + WS_LGATE);
        const bf16_t* HID = (const bf16_t*)(p.ws + WS_HID);
        int tst = 0;
        for (int e = 0; e < NE1; ++e) { const int n = e < 64 ? (int)cnt[e] : nrows; const int nt = (n + 255) >> 8;
            for (long idx = gtid; idx < (long)n * 2; idx += gstride) { const int jrow = (int)(idx >> 1), sidx = (int)(idx & 1); const int pp = tst * 256 + jrow; const int c = (jrow * 3 + sidx * 131) & 255;
                if (ID == 2) { const int tok = ltok[pp]; const bf16_t* W = (const bf16_t*)(p.ws + WS_W13) + (size_t)e * 512 * 1024;
                    const int r1 = (c >> 7) * 256 + (c & 127);
                    const float a = dot_bf16(HB + (size_t)tok * DM, W + (size_t)r1 * DM, DM), b = dot_bf16(HB + (size_t)tok * DM, W + (size_t)(r1 + 128) * DM, DM);
                    const float ref = siluf(a) * b * lgate[pp]; const float got = bf2f(HID[(size_t)pp * 256 + c]);
                    if (bad(got, ref)) atomicAdd(err + 2, 1u); }
                else { const bf16_t* W = (const bf16_t*)(p.ws + WS_W2) + (size_t)e * 1024 * 256;
                    const float ref = dot_bf16(HID + (size_t)pp * 256, W + (size_t)(q * 256 + c) * 256, 256); const float got = bf2f(((const bf16_t*)(p.ws + WS_PAIR))[(size_t)pp * 256 + c]);
                    if (bad(got, ref)) atomicAdd(err + 3, 1u); } }
            tst += nt; }
    }

    if (ID == 4) {
        const unsigned* cnt = (const unsigned*)(p.ws + WS_CTL) + CW_CNT + l * 128; const int nrows = l == 0 ? MT : TL;
        const int* ltok = (const int*)(p.ws + WS_LTOK); const float* lgate = (const float*)(p.ws + WS_LGATE);
        const int* tki = (const int*)(p.ws + WS_TKI); const float* tkw = (const float*)(p.ws + WS_TKW); const int* pos = (const int*)(p.ws + WS_POS);
        int tsv[NE1 + 1]; { int a = 0; for (int e = 0; e < NE1; ++e) { tsv[e] = a; const int n = e < 64 ? (int)cnt[e] : nrows; a += (n + 255) >> 8; } tsv[NE1] = a; }
        unsigned tot = 0; for (int e = 0; e < 64; ++e) tot += cnt[e];
        if (gtid == 0 && tot != (unsigned)nrows * 8u) atomicAdd(err + 1, 1u);

        for (long t = gtid; t < nrows; t += gstride) {
            unsigned long long seen = 0ull; unsigned gm = 0u; float ws_ = 0.f;
            for (int k = 0; k < 8; ++k) { const int e = tki[t * 8 + k], pp = pos[t * 8 + k];
                int ts = 0; for (int x = 0; x < 64; ++x) if (x == e) ts = tsv[x];
                if (e < 0 || e > 63 || ((seen >> e) & 1ull)) atomicAdd(err + 2, 1u);
                seen |= 1ull << e; gm |= 1u << (e >> 3); ws_ += tkw[t * 8 + k];
                if (ltok[pp] != (int)t || lgate[pp] != tkw[t * 8 + k] || pp < ts * 256 || pp >= ts * 256 + (int)cnt[e]) atomicAdd(err + 0, 1u); }
            if (__builtin_popcount(gm) > 4 || fabsf(ws_ - 2.5f) > 1e-3f) atomicAdd(err + 2, 1u);
        }
    }

    if (ID == 5) {
        const float* Wf = p.in[I_WIN] + (size_t)l * 1024 * NIN;
        for (long idx = gtid; idx < (long)MT * 2; idx += gstride) { const int r = (int)(idx >> 1), isk = (int)(idx & 1); const int sc_ = (int)(((long)r * 13 + isk * 7) % 512);
            const int g32 = sc_ >> 5, r32 = sc_ & 31, qq = r32 >> 3, nn = (r32 >> 2) & 1, jj = r32 & 3, f = 4 * qq + jj;
            const int c1 = isk * 512 + g32 * 32 + f, c2 = c1 + 16;
            float a = 0.f, b = 0.f; for (int k = 0; k < DM; ++k) { const float hv = bf2f(HB[(size_t)r * DM + k]); a += hv * bf2f((bf16_t)f2bf(Wf[(size_t)k * NIN + c1])); b += hv * bf2f((bf16_t)f2bf(Wf[(size_t)k * NIN + c2])); }
            float ref;
            if (r < TL) { const int t = r & (SEQ - 1); const int ps = (g32 & 1) ? (t & 63) : (t >> 6); const double ang = (double)((float)ps * (float)pow(10000.0, -(double)f / 16.0)); const float cs = (float)cos(ang), sn = (float)sin(ang);
                ref = nn == 0 ? a * cs - b * sn : a * sn + b * cs; } else ref = nn == 0 ? a : b;
            if (!isk) ref *= 0.125f;
            const float got = bf2f(((const bf16_t*)(p.ws + (isk ? WS_K : WS_Q)))[(size_t)r * 512 + sc_]);
            if (bad(got, ref)) atomicAdd(err + isk, 1u); }
    }
    if (ID == 6) {
        const bf16_t* WIN = (const bf16_t*)(p.ws + WS_WIN); const float* Wf = p.in[I_WIN] + (size_t)l * 1024 * NIN;
        for (long idx = gtid; idx < (long)NINP * 1024; idx += gstride) { const int n = (int)(idx >> 10), k = (int)(idx & 1023);
            int col = n; if (n < 1024) col = (n & ~31) + dimperm(n & 31);
            const bf16_t ref = n < NIN ? (bf16_t)f2bf(Wf[(size_t)k * NIN + col]) : (bf16_t)0;
            if (WIN[idx] != ref) atomicAdd(err + 2, 1u); }
        const bf16_t* WO = (const bf16_t*)(p.ws + WS_WOUT); const float* Wof = p.in[I_WOUT] + (size_t)l * 1024 * 1024;
        for (long idx = gtid; idx < (long)1024 * 1024; idx += gstride) { const int n = (int)(idx >> 10), k = (int)(idx & 1023); if (WO[idx] != (bf16_t)f2bf(Wof[(size_t)k * 1024 + n])) atomicAdd(err + 2, 1u); }
        const bf16_t* W13 = (const bf16_t*)(p.ws + WS_W13); const bf16_t* W2 = (const bf16_t*)(p.ws + WS_W2);
        for (long idx = gtid; idx < (long)NE1 * 512 * 1024; idx += gstride) { const int e = (int)(idx / (512 * 1024)), rr = (int)((idx >> 10) & 511), k = (int)(idx & 1023);
            const int pn = rr >> 8, is3 = (rr >> 7) & 1, cc = pn * 128 + (rr & 127);
            const float* src = e < 64 ? p.in[is3 ? I_W3 : I_W1] + ((size_t)l * 64 + e) * 1024 * 256 : p.in[is3 ? I_WS3 : I_WS1] + (size_t)l * 1024 * 256;
            if (W13[idx] != (bf16_t)f2bf(src[(size_t)k * 256 + cc])) atomicAdd(err + 2, 1u); }
        for (long idx = gtid; idx < (long)NE1 * 1024 * 256; idx += gstride) { const int e = (int)(idx / (1024 * 256)), n = (int)((idx >> 8) & 1023), k = (int)(idx & 255);
            const float* src = e < 64 ? p.in[I_W2] + ((size_t)l * 64 + e) * 256 * 1024 : p.in[I_WS2] + (size_t)l * 256 * 1024;
            if (W2[idx] != (bf16_t)f2bf(src[(size_t)k * 1024 + n])) atomicAdd(err + 2, 1u); }
    }

    if (ID == 7) {
        const float* mods = (const float*)(p.ws + WS_MODS);
        for (long idx = gtid; idx < (long)2 * 9 * 6144; idx += gstride) { const int n = (int)(idx % 6144), j = (int)((idx / 6144) % 9), ll = (int)(idx / (9 * 6144));
            double acc = 0.0; for (int k = 0; k < 1024; ++k) { const float v = j < 8 ? p.in[I_C][j * 1024 + k] : p.in[I_CCTX][k]; acc += (double)(v / (1.f + expf(-v))) * (double)p.in[I_WMOD][((size_t)ll * 1024 + k) * 6144 + n]; }
            const float ref = (float)acc + p.in[I_BMOD][ll * 6144 + n];
            if (!(fabsf(mods[idx] - ref) <= 1e-3f * fabsf(ref) + 1e-4f)) atomicAdd(err + 0, 1u); }
    }
    if (ID == 8) {
        const float* mods = (const float*)(p.ws + WS_MODS) + (size_t)l * 9 * 6144;
        for (long r = gtid; r < MT; r += gstride) {
            const float* xr = r < TL ? (l == 0 ? p.in[I_X] : p.out) + (size_t)r * DM : (l == 0 ? p.in[I_CTX] : (const float*)(p.ws + WS_XC)) + (size_t)(r - TL) * DM;
            double ss = 0.0; for (int k = 0; k < DM; ++k) ss += (double)xr[k] * xr[k];
            const float rstd = (float)(1.0 / sqrt(ss / DM + 1e-6)); const int j = r < TL ? (int)(r / SEQ) : 8;
            for (int s2 = 0; s2 < 4; ++s2) { const int col = (int)((r * 3 + s2 * 257) & 1023);
                const float ref = xr[col] * rstd * p.in[I_N1W][l * DM + col] * (1.f + mods[j * 6144 + 1024 + col]) + mods[j * 6144 + col];
                if (bad(bf2f(HB[(size_t)r * DM + col]), ref)) atomicAdd(err + 1, 1u); } }
    }
    if (ID == 10) {
        const float* mods = (const float*)(p.ws + WS_MODS) + (size_t)l * 9 * 6144; const int nrows = l == 0 ? MT : TL; const float* lg = (const float*)(p.ws + WS_LOG);
        for (long r = gtid; r < nrows; r += gstride) {
            const float* xr = r < TL ? p.out + (size_t)r * DM : (const float*)(p.ws + WS_XC) + (size_t)(r - TL) * DM;
            double ss = 0.0; for (int k = 0; k < DM; ++k) ss += (double)xr[k] * xr[k];
            const float rstd = (float)(1.0 / sqrt(ss / DM + 1e-6)); const int j = r < TL ? (int)(r / SEQ) : 8;
            for (int s2 = 0; s2 < 4; ++s2) { const int col = (int)((r * 3 + s2 * 257) & 1023);
                const float ref = xr[col] * rstd * p.in[I_N2W][l * DM + col] * (1.f + mods[j * 6144 + 4 * 1024 + col]) + mods[j * 6144 + 3 * 1024 + col];
                if (bad(bf2f(HB[(size_t)r * DM + col]), ref)) atomicAdd(err + 3, 1u); }
            const int e = (int)(r & 63); float d = 0.f; for (int k = 0; k < DM; ++k) d += bf2f(HB[(size_t)r * DM + k]) * p.in[I_WR][((size_t)l * 1024 + k) * 64 + e];
            if (!(fabsf(lg[(size_t)r * 64 + e] - d) <= 0.03f)) atomicAdd(err + 2, 1u); }
    }
    if (ID == 9) {
        int base = 0;
        for (int i = 0; i < 4; ++i) { const int nr = 1024 << i; if (err[i] != 0u) { for (long idx = gtid; idx < (long)nr * DM; idx += gstride) p.out[(size_t)base * DM + idx] = 0.f; } base += nr; }
    }
}
#endif

template <int PH> static void launch_phase(const Params& p, int l, int q, int grid, hipStream_t stream) {
    static bool attr = false;
    if (!attr) { (void)hipFuncSetAttribute((const void*)k_phase<PH>, hipFuncAttributeMaxDynamicSharedMemorySize, LDS_BYTES); attr = true; }
    hipLaunchKernelGGL(k_phase<PH>, dim3(grid), dim3(512), LDS_BYTES, stream, p, l, q);
}

extern "C" void kernel_launch(void* const* d_in, const int* in_sizes, int n_in, void* d_out, int out_size, void* d_ws, size_t ws_size, hipStream_t stream) {
    static int grid = 0;
    if (grid == 0) {
        if (n_in != 35 || out_size != TL * DM || ws_size < WS_END) { fprintf(stderr, "kernel_launch: unexpected shapes n_in %d out %d ws %zu (need %zu)\n", n_in, out_size, ws_size, (size_t)WS_END); grid = -1; return; }
        int dev = 0, cus = 0;
        if (hipGetDevice(&dev) != hipSuccess || hipDeviceGetAttribute(&cus, hipDeviceAttributeMultiprocessorCount, dev) != hipSuccess) { grid = -1; return; }
#if ONE_LAUNCH
        (void)hipFuncSetAttribute((const void*)k_mega, hipFuncAttributeMaxDynamicSharedMemorySize, LDS_BYTES);
#endif
        grid = cus;
    }
    if (grid < 0) return;
    (void)hipMemsetAsync((char*)d_ws + WS_CTL, 0, CTL_BYTES, stream);
    Params p{};
    for (int i = 0; i < 35; ++i) p.in[i] = (const float*)d_in[i];
    p.out = (float*)d_out; p.ws = (unsigned char*)d_ws;
#if ONE_LAUNCH
    hipLaunchKernelGGL(k_mega, dim3(grid), dim3(512), LDS_BYTES, stream, p);
#else
    launch_phase<PH_PRE>(p, 0, 0, grid, stream);
    for (int l = 0; l < 2; ++l) {
        launch_phase<PH_B>(p, l, 0, grid, stream);
        launch_phase<PH_INP>(p, l, 0, grid, stream);
        launch_phase<PH_D>(p, l, 0, grid, stream);
        launch_phase<PH_E>(p, l, 0, grid, stream);
        launch_phase<PH_OUTP>(p, l, 0, grid, stream);
        launch_phase<PH_N2>(p, l, 0, grid, stream);
        launch_phase<PH_TOPK>(p, l, 0, grid, stream);
        launch_phase<PH_LISTS>(p, l, 0, grid, stream);
        launch_phase<PH_UP>(p, l, 0, grid, stream);
        for (int q = 0; q < 4; ++q) { launch_phase<PH_DOWN>(p, l, q, grid, stream); launch_phase<PH_RED>(p, l, q, grid, stream); }
    }
    launch_phase<PH_FINAL>(p, 0, 0, grid, stream);
#endif
}
```

```cpp
#include <hip/hip_runtime.h>
#include <cstdio>
#include <cstdint>

#define ABL_ZERO_S5 0
#define ABL_ZERO_GDN 0
#define ABL_ZERO_ATT 0
#define ABL_NOCTXKEYS 0
#define ABL_CTXORIG 0
#define DBG_CHECK 0
#ifndef DUP_SUB
#define DUP_SUB 0
#endif
#ifndef ATT_X
#define ATT_X 0
#endif
#ifndef DUP_MASK
#define DUP_MASK 0
#endif
#ifndef ONE_LAUNCH
#define ONE_LAUNCH 1
#endif

#define LAS __attribute__((address_space(3)))
typedef unsigned short bf16_t;
typedef short bf16x8 __attribute__((ext_vector_type(8)));
typedef float f32x4 __attribute__((ext_vector_type(4)));
typedef float f32x2 __attribute__((ext_vector_type(2)));
typedef unsigned u32x4 __attribute__((ext_vector_type(4)));
typedef unsigned u32x2 __attribute__((ext_vector_type(2)));

constexpr int NB = 8, SEQ = 4096, DM = 1024, NCTX = 256;
constexpr int TL = NB * SEQ, TC = NB * NCTX, MT = TL + TC;
constexpr int NIN = 2832, NINP = 3072;
constexpr int NE1 = 65;
constexpr int PAIRS_PAD = 329728;
constexpr float EPS = 1e-6f;

constexpr size_t MiB = 1u << 20;
constexpr size_t WS_CTL = 0, CTL_BYTES = 1 * MiB;
constexpr size_t WS_MODS = 1 * MiB;
constexpr size_t WS_ROPE = 1 * MiB + 512 * 1024;
constexpr size_t WS_WIN = 2 * MiB;
constexpr size_t WS_WOUT = 8 * MiB;
constexpr size_t WS_W2 = 10 * MiB;
constexpr size_t WS_W13 = 43 * MiB;
constexpr size_t WS_HB = 108 * MiB;
constexpr size_t WS_XC = 365 * MiB;
constexpr size_t WS_WR2 = 8 * MiB;
constexpr size_t WS_TKI = 2 * MiB;
constexpr size_t WS_TKW = WS_TKI + 1152 * 1024;
constexpr size_t WS_POS = WS_TKW + 1152 * 1024;
constexpr size_t WS_LTOK = WS_POS + 1152 * 1024;
constexpr size_t WS_LGATE = WS_LTOK + 1344 * 1024;
constexpr size_t WS_PROJ = 204 * MiB;
constexpr size_t WS_Q = WS_PROJ, WS_K = WS_Q + 34 * MiB, WS_V = WS_K + 34 * MiB, WS_U = WS_V + 34 * MiB, WS_G = WS_U + 17 * MiB,
                 WS_Z = WS_G + 51 * MiB, WS_BA = WS_Z + 17 * MiB;
constexpr size_t WS_LOG = WS_PROJ;
constexpr size_t WS_HID = WS_PROJ;
constexpr size_t WS_MIX = 394 * MiB;
constexpr size_t WS_LO = WS_MIX;
constexpr size_t WS_S5A = WS_MIX;
constexpr size_t WS_S5L = WS_S5A + 30 * MiB;
constexpr size_t WS_S5M = WS_S5L + 20 * MiB;
constexpr size_t WS_S5F = WS_S5M + 12 * MiB;
constexpr size_t WS_S5G = WS_S5F + 4 * MiB;
constexpr size_t WS_REC1 = WS_S5G + 1 * MiB;
constexpr size_t WS_GL = WS_REC1 + 85 * MiB;
constexpr size_t WS_GO = WS_GL + 1 * MiB;
constexpr size_t WS_REC0 = WS_W2;
constexpr size_t WS_ZS = WS_U;
constexpr size_t REC_BYTES = 40960; constexpr int NGU = NB * 4 * 68;
static_assert((size_t)NGU * REC_BYTES <= 97 * MiB, "rec");
constexpr size_t WS_PAIRA = WS_W13;
constexpr size_t WS_PAIRB = 373 * MiB;
constexpr int PAIR_RA = 164864;
constexpr size_t WS_S5W1 = WS_GO + 34 * MiB;
constexpr size_t WS_END = WS_S5W1 + 17 * MiB;
constexpr int S5R = 1280, S5RV = 1088;
static_assert(WS_BA + (size_t)MT * 16 * 4 <= WS_MIX, "proj region");
static_assert(WS_HID + (size_t)PAIRS_PAD * 512 <= WS_MIX, "hid region");
static_assert(WS_PAIRA + (size_t)PAIR_RA * 1024 <= WS_HID && WS_PAIRB + (size_t)(PAIRS_PAD - PAIR_RA) * 1024 <= WS_END && WS_XC + 8 * MiB <= WS_PAIRB && WS_LGATE + 1344 * 1024 <= WS_WR2 && WS_HID + (size_t)PAIRS_PAD * 512 <= WS_XC, "pair region");
static_assert(WS_END <= 600 * MiB && WS_S5F == WS_S5M + 12 * MiB && WS_S5G == WS_S5F + 4 * MiB, "ws");
__host__ __device__ constexpr size_t ws_s5m(int l) { return l == 0 ? WS_S5M : WS_S5W1; }
__host__ __device__ constexpr size_t ws_s5f(int l) { return ws_s5m(l) + 12 * MiB; }
__host__ __device__ constexpr size_t ws_s5g(int l) { return ws_s5m(l) + 16 * MiB; }
static_assert(WS_REC1 + 85 * MiB <= WS_GL && WS_W2 + 33 * MiB <= WS_W13 && WS_W13 + 65 * MiB <= WS_HB, "mix");

constexpr int CW_BAR = 4096;
constexpr int CW_CNT = 16384;
constexpr int CW_FILL = 16384 + 256;
constexpr int CW_ATTQ = 16384 + 512;

constexpr int LDS_BYTES = 147456;
constexpr int LDS_MISC = 144 * 1024 - 256;

__device__ __forceinline__ float wave_sum(float v) {
#pragma unroll
    for (int o = 32; o > 0; o >>= 1) v += __shfl_xor(v, o);
    return v;
}
__device__ __forceinline__ unsigned f2bf(float f) { unsigned u = __builtin_bit_cast(unsigned, f); return (u + 0x7fffu + ((u >> 16) & 1u)) >> 16; }
__device__ __forceinline__ unsigned pk2(float lo, float hi) { return f2bf(lo) | (f2bf(hi) << 16); }
__device__ __forceinline__ float bf2f(unsigned short b) { return __builtin_bit_cast(float, ((unsigned)b) << 16); }
__device__ __forceinline__ float siluf(float x) { return x / (1.f + __expf(-x)); }
__device__ __forceinline__ float sigmf(float x) { return 1.f / (1.f + __expf(-x)); }
__device__ __forceinline__ int dimperm(int r) { return 16 * ((r >> 2) & 1) + 4 * (r >> 3) + (r & 3); }
#define LDS_WAIT() asm volatile("s_waitcnt lgkmcnt(0)" ::: "memory")
__device__ __forceinline__ float ozero() { float z; asm volatile("v_mov_b32 %0, 0" : "=v"(z)); return z; }
__device__ __forceinline__ f32x4 ozero4() { const float z = ozero(); return (f32x4){z, z, z, z}; }
typedef float f32x16_t __attribute__((ext_vector_type(16)));
__device__ __forceinline__ f32x16_t ozero16() { const float z = ozero(); return (f32x16_t){z, z, z, z, z, z, z, z, z, z, z, z, z, z, z, z}; }

struct Params {
    const float* in[35];
    float* out;
    unsigned char* ws;
};
enum { I_X = 0, I_C, I_CTX, I_CCTX, I_N1W, I_N2W, I_WMOD, I_BMOD, I_WIN, I_WOUT, I_DALAM, I_DASUB, I_S5LRE, I_S5LIM, I_S5STEP, I_S5BRE, I_S5BIM,
       I_S5CRE, I_S5CIM, I_S5D, I_S5WGLU, I_S5BGLU, I_GCONV, I_GALOG, I_GDT, I_GNORM, I_WR, I_RB, I_W1, I_W3, I_W2, I_WS1, I_WS3, I_WS2, I_FNW };

#define XB_TMO      128
#define XB_XCNT(j)  (256  + 64 * (j))
#define XB_XSUB(j)  (1280 + 64 * (j))
#define XB_XGEN(j)  (2304 + 64 * (j))
#define XB_TOP      3328
#define XB_TOPGEN   3392
#define XCD_BAR_WORDS 3456
#define XB_SPIN_CAP (1u << 22)
__device__ __forceinline__ unsigned xb_ld(unsigned* p)              { return __hip_atomic_load(p, __ATOMIC_RELAXED, __HIP_MEMORY_SCOPE_AGENT); }
__device__ __forceinline__ unsigned xb_add(unsigned* p, unsigned v) { return __hip_atomic_fetch_add(p, v, __ATOMIC_RELAXED, __HIP_MEMORY_SCOPE_AGENT); }
__device__ __forceinline__ unsigned xb_xcc_id() { return (unsigned)__builtin_amdgcn_s_getreg((3 << 11) | 20) & 0xFu; }
#define XB_SPIN(cond, bar) do { unsigned _sp = 0; while (cond) { __builtin_amdgcn_s_sleep(1); \
    if ((++_sp & 255u) == 0u) { if (xb_ld(&(bar)[XB_TMO])) break; if (_sp > XB_SPIN_CAP) { atomicAdd(&(bar)[XB_TMO], 1u); break; } } } } while (0)
struct XcdBarrier { unsigned* bar; unsigned x; volatile LAS unsigned* st; };
__device__ __forceinline__ XcdBarrier xcd_barrier_post(unsigned* bar, volatile LAS unsigned* st) {
    XcdBarrier b; b.bar = bar; b.x = xb_xcc_id(); b.st = st;
    if (threadIdx.x == 0) (void)xb_add(&bar[XB_XCNT(b.x)], 1u);
    return b;
}
__device__ __forceinline__ void xcd_barrier_complete(unsigned* bar, unsigned x, unsigned& nloc, unsigned& nx) {
    const unsigned G = gridDim.x * gridDim.y * gridDim.z;
    unsigned sum, cnt, mine, sp = 0u;
    for (;;) {
        sum = 0u; cnt = 0u; mine = 0u;
#pragma unroll
        for (unsigned j = 0; j < 16; ++j) { const unsigned c = xb_ld(&bar[XB_XCNT(j)]); sum += c; cnt += (c > 0u) ? 1u : 0u; mine = (j == x) ? c : mine; }
        if (sum == G) break;
        __builtin_amdgcn_s_sleep(1);
        if ((++sp & 255u) == 0u) { if (xb_ld(&bar[XB_TMO])) break; if (sp > XB_SPIN_CAP) { atomicAdd(&bar[XB_TMO], 1u); break; } }
    }
    nloc = mine > 0u ? mine : 1u; nx = cnt > 0u ? cnt : 1u;
}
__device__ __forceinline__ void xcd_barrier(const XcdBarrier& b) {
    asm volatile("s_waitcnt vmcnt(0)" ::: "memory");
    __syncthreads();
    if (threadIdx.x == 0) {
        unsigned* bar = b.bar; asm volatile("" : "+s"(bar)); unsigned bx_ = __builtin_amdgcn_readfirstlane(b.x); asm volatile("" : "+s"(bx_));
        __builtin_amdgcn_s_waitcnt(0);
        unsigned nloc = b.st[0], nx = b.st[1];
        if (nloc == 0u) { xcd_barrier_complete(bar, bx_, nloc, nx); b.st[0] = nloc; b.st[1] = nx; }
        const unsigned old = xb_add(&bar[XB_XSUB(bx_)], 1u);
        const unsigned gen = old / nloc;
        if (old + 1u == (gen + 1u) * nloc) {
            __builtin_amdgcn_fence(__ATOMIC_RELEASE, "agent");
            asm volatile("s_waitcnt vmcnt(0)" ::: "memory");
            const unsigned og = xb_add(&bar[XB_TOP], 1u);
            const unsigned tg = og / nx;
            if (og + 1u == (tg + 1u) * nx) xb_add(&bar[XB_TOPGEN], 1u);
            else XB_SPIN(xb_ld(&bar[XB_TOPGEN]) == tg, bar);
            __builtin_amdgcn_fence(__ATOMIC_ACQUIRE, "agent");
            xb_add(&bar[XB_XGEN(bx_)], 1u);
            asm volatile("s_waitcnt vmcnt(0)" ::: "memory");
        } else {
            XB_SPIN(xb_ld(&bar[XB_XGEN(bx_)]) == gen, bar);
            __builtin_amdgcn_fence(__ATOMIC_ACQUIRE, "agent");
            asm volatile("s_waitcnt vmcnt(0)" ::: "memory");
        }
    }
    __syncthreads();
}

namespace pg8 {
constexpr int BM = 256, BK = 64, HALF = 128, HTB = HALF * BK * 2, STAGE_BYTES = 8 * HTB, NXCD = 8, WGM = 8;
__device__ __forceinline__ int lds_byte(int r, int c) { const int st = (r >> 4) * 2 + (c >> 5), rr = r & 15, cc = c & 31, ob = rr * 64 + cc * 2; return st * 1024 + (ob ^ (((ob >> 9) & 1) << 5)); }
__device__ __forceinline__ void stage_rc(int b, int& R, int& C) { const int st = b / 1024, sb = b % 1024, swz = sb ^ (((sb >> 9) & 1) << 5); R = (st >> 1) * 16 + swz / 64; C = (st & 1) * 32 + (swz % 64) / 2; }
__device__ __forceinline__ int perm32(int rho) { const int n = rho >> 4, i = rho & 15; return 8 * (i >> 2) + 4 * n + (i & 3); }
__device__ __forceinline__ unsigned cvt_pk_bf16(float lo, float hi) { unsigned r; asm volatile("v_cvt_pk_bf16_f32 %0, %1, %2" : "=v"(r) : "v"(lo), "v"(hi)); return r; }

struct Unit { int pm, pn, e, row0; };

__device__ __forceinline__ int xcd_remap(int wgid, int nwg) { const int q = nwg / NXCD, r = nwg % NXCD, xcd = wgid % NXCD, off = wgid / NXCD; return (xcd < r ? xcd * (q + 1) : r * (q + 1) + (xcd - r) * q) + off; }

template <int K, class Epi, class Sched, bool ALIGN_EPI = true, bool SP2 = true>
__device__ __forceinline__ void gemm_phase(LAS unsigned char* lds, const Sched& S, const Epi& E) {
    int tid = threadIdx.x; asm volatile("" : "+v"(tid));
    const int wid = __builtin_amdgcn_readfirstlane(tid >> 6), lane = tid & 63, wr = wid >> 2, wc = wid & 3, fr = lane & 15, fq = lane >> 4;
    constexpr int nt = K / BK;
    unsigned voffB[2];
#pragma unroll
    for (int i = 0; i < 2; ++i) { int R, C; stage_rc(tid * 16 + i * 8192, R, C); const int Rb = Epi::PERM ? ((R & ~31) + perm32(R & 31)) : R; voffB[i] = (unsigned)(Rb * K + C) * 2u; }
    constexpr size_t kstep = (size_t)(BK * 2);
    constexpr size_t hstep = (size_t)HALF * K * 2;
    const unsigned ldsw = (unsigned)wid * 1024u;
    const int aoff = lds_byte(wr * 64 + fr, fq * 8), boff = lds_byte(wc * 32 + fr, fq * 8);
#define PG8_SA(b, h) (((b) * 2 + (h)) * HTB)
#define PG8_SB(b, h) ((4 + (b) * 2 + (h)) * HTB)
#define PG8_STAGE2(bufoff, gbase, v0, v1) do { \
        __builtin_amdgcn_global_load_lds((const unsigned*)((const char*)(gbase) + (v0)), (LAS unsigned*)(lds + (bufoff) + ldsw), 16, 0, 0); \
        __builtin_amdgcn_global_load_lds((const unsigned*)((const char*)(gbase) + (v1)), (LAS unsigned*)(lds + (bufoff) + ldsw + 8192), 16, 0, 0); } while (0)
#define PG8_STAGEB(bufoff, gbase) PG8_STAGE2(bufoff, gbase, voffB[0], voffB[1])
#define PG8_LDA(dst, b, h) do { _Pragma("unroll") for (int m = 0; m < 4; ++m) _Pragma("unroll") for (int k = 0; k < 2; ++k) dst[m][k] = *(const LAS bf16x8*)(lds + PG8_SA(b, h) + aoff + m * 2048 + k * 1024); } while (0)
#define PG8_LDB(dst, b, h) do { _Pragma("unroll") for (int n = 0; n < 2; ++n) _Pragma("unroll") for (int k = 0; k < 2; ++k) dst[n][k] = *(const LAS bf16x8*)(lds + PG8_SB(b, h) + boff + n * 2048 + k * 1024); } while (0)
#define PG8_MMA(ai, bj, At, Bt) do { __builtin_amdgcn_s_setprio(1); _Pragma("unroll") for (int m = 0; m < 4; ++m) _Pragma("unroll") for (int n = 0; n < 2; ++n) _Pragma("unroll") for (int k = 0; k < 2; ++k) \
        acc[ai][bj][m][n] = __builtin_amdgcn_mfma_f32_16x16x32_bf16(Bt[n][k], At[m][k], acc[ai][bj][m][n], 0, 0, 0); __builtin_amdgcn_s_setprio(0); } while (0)
#define PG8_WAIT_V(n) asm volatile("s_waitcnt vmcnt(" #n ")" ::: "memory")
#define PG8_WAIT_L(n) asm volatile("s_waitcnt lgkmcnt(" #n ")" ::: "memory")
#define PG8_BAR __builtin_amdgcn_s_barrier()
#define PG8_SCHED __builtin_amdgcn_sched_barrier(0)
    Unit cur, nxt; int ui = 0;
    if (!S.next(0, cur)) return;
    f32x4 acc[2][2][4][2];
    float zero_ = 0.f; asm volatile("" : "+v"(zero_));
#pragma unroll
    for (int a = 0; a < 2; ++a)
#pragma unroll
        for (int b = 0; b < 2; ++b)
#pragma unroll
            for (int m = 0; m < 4; ++m)
#pragma unroll
                for (int n = 0; n < 2; ++n) acc[a][b][m][n] = (f32x4){zero_, zero_, zero_, zero_};
    bf16x8 At[4][2], B0[2][2], B1[2][2];
    unsigned vA[2][2], nvA[2][2];
    S.a_voff(cur, tid, vA);
    const char* cA = S.a_base(cur); const char* cB = S.b_base(cur);
    if constexpr (SP2) {
        PG8_STAGEB(PG8_SB(0, 0), cB); PG8_STAGEB(PG8_SB(0, 1), cB + hstep); PG8_STAGE2(PG8_SA(0, 0), cA, vA[0][0], vA[0][1]); PG8_STAGE2(PG8_SA(0, 1), cA, vA[1][0], vA[1][1]);
        if (wr == 1) PG8_BAR;
        PG8_WAIT_V(2); PG8_BAR;
        PG8_STAGEB(PG8_SB(1, 0), cB + kstep); PG8_STAGE2(PG8_SA(1, 0), cA + kstep, vA[0][0], vA[0][1]); PG8_STAGEB(PG8_SB(1, 1), cB + hstep + kstep);
        PG8_WAIT_V(6); PG8_BAR;
    } else {
        PG8_STAGEB(PG8_SB(0, 0), cB); PG8_STAGE2(PG8_SA(0, 0), cA, vA[0][0], vA[0][1]); PG8_STAGEB(PG8_SB(0, 1), cB + hstep); PG8_STAGE2(PG8_SA(0, 1), cA, vA[1][0], vA[1][1]);
        if (wr == 1) PG8_BAR;
        PG8_WAIT_V(4); PG8_BAR;
        PG8_STAGEB(PG8_SB(1, 0), cB + kstep); PG8_STAGE2(PG8_SA(1, 0), cA + kstep, vA[0][0], vA[0][1]); PG8_STAGEB(PG8_SB(1, 1), cB + hstep + kstep);
        PG8_WAIT_V(6); PG8_BAR;
    }
    for (;;) {
        const bool has_next = S.next(ui + 1, nxt);
        const char* nA = cA; const char* nB = cB;
#pragma unroll
        for (int h = 0; h < 2; ++h)
#pragma unroll
            for (int i = 0; i < 2; ++i) nvA[h][i] = vA[h][i];
        if (has_next) { S.a_voff(nxt, tid, nvA); nA = S.a_base(nxt); nB = S.b_base(nxt); }
#pragma unroll 1
        for (int t = 0; t < nt; t += 2) {
            const bool last = (t == nt - 2);
            const char* a1 = cA + (size_t)(t + 1) * kstep;
            const char* a2 = last ? nA : cA + (size_t)(t + 2) * kstep; const char* b2 = last ? nB : cB + (size_t)(t + 2) * kstep;
            const char* a3 = a2 + kstep; const char* b3 = b2 + kstep;
            const unsigned s00 = last ? nvA[0][0] : vA[0][0], s01 = last ? nvA[0][1] : vA[0][1], s10 = last ? nvA[1][0] : vA[1][0], s11 = last ? nvA[1][1] : vA[1][1];
            if constexpr (SP2) {
            PG8_LDB(B0, 0, 0); PG8_LDB(B1, 0, 1); PG8_SCHED; PG8_LDA(At, 0, 0); PG8_STAGE2(PG8_SA(1, 1), a1, vA[1][0], vA[1][1]);
            PG8_WAIT_V(8); PG8_WAIT_L(0); PG8_BAR; PG8_MMA(0, 0, At, B0); PG8_MMA(0, 1, At, B1); PG8_BAR; PG8_SCHED;
            PG8_LDA(At, 0, 1); PG8_STAGEB(PG8_SB(0, 0), b2); PG8_STAGEB(PG8_SB(0, 1), b2 + hstep); PG8_STAGE2(PG8_SA(0, 0), a2, s00, s01);
            PG8_WAIT_V(8); PG8_WAIT_L(0); PG8_BAR; PG8_MMA(1, 0, At, B0); PG8_MMA(1, 1, At, B1); PG8_BAR; PG8_SCHED;
            PG8_LDB(B0, 1, 0); PG8_LDB(B1, 1, 1); PG8_SCHED; PG8_LDA(At, 1, 0); PG8_STAGE2(PG8_SA(0, 1), a2, s10, s11);
            PG8_WAIT_V(8); PG8_WAIT_L(0); PG8_BAR; PG8_MMA(0, 0, At, B0); PG8_MMA(0, 1, At, B1); PG8_BAR; PG8_SCHED;
            PG8_LDA(At, 1, 1); PG8_STAGEB(PG8_SB(1, 0), b3); PG8_STAGEB(PG8_SB(1, 1), b3 + hstep); PG8_STAGE2(PG8_SA(1, 0), a3, s00, s01);
            PG8_WAIT_V(8); PG8_WAIT_L(0); PG8_BAR; PG8_MMA(1, 0, At, B0); PG8_MMA(1, 1, At, B1); PG8_BAR; PG8_SCHED;
            } else {
            PG8_LDB(B0, 0, 0); PG8_SCHED; PG8_LDA(At, 0, 0); PG8_STAGE2(PG8_SA(1, 1), a1, vA[1][0], vA[1][1]);
            PG8_WAIT_L(8); PG8_BAR; PG8_WAIT_L(0); PG8_MMA(0, 0, At, B0); PG8_BAR; PG8_SCHED;
            PG8_LDB(B1, 0, 1); PG8_STAGEB(PG8_SB(0, 0), b2);
            PG8_BAR; PG8_WAIT_L(0); PG8_MMA(0, 1, At, B1); PG8_BAR;
            PG8_LDA(At, 0, 1); PG8_STAGE2(PG8_SA(0, 0), a2, s00, s01);
            PG8_BAR; PG8_WAIT_L(0); PG8_MMA(1, 0, At, B0); PG8_BAR; PG8_SCHED;
            PG8_STAGEB(PG8_SB(0, 1), b2 + hstep);
            PG8_WAIT_V(6); PG8_BAR; PG8_MMA(1, 1, At, B1); PG8_BAR;
            PG8_LDB(B0, 1, 0); PG8_SCHED; PG8_LDA(At, 1, 0); PG8_STAGE2(PG8_SA(0, 1), a2, s10, s11);
            PG8_WAIT_L(8); PG8_BAR; PG8_WAIT_L(0); PG8_MMA(0, 0, At, B0); PG8_BAR; PG8_SCHED;
            PG8_LDB(B1, 1, 1); PG8_STAGEB(PG8_SB(1, 0), b3);
            PG8_BAR; PG8_WAIT_L(0); PG8_MMA(0, 1, At, B1); PG8_BAR;
            PG8_LDA(At, 1, 1); PG8_STAGE2(PG8_SA(1, 0), a3, s00, s01);
            PG8_BAR; PG8_WAIT_L(0); PG8_MMA(1, 0, At, B0); PG8_BAR; PG8_SCHED;
            PG8_STAGEB(PG8_SB(1, 1), b3 + hstep);
            PG8_WAIT_V(6); PG8_BAR; PG8_MMA(1, 1, At, B1); PG8_BAR;
            }
        }
        if constexpr (ALIGN_EPI) { if (wr == 0) PG8_BAR; }
        E(acc, cur, wr, wc, fr, fq);
        if (!has_next) break;
        asm volatile("v_mov_b32 %0, 0" : "=v"(zero_));
#pragma unroll
        for (int a = 0; a < 2; ++a)
#pragma unroll
            for (int b = 0; b < 2; ++b)
#pragma unroll
                for (int m = 0; m < 4; ++m)
#pragma unroll
                    for (int n = 0; n < 2; ++n) acc[a][b][m][n] = (f32x4){zero_, zero_, zero_, zero_};
        cur = nxt; cA = nA; cB = nB; ++ui;
#pragma unroll
        for (int h = 0; h < 2; ++h)
#pragma unroll
            for (int i = 0; i < 2; ++i) vA[h][i] = nvA[h][i];
        if constexpr (ALIGN_EPI) { if (wr == 1) PG8_BAR; }
    }
    PG8_WAIT_V(0);
    if constexpr (!ALIGN_EPI) { if (wr == 0) PG8_BAR; }
    PG8_BAR;
#undef PG8_SA
#undef PG8_SB
#undef PG8_STAGE2
#undef PG8_STAGEB
#undef PG8_LDA
#undef PG8_LDB
#undef PG8_MMA
#undef PG8_WAIT_V
#undef PG8_WAIT_L
#undef PG8_BAR
#undef PG8_SCHED
}

template <int K> struct DenseSched {
    const char* A; const char* Bt; int nM, nN, nwg, G, c;
    __device__ __forceinline__ void init(const void* A_, const void* Bt_, int M, int N, int G_, int c_) { A = (const char*)A_; Bt = (const char*)Bt_; nM = M / BM; nN = N / BM; nwg = nM * nN; G = G_; c = c_; }
    __device__ __forceinline__ bool next(int i, Unit& u) const {
        const long L = (long)i * G + c; if (L >= nwg) return false;
        const int wgid = xcd_remap((int)L, nwg);
        const int nig = WGM * nN, gid = wgid / nig, fm = gid * WGM, gsz = (nM - fm) < WGM ? (nM - fm) : WGM;
        u.pm = fm + ((wgid % nig) % gsz); u.pn = (wgid % nig) / gsz; u.e = 0; u.row0 = u.pm * BM; return true;
    }
    __device__ __forceinline__ const char* a_base(const Unit& u) const { return A + (size_t)u.pm * BM * K * 2; }
    __device__ __forceinline__ const char* b_base(const Unit& u) const { return Bt + (size_t)u.pn * BM * K * 2; }
    __device__ __forceinline__ void a_voff(const Unit&, int tid, unsigned (&v)[2][2]) const {
#pragma unroll
        for (int i = 0; i < 2; ++i) { int R, C; stage_rc(tid * 16 + i * 8192, R, C); v[0][i] = (unsigned)(R * K + C) * 2u; v[1][i] = (unsigned)((R + HALF) * K + C) * 2u; }
    }
};
template <int K, bool GATHER, bool SPREAD = false> struct MoeSched {
    const char* A; const char* Bt; const int* ltok; const LAS int* tstart; int ntiles, nN, nwg, G, c; size_t bstride_e; int bcol0;
    __device__ __forceinline__ bool next(int i, Unit& u) const {
        int wgid;
        if (SPREAD) {
            const int xcd = c & 7, off = i * (G >> 3) + (c >> 3); const int Ru = tstart[64] * nN, Su = nwg - Ru;
            const int r0 = (int)((long)xcd * Ru / 8), r1 = (int)((long)(xcd + 1) * Ru / 8), s0 = (int)((long)xcd * Su / 8), s1 = (int)((long)(xcd + 1) * Su / 8);
            if (off < r1 - r0) wgid = r0 + off; else if (off < (r1 - r0) + (s1 - s0)) wgid = Ru + s0 + off - (r1 - r0); else return false;
        } else {
            const long L = (long)i * G + c; if (L >= nwg) return false;
            wgid = xcd_remap((int)L, nwg);
        }
        const int rt = wgid / nN; u.pn = wgid % nN; u.pm = rt; u.row0 = rt * BM;
        int lo = 0, hi = NE1;
        while (hi - lo > 1) { const int mid = (lo + hi) >> 1; if (tstart[mid] <= rt) lo = mid; else hi = mid; }
        u.e = lo; return true;
    }
    __device__ __forceinline__ const char* a_base(const Unit& u) const { return GATHER ? A : A + (size_t)u.row0 * K * 2; }
    __device__ __forceinline__ const char* b_base(const Unit& u) const { return Bt + (size_t)u.e * bstride_e + (size_t)(bcol0 + u.pn * BM) * K * 2; }
    __device__ __forceinline__ void a_voff(const Unit& u, int tid, unsigned (&v)[2][2]) const {
#pragma unroll
        for (int i = 0; i < 2; ++i) { int R, C; stage_rc(tid * 16 + i * 8192, R, C);
            if (GATHER) { const int t0 = ltok[u.row0 + R], t1 = ltok[u.row0 + HALF + R]; v[0][i] = (unsigned)(t0 * K + C) * 2u; v[1][i] = (unsigned)(t1 * K + C) * 2u; }
            else { v[0][i] = (unsigned)(R * K + C) * 2u; v[1][i] = (unsigned)((R + HALF) * K + C) * 2u; } }
    }
};
}
using pg8::Unit;

struct EpiInProj {
    static constexpr bool PERM = true;
    unsigned char* ws; const f32x2* rope;
    __device__ __forceinline__ void operator()(const f32x4 (&acc)[2][2][4][2], const Unit& u, int wr, int wc, int fr, int fq) const {
        const int pn = u.pn; const int row0 = u.pm * 256 + wr * 64 + fr;
        bf16_t* dst; int ld, colt;
        if (pn < 2) { dst = (bf16_t*)(ws + WS_Q); ld = 512; colt = pn * 256; }
        else if (pn < 4) { dst = (bf16_t*)(ws + WS_K); ld = 512; colt = (pn - 2) * 256; }
        else if (pn < 6) { dst = (bf16_t*)(ws + WS_V); ld = 512; colt = (pn - 4) * 256; }
        else if (pn == 6) { dst = nullptr; ld = 0; colt = 0; }
        else if (pn < 10) { dst = (bf16_t*)(ws + WS_G); ld = 768; colt = (pn - 7) * 256; }
        else { dst = (bf16_t*)(ws + WS_Z); ld = 256; colt = 0; }
        const bool rope_on = (pn < 4) && (u.pm < TL / 256);
        const float qs = pn < 2 ? 0.125f * 1.4426950408889634f : 1.f;
        float* BA = (float*)(ws + WS_BA);
#pragma unroll
        for (int ai = 0; ai < 2; ++ai)
#pragma unroll
            for (int m = 0; m < 4; ++m) {
                const int r = row0 + ai * 128 + m * 16;
                if (pn == 6) {
                    int b_, cc_, k_; if (r < TL) { b_ = r >> 12; const int t = r & (SEQ - 1); cc_ = 8 + (t >> 5); k_ = t & 31; } else { const int t = (r - TL) & (NCTX - 1); b_ = (r - TL) >> 8; cc_ = t >> 5; k_ = t & 31; }
#pragma unroll
                    for (int bj = 0; bj < 2; ++bj) { const int ch = bj * 128 + wc * 32 + 8 * fq; const f32x4 v0 = acc[ai][bj][m][0], v1 = acc[ai][bj][m][1];
                        u32x4 w; w.x = pg8::cvt_pk_bf16(v0[0], v0[1]); w.y = pg8::cvt_pk_bf16(v0[2], v0[3]); w.z = pg8::cvt_pk_bf16(v1[0], v1[1]); w.w = pg8::cvt_pk_bf16(v1[2], v1[3]);
                        *(u32x4*)((bf16_t*)(ws + WS_S5A) + ((size_t)(ch >> 4) * S5R + b_ * 136 + cc_) * 768 + k_ * 16 + (ch & 15)) = w; }
                } else if (pn == 11) {
                    if (wc == 0 && fq < 2) { *(f32x4*)(BA + (size_t)r * 16 + 8 * fq) = acc[ai][0][m][0]; *(f32x4*)(BA + (size_t)r * 16 + 8 * fq + 4) = acc[ai][0][m][1]; }
                } else {
                    f32x4 cs0 = {1.f, 0.f, 1.f, 0.f}, cs1 = {1.f, 0.f, 1.f, 0.f};
                    if (rope_on) { const int t = r & (SEQ - 1); const int pos = (wc & 1) ? (t & 63) : (t >> 6); const f32x4* rp = (const f32x4*)(rope + pos * 16 + 4 * fq); cs0 = rp[0]; cs1 = rp[1]; }
#pragma unroll
                    for (int bj = 0; bj < 2; ++bj) {
                        f32x4 v0 = acc[ai][bj][m][0], v1 = acc[ai][bj][m][1];
                        if (rope_on) {
                            const f32x4 c = {cs0[0], cs0[2], cs1[0], cs1[2]}, s = {cs0[1], cs0[3], cs1[1], cs1[3]};
                            const f32x4 x1 = v0, x2 = v1; v0 = x1 * c - x2 * s; v1 = x1 * s + x2 * c;
                        }
                        v0 = v0 * qs; v1 = v1 * qs;
                        u32x4 w; w.x = pg8::cvt_pk_bf16(v0[0], v0[1]); w.y = pg8::cvt_pk_bf16(v0[2], v0[3]); w.z = pg8::cvt_pk_bf16(v1[0], v1[1]); w.w = pg8::cvt_pk_bf16(v1[2], v1[3]);
                        *(u32x4*)(dst + (size_t)r * ld + colt + bj * 128 + wc * 32 + 8 * fq) = w;
                    }
                }
            }
    }
};
struct EpiResid {
    static constexpr bool PERM = false;
    const float* xin_lat; const float* xin_ctx; float* xo_lat; float* xo_ctx; const float* mod; int gidx;
    __device__ __forceinline__ void operator()(const f32x4 (&acc)[2][2][4][2], const Unit& u, int wr, int wc, int fr, int fq) const {
        const bool lat = u.pm < TL / 256;
        const int j = lat ? (u.pm >> 4) : 8  ;
        const float* gv = mod + j * 6144 + gidx * 1024 + u.pn * 256 + wc * 32 + 4 * fq;
        const float* src = (lat ? xin_lat + (size_t)u.pm * 256 * DM : xin_ctx + (size_t)(u.pm - TL / 256) * 256 * DM) + (size_t)(wr * 64 + fr) * DM + u.pn * 256 + wc * 32 + 4 * fq;
        float* dst = (lat ? xo_lat + (size_t)u.pm * 256 * DM : xo_ctx + (size_t)(u.pm - TL / 256) * 256 * DM) + (size_t)(wr * 64 + fr) * DM + u.pn * 256 + wc * 32 + 4 * fq;
        f32x4 g[2][2];
#pragma unroll
        for (int bj = 0; bj < 2; ++bj)
#pragma unroll
            for (int n = 0; n < 2; ++n) g[bj][n] = *(const f32x4*)(gv + bj * 128 + n * 16);
#pragma unroll
        for (int ai = 0; ai < 2; ++ai)
#pragma unroll
            for (int mh = 0; mh < 2; ++mh) {
                f32x4 x[2][2][2];
#pragma unroll
                for (int m2 = 0; m2 < 2; ++m2)
#pragma unroll
                    for (int bj = 0; bj < 2; ++bj)
#pragma unroll
                        for (int n = 0; n < 2; ++n) x[m2][bj][n] = *(const f32x4*)(src + (size_t)(ai * 128 + (2 * mh + m2) * 16) * DM + bj * 128 + n * 16);
#pragma unroll
                for (int m2 = 0; m2 < 2; ++m2)
#pragma unroll
                    for (int bj = 0; bj < 2; ++bj)
#pragma unroll
                        for (int n = 0; n < 2; ++n) *(f32x4*)(dst + (size_t)(ai * 128 + (2 * mh + m2) * 16) * DM + bj * 128 + n * 16) = x[m2][bj][n] + g[bj][n] * acc[ai][bj][2 * mh + m2][n];
            }
    }
};
struct EpiMoeUp {
    static constexpr bool PERM = true;
    bf16_t* hid; const float* lgate;
    __device__ __forceinline__ void operator()(const f32x4 (&acc)[2][2][4][2], const Unit& u, int wr, int wc, int fr, int fq) const {
        float gt[2][4];
#pragma unroll
        for (int ai = 0; ai < 2; ++ai)
#pragma unroll
            for (int m = 0; m < 4; ++m) gt[ai][m] = lgate[u.row0 + wr * 64 + fr + ai * 128 + m * 16];
#pragma unroll
        for (int ai = 0; ai < 2; ++ai)
#pragma unroll
            for (int m = 0; m < 4; ++m) {
                const int r = u.row0 + wr * 64 + fr + ai * 128 + m * 16;
                f32x4 h0, h1;
#pragma unroll
                for (int j = 0; j < 4; ++j) { const float a0 = acc[ai][0][m][0][j], a1 = acc[ai][0][m][1][j]; h0[j] = siluf(a0) * acc[ai][1][m][0][j] * gt[ai][m]; h1[j] = siluf(a1) * acc[ai][1][m][1][j] * gt[ai][m]; }
                u32x4 w; w.x = pg8::cvt_pk_bf16(h0[0], h0[1]); w.y = pg8::cvt_pk_bf16(h0[2], h0[3]); w.z = pg8::cvt_pk_bf16(h1[0], h1[1]); w.w = pg8::cvt_pk_bf16(h1[2], h1[3]);
                *(u32x4*)(hid + (size_t)r * 256 + u.pn * 128 + wc * 32 + 8 * fq) = w;
            }
    }
};
constexpr float PAIR_SCALE = 8.f;
struct EpiMoeDown {
    static constexpr bool PERM = true;
    unsigned char* ws;
    __device__ __forceinline__ void operator()(const f32x4 (&acc)[2][2][4][2], const Unit& u, int wr, int wc, int fr, int fq) const {
        unsigned char* base = u.row0 < PAIR_RA ? ws + WS_PAIRA + (size_t)u.row0 * 1024 : ws + WS_PAIRB + (size_t)(u.row0 - PAIR_RA) * 1024;
#pragma unroll
        for (int ai = 0; ai < 2; ++ai)
#pragma unroll
            for (int m = 0; m < 4; ++m) {
                const int r = wr * 64 + fr + ai * 128 + m * 16;
#pragma unroll
                for (int bj = 0; bj < 2; ++bj) {
                    const f32x4 v0 = acc[ai][bj][m][0] * PAIR_SCALE, v1 = acc[ai][bj][m][1] * PAIR_SCALE;
                    int w0 = __builtin_amdgcn_cvt_pk_fp8_f32(v0[0], v0[1], 0, false); w0 = __builtin_amdgcn_cvt_pk_fp8_f32(v0[2], v0[3], w0, true);
                    int w1 = __builtin_amdgcn_cvt_pk_fp8_f32(v1[0], v1[1], 0, false); w1 = __builtin_amdgcn_cvt_pk_fp8_f32(v1[2], v1[3], w1, true);
                    *(u32x2*)(base + (size_t)r * 1024 + u.pn * 256 + bj * 128 + wc * 32 + 8 * fq) = (u32x2){(unsigned)w0, (unsigned)w1};
                }
            }
    }
};

template <int K> struct GroupSched {
    const char* A; size_t a_gs; int lda; const char* Bt; size_t b_gs; int nM, nN, nwg, G, c;
    __device__ __forceinline__ bool next(int i, Unit& u) const {
        const long L = (long)i * G + c; if (L >= nwg) return false;
        const int wgid = pg8::xcd_remap((int)L, nwg); const int per = nM * nN, g = wgid / per, rem = wgid % per;
        u.e = g; u.pn = rem % nN; u.pm = rem / nN; u.row0 = u.pm * 256; return true;
    }
    __device__ __forceinline__ const char* a_base(const Unit& u) const { return A + (size_t)u.e * a_gs + (size_t)u.pm * 256 * lda * 2; }
    __device__ __forceinline__ const char* b_base(const Unit& u) const { return Bt + (size_t)u.e * b_gs + (size_t)u.pn * 256 * K * 2; }
    __device__ __forceinline__ void a_voff(const Unit&, int tid, unsigned (&v)[2][2]) const {
#pragma unroll
        for (int i = 0; i < 2; ++i) { int R, C; pg8::stage_rc(tid * 16 + i * 8192, R, C); v[0][i] = (unsigned)(R * lda + C) * 2u; v[1][i] = (unsigned)((R + 128) * lda + C) * 2u; }
    }
};
struct EpiLogits {
    static constexpr bool PERM = false;
    float* LOG;
    __device__ __forceinline__ void operator()(const f32x4 (&acc)[2][2][4][2], const Unit& u, int wr, int wc, int fr, int fq) const {
#pragma unroll
        for (int ai = 0; ai < 2; ++ai)
#pragma unroll
            for (int m = 0; m < 4; ++m) { const int r = u.row0 + wr * 64 + fr + ai * 128 + m * 16; float* rowp = LOG + ((size_t)u.e * MT + r) * 128;
#pragma unroll
                for (int n = 0; n < 2; ++n) *(f32x4*)(rowp + wc * 32 + n * 16 + 4 * fq) = acc[ai][0][m][n]; }
    }
};
struct EpiS5L {
    static constexpr bool PERM = false;
    float* L;
    __device__ __forceinline__ void operator()(const f32x4 (&acc)[2][2][4][2], const Unit& u, int wr, int wc, int fr, int fq) const {
#pragma unroll
        for (int ai = 0; ai < 2; ++ai)
#pragma unroll
            for (int m = 0; m < 4; ++m) { const int r = u.row0 + wr * 64 + fr + ai * 128 + m * 16; float* rowp = L + ((size_t)u.e * S5R + r) * 256;
#pragma unroll
                for (int bj = 0; bj < 2; ++bj)
#pragma unroll
                    for (int n = 0; n < 2; ++n) *(f32x4*)(rowp + bj * 128 + wc * 32 + n * 16 + 4 * fq) = acc[ai][bj][m][n]; }
    }
};
__device__ __forceinline__ float gelu_tanh(float x) { const float t = 0.7978845608028654f * (x + 0.044715f * x * x * x); const float th = 1.f - 2.f / (1.f + __expf(2.f * t)); return 0.5f * x * (1.f + th); }
struct EpiS5Y {
    static constexpr bool PERM = true;
    bf16_t* Zs;
    __device__ __forceinline__ void operator()(const f32x4 (&acc)[2][2][4][2], const Unit& u, int wr, int wc, int fr, int fq) const {
#pragma unroll
        for (int ai = 0; ai < 2; ++ai)
#pragma unroll
            for (int m = 0; m < 4; ++m) { const int r = u.row0 + wr * 64 + fr + ai * 128 + m * 16;
                if (r < S5RV) { const int b_ = r / 136, cc_ = r % 136; const int tok0 = cc_ < 8 ? TL + b_ * NCTX + cc_ * 32 : b_ * SEQ + (cc_ - 8) * 32;
#pragma unroll
                    for (int bj = 0; bj < 2; ++bj) { const int n = u.pn * 256 + bj * 128 + wc * 32 + 8 * fq; const f32x4 v0 = acc[ai][bj][m][0], v1 = acc[ai][bj][m][1];
                        u32x4 w; w.x = pg8::cvt_pk_bf16(gelu_tanh(v0[0]), gelu_tanh(v0[1])); w.y = pg8::cvt_pk_bf16(gelu_tanh(v0[2]), gelu_tanh(v0[3]));
                        w.z = pg8::cvt_pk_bf16(gelu_tanh(v1[0]), gelu_tanh(v1[1])); w.w = pg8::cvt_pk_bf16(gelu_tanh(v1[2]), gelu_tanh(v1[3]));
                        *(u32x4*)(Zs + (size_t)(tok0 + (n >> 4)) * 256 + u.e * 16 + (n & 15)) = w; } } }
    }
};
struct EpiGlu {
    static constexpr bool PERM = true;
    const bf16_t* Zs; bf16_t* hb; const float* bg;
    __device__ __forceinline__ void operator()(const f32x4 (&acc)[2][2][4][2], const Unit& u, int wr, int wc, int fr, int fq) const {
        f32x4 b0[2], b1[2];
#pragma unroll
        for (int bj = 0; bj < 2; ++bj) { const int col = bj * 128 + wc * 32 + 8 * fq; b0[bj] = *(const f32x4*)(bg + col); b1[bj] = *(const f32x4*)(bg + col + 4); }
#pragma unroll
        for (int ai = 0; ai < 2; ++ai) {
            u32x4 zz[4][2];
#pragma unroll
            for (int m = 0; m < 4; ++m)
#pragma unroll
                for (int bj = 0; bj < 2; ++bj) zz[m][bj] = *(const u32x4*)(Zs + (size_t)(u.row0 + wr * 64 + fr + ai * 128 + m * 16) * 256 + bj * 128 + wc * 32 + 8 * fq);
#pragma unroll
            for (int m = 0; m < 4; ++m) { const int r = u.row0 + wr * 64 + fr + ai * 128 + m * 16;
#pragma unroll
                for (int bj = 0; bj < 2; ++bj) { const int col = bj * 128 + wc * 32 + 8 * fq; const u32x4 z4 = zz[m][bj];
                    const f32x4 v0 = acc[ai][bj][m][0] + b0[bj], v1 = acc[ai][bj][m][1] + b1[bj];
                    float z[8]; z[0] = __builtin_bit_cast(float, z4.x << 16); z[1] = __builtin_bit_cast(float, z4.x & 0xffff0000u); z[2] = __builtin_bit_cast(float, z4.y << 16); z[3] = __builtin_bit_cast(float, z4.y & 0xffff0000u);
                    z[4] = __builtin_bit_cast(float, z4.z << 16); z[5] = __builtin_bit_cast(float, z4.z & 0xffff0000u); z[6] = __builtin_bit_cast(float, z4.w << 16); z[7] = __builtin_bit_cast(float, z4.w & 0xffff0000u);
                    u32x4 w; w.x = pg8::cvt_pk_bf16(z[0] * sigmf(v0[0]), z[1] * sigmf(v0[1])); w.y = pg8::cvt_pk_bf16(z[2] * sigmf(v0[2]), z[3] * sigmf(v0[3]));
                    w.z = pg8::cvt_pk_bf16(z[4] * sigmf(v1[0]), z[5] * sigmf(v1[1])); w.w = pg8::cvt_pk_bf16(z[6] * sigmf(v1[2]), z[7] * sigmf(v1[3]));
                    *(u32x4*)(hb + (size_t)r * DM + 512 + col) = w; } } }
    }
};


struct Ctx {
    const LAS unsigned* pl;
    LAS unsigned char* lds; int tid, lane, wave, G, bid, gw, NGW;
    __device__ __forceinline__ const float* ptr(int i) const { unsigned a_ = (unsigned)(size_t)pl; asm volatile("" : "+v"(a_));
        const LAS unsigned* q = (const LAS unsigned*)(size_t)a_; const unsigned lo = __builtin_amdgcn_readfirstlane(q[2 * i]), hi = __builtin_amdgcn_readfirstlane(q[2 * i + 1]); return (const float*)(((unsigned long long)hi << 32) | lo); }
    __device__ __forceinline__ const float* in(int i) const { return ptr(i); }
    __device__ __forceinline__ float* out() const { return (float*)ptr(35); }
    __device__ __forceinline__ unsigned char* ws() const { return (unsigned char*)ptr(36); }
    template <class T> __device__ __forceinline__ T* wsp(size_t off) const { return (T*)(ws() + off); }
};

__device__ __forceinline__ void ph_pre(const Ctx& c) {
    LAS float* act = (LAS float*)c.lds;
    const float* cv = c.in(I_C); const float* cc = c.in(I_CCTX);
    for (int i = c.tid; i < 9216; i += 512) { const int j = i >> 10, k = i & 1023; const float v = j < 8 ? cv[j * 1024 + k] : cc[k]; act[i] = siluf(v); }
    __syncthreads();
    float* mods = c.wsp<float>(WS_MODS);
    LAS float* red = act + 9216;
    for (int item = c.bid; item < 192; item += c.G) {
        const int l = item / 96, n0 = (item % 96) * 64, cg = c.tid & 15, ks = c.tid >> 4;
        f32x4 a[9];
#pragma unroll
        for (int j = 0; j < 9; ++j) a[j] = (f32x4){0.f, 0.f, 0.f, 0.f};
        const float* w = c.in(I_WMOD) + ((size_t)l * 1024 + ks * 32) * 6144 + n0 + 4 * cg;
#pragma unroll 8
        for (int k = 0; k < 32; ++k) { const f32x4 wv = *(const f32x4*)(w + (size_t)k * 6144);
#pragma unroll
            for (int j = 0; j < 9; ++j) a[j] += wv * act[j * 1024 + ks * 32 + k]; }
#pragma unroll
        for (int j = 0; j < 9; ++j) *(LAS f32x4*)(red + (ks * 9 + j) * 64 + 4 * cg) = a[j];
        __syncthreads();
        for (int o = c.tid; o < 576; o += 512) { const int j = o >> 6, n = o & 63; float sacc = 0.f;
#pragma unroll 8
            for (int q = 0; q < 32; ++q) sacc += red[(q * 9 + j) * 64 + n];
            mods[((size_t)l * 9 + j) * 6144 + n0 + n] = sacc + c.in(I_BMOD)[l * 6144 + n0 + n]; }
        __syncthreads();
    }
    if (c.bid == c.G - 1) {
        f32x2* rope = c.wsp<f32x2>(WS_ROPE);
        for (int i = c.tid; i < 1024; i += 512) { const int pos = i >> 4, f = i & 15; const float inv = exp2f(-(float)f * (13.287712379549449f / 16.f)); const float a = (float)pos * inv;
            rope[i] = (f32x2){__cosf(a), __sinf(a)}; }
    }
}

__device__ __forceinline__ void tr_item64(const float* W, int ldw, int ncols, int k0, int n0, bf16_t* WT, int Kdim, int drow0, bool perm, LAS float* scr, int lane) {
    const int lc = 4 * (lane & 15), lr = lane >> 4;
    f32x4 v[16];
#pragma unroll
    for (int i = 0; i < 16; ++i) { const int kk = 4 * i + lr; const int col = n0 + lc;
        v[i] = (col + 3 < ncols) ? __builtin_nontemporal_load((const __attribute__((address_space(1))) f32x4*)(size_t)(W + (size_t)(k0 + kk) * ldw + col)) :        (f32x4){col < ncols ? W[(size_t)(k0 + kk) * ldw + col] : 0.f, col + 1 < ncols ? W[(size_t)(k0 + kk) * ldw + col + 1] : 0.f, col + 2 < ncols ? W[(size_t)(k0 + kk) * ldw + col + 2] : 0.f, 0.f}; }
#pragma unroll
    for (int i = 0; i < 16; ++i) { const int kk = 4 * i + lr; LAS float* d = scr + kk * 65 + lc; d[0] = v[i][0]; d[1] = v[i][1]; d[2] = v[i][2]; d[3] = v[i][3]; }
    LDS_WAIT(); asm volatile("" ::: "memory");
    const int cch = lane & 7;
#pragma unroll
    for (int j = 0; j < 8; ++j) { const int n = (lane >> 3) + 8 * j; const int sn = perm ? (n & ~31) + dimperm(n & 31) : n; const LAS float* s = scr + (8 * cch) * 65 + sn;
        u32x4 o; o.x = pk2(s[0 * 65], s[1 * 65]); o.y = pk2(s[2 * 65], s[3 * 65]); o.z = pk2(s[4 * 65], s[5 * 65]); o.w = pk2(s[6 * 65], s[7 * 65]);
        *(u32x4*)(WT + (size_t)(drow0 + n) * Kdim + k0 + 8 * cch) = o; }
    LDS_WAIT(); asm volatile("" ::: "memory");
}
__device__ __forceinline__ void wprep13_item(const Ctx& c, int l, int e, int q, LAS float* scr) {
    const bool is3 = q >= 64; q &= 63; const int kb = q / 4, nb = q % 4, n0 = nb * 64;
    const float* src = e < 64 ? c.in(is3 ? I_W3 : I_W1) + ((size_t)l * 64 + e) * 1024 * 256 : c.in(is3 ? I_WS3 : I_WS1) + (size_t)l * 1024 * 256;
    tr_item64(src, 256, 256, kb * 64, n0, c.wsp<bf16_t>(WS_W13) + (size_t)e * 512 * 1024, 1024, (n0 >> 7) * 256 + (n0 & 127) + (is3 ? 128 : 0), false, scr, c.lane);
}
__device__ __forceinline__ void ph_wprep13_dyn(const Ctx& c, int l, int qsel) {
    LAS float* scr = (LAS float*)(c.lds + c.wave * 16640);
    unsigned* qctr = c.wsp<unsigned>(WS_CTL) + CW_ATTQ + l * 64 + qsel * 32 + 16;
    LAS int* qslot = (LAS int*)(c.lds + 8 * 16640);
    constexpr int NIT = NE1 * 128;
#pragma unroll 1
    for (;;) {
        if (c.tid == 0) qslot[0] = (int)atomicAdd(qctr, 8u);
        __syncthreads();
        const int base = __builtin_amdgcn_readfirstlane(qslot[0]);
        __syncthreads();
        if (base >= NIT) break;
        const int it = base + c.wave;
        if (it < NIT) wprep13_item(c, l, it >> 7, it & 127, scr);
    }
}
__device__ __forceinline__ void ph_wprep2_dyn(const Ctx& c, int l, int qsel) {
    LAS float* scr = (LAS float*)(c.lds + c.wave * 16640);
    unsigned* qctr = c.wsp<unsigned>(WS_CTL) + CW_ATTQ + l * 64 + qsel * 32 + 17;
    LAS int* qslot = (LAS int*)(c.lds + 8 * 16640);
    constexpr int NIT = NE1 * 64;
    __syncthreads();
#pragma unroll 1
    for (;;) {
        if (c.tid == 0) qslot[0] = (int)atomicAdd(qctr, 8u);
        __syncthreads();
        const int base = __builtin_amdgcn_readfirstlane(qslot[0]);
        __syncthreads();
        if (base >= NIT) break;
        const int it = base + c.wave;
        if (it < NIT) { const int e = it >> 6, q = it & 63, kb = q / 16, nb = q % 16;
            const float* src = e < 64 ? c.in(I_W2) + ((size_t)l * 64 + e) * 256 * 1024 : c.in(I_WS2) + (size_t)l * 256 * 1024;
            tr_item64(src, 1024, 1024, kb * 64, nb * 64, c.wsp<bf16_t>(WS_W2) + (size_t)e * 1024 * 256, 256, nb * 64, false, scr, c.lane); }
    }
}
template <int PART> __device__ __forceinline__ void ph_wprep(const Ctx& c, int l) {
    LAS float* scr = (LAS float*)(c.lds + c.wave * 16640);
    constexpr int I_IN = 16 * 48, I_OUT = 16 * 16, I_EXP = 192;
    constexpr int NITEMS = PART == 0 ? I_IN + I_OUT : (PART == 1 ? NE1 * I_EXP : NE1 * 64);
    for (int it = c.gw; it < NITEMS; it += c.NGW) {
        int r = PART == 0 ? it : (PART == 1 ? it + I_IN + I_OUT : (it >> 6) * I_EXP + 128 + (it & 63) + I_IN + I_OUT);
        if (r < I_IN) { const int kb = r / 48, nb = r % 48; tr_item64(c.in(I_WIN) + (size_t)l * 1024 * NIN, NIN, NIN, kb * 64, nb * 64, c.wsp<bf16_t>(WS_WIN), 1024, nb * 64, nb * 64 < 1024, scr, c.lane); continue; }
        r -= I_IN;
        if (r < I_OUT) { const int kb = r / 16, nb = r % 16; tr_item64(c.in(I_WOUT) + (size_t)l * 1024 * 1024, 1024, 1024, kb * 64, nb * 64, c.wsp<bf16_t>(WS_WOUT), 1024, nb * 64, false, scr, c.lane); continue; }
        r -= I_OUT;
        const int e = r / I_EXP; int q = r % I_EXP;
        if (q < 128) wprep13_item(c, l, e, q, scr);
        else {
            q -= 128; const int kb = q / 16, nb = q % 16;
            const float* src = e < 64 ? c.in(I_W2) + ((size_t)l * 64 + e) * 256 * 1024 : c.in(I_WS2) + (size_t)l * 256 * 1024;
            tr_item64(src, 1024, 1024, kb * 64, nb * 64, c.wsp<bf16_t>(WS_W2) + (size_t)e * 1024 * 256, 256, nb * 64, false, scr, c.lane);
        }
    }
}

template <bool LOPART> __device__ __forceinline__ void norm_mod_row(const float* xrow, const float* nw, const float* sc, const float* sh, bf16_t* orow, bf16_t* lorow, int lane) {
    f32x4 v[4]; float ss = 0.f;
#pragma unroll
    for (int j = 0; j < 4; ++j) { v[j] = ((const f32x4*)xrow)[lane + 64 * j]; ss += (v[j][0] * v[j][0] + v[j][1] * v[j][1]) + (v[j][2] * v[j][2] + v[j][3] * v[j][3]); }
    ss = wave_sum(ss);
    const float rstd = rsqrtf(ss * (1.f / DM) + EPS);
#pragma unroll
    for (int j = 0; j < 4; ++j) { const int col = 4 * lane + 256 * j;
        const f32x4 w = *(const f32x4*)(nw + col), a = *(const f32x4*)(sc + col), s = *(const f32x4*)(sh + col);
        const f32x4 y = (v[j] * rstd) * w * (a + 1.f) + s;
        u32x2 o; o.x = pk2(y[0], y[1]); o.y = pk2(y[2], y[3]);
        *(u32x2*)(orow + col) = o;
        if (LOPART) { const float r0 = y[0] - __builtin_bit_cast(float, o.x << 16), r1 = y[1] - __builtin_bit_cast(float, o.x & 0xffff0000u), r2 = y[2] - __builtin_bit_cast(float, o.y << 16), r3 = y[3] - __builtin_bit_cast(float, o.y & 0xffff0000u);
            u32x2 lo; lo.x = pk2(r0, r1); lo.y = pk2(r2, r3); *(u32x2*)(lorow + col) = lo; } }
}
__device__ __forceinline__ const float* xrow_ptr(const Ctx& c, int l, int m) {
    if (m < TL) return (l == 0 ? c.in(I_X) : c.out()) + (size_t)m * DM;
    return ((l == 0 || ABL_CTXORIG) ? c.in(I_CTX) : c.wsp<float>(WS_XC)) + (size_t)(m - TL) * DM;
}
__device__ __forceinline__ void ph_norm1(const Ctx& c, int l) {
    const float* mods = c.wsp<float>(WS_MODS) + (size_t)l * 9 * 6144;
    bf16_t* hb = c.wsp<bf16_t>(WS_HB);
    for (int m = c.gw; m < MT; m += c.NGW) {
        const int j = m < TL ? m / SEQ : 8;
        norm_mod_row<false>(xrow_ptr(c, l, m), c.in(I_N1W) + l * DM, mods + j * 6144 + 1 * 1024, mods + j * 6144 + 0 * 1024, hb + (size_t)m * DM, nullptr, c.lane);
    }
}


namespace fa {
using f32x16 = __attribute__((ext_vector_type(16))) float;
using s16x4 = __attribute__((ext_vector_type(4))) short;
constexpr int SHM_V = 64 * 128 * 2, SHM_K = 64 * 128 * 2;
constexpr float THR = 8.f, C = 1.4426950408889634f;
#define FA_KSWZ(row, colB) ((row) * 256 + ((colB) ^ (((row) & 15) << 4)))
#define FA_SBAR() __builtin_amdgcn_sched_barrier(0)
__device__ __forceinline__ int crow(int r, int hi) { return (r & 3) + 8 * (r >> 2) + 4 * hi; }
__device__ __forceinline__ unsigned cvtpk(float lo, float hi) { unsigned r; asm volatile("v_cvt_pk_bf16_f32 %0, %1, %2" : "=v"(r) : "v"(lo), "v"(hi)); return r; }
template <int BASE> __device__ __forceinline__ bf16x8 pk8(const f32x16& P) {
    u32x4 w = {cvtpk(P[BASE + 0], P[BASE + 1]), cvtpk(P[BASE + 2], P[BASE + 3]), cvtpk(P[BASE + 4], P[BASE + 5]), cvtpk(P[BASE + 6], P[BASE + 7])};
    return *reinterpret_cast<bf16x8*>(&w);
}
__device__ __forceinline__ void partialSM(f32x16& p0, f32x16& p1, float& m_reg, float& mn, float& alpha) {
    float pmax = p0[0];
#pragma unroll
    for (int r = 1; r < 16; ++r) pmax = fmaxf(pmax, p0[r]);
#pragma unroll
    for (int r = 0; r < 16; ++r) pmax = fmaxf(pmax, p1[r]);
    { auto rr = __builtin_amdgcn_permlane32_swap(__float_as_uint(pmax), __float_as_uint(pmax), false, false); pmax = fmaxf(__uint_as_float(rr[0]), __uint_as_float(rr[1])); }
    if (__builtin_expect(__all(pmax - m_reg <= THR), 1)) { mn = m_reg; alpha = 1.f; }
    else { mn = fmaxf(m_reg, pmax); alpha = __builtin_amdgcn_exp2f((m_reg - mn) * C); m_reg = mn; }
    const float mnC = -mn * C;
#pragma unroll
    for (int r = 0; r < 16; ++r) p0[r] = fmaf(p0[r], C, mnC);
#pragma unroll
    for (int r = 0; r < 16; ++r) p1[r] = fmaf(p1[r], C, mnC);
#pragma unroll
    for (int r = 0; r < 16; ++r) p0[r] = __builtin_amdgcn_exp2f(p0[r]);
}
__device__ __forceinline__ void finishSM(f32x16& p0, f32x16& p1, float alpha, float& l_reg, bf16x8& pa0, bf16x8& pa1, bf16x8& pa2, bf16x8& pa3) {
#pragma unroll
    for (int r = 0; r < 16; ++r) p1[r] = __builtin_amdgcn_exp2f(p1[r]);
#if ATT_X == 1
#pragma unroll
    for (int r = 0; r < 16; ++r) { float t_; asm volatile("v_exp_f32 %0, %1" : "=v"(t_) : "v"(p1[r])); asm volatile("v_exp_f32 %0, %1" : "=v"(t_) : "v"(p0[r])); }
#endif
    float ps = 0;
#pragma unroll
    for (int r = 0; r < 16; ++r) ps += p0[r];
#pragma unroll
    for (int r = 0; r < 16; ++r) ps += p1[r];
    { auto rr = __builtin_amdgcn_permlane32_swap(__float_as_uint(ps), __float_as_uint(ps), false, false); ps = __uint_as_float(rr[0]) + __uint_as_float(rr[1]); }
    l_reg = l_reg * alpha + ps;
#define FA_PK4(P, BASE, OUT) do { unsigned a0 = cvtpk(P[BASE + 0], P[BASE + 1]), a1 = cvtpk(P[BASE + 2], P[BASE + 3]);   \
    unsigned b0 = cvtpk(P[BASE + 4], P[BASE + 5]), b1 = cvtpk(P[BASE + 6], P[BASE + 7]);                              \
    auto r0 = __builtin_amdgcn_permlane32_swap(a0, b0, false, false); auto r1 = __builtin_amdgcn_permlane32_swap(a1, b1, false, false); \
    u32x4 w = {r0[0], r1[0], r0[1], r1[1]}; OUT = *reinterpret_cast<bf16x8*>(&w); } while (0)
    FA_PK4(p0, 0, pa0); FA_PK4(p0, 8, pa1); FA_PK4(p1, 0, pa2); FA_PK4(p1, 8, pa3);
#undef FA_PK4
}
__device__ __forceinline__ void qkt(f32x16& p0, f32x16& p1, const LAS char* Ks, const bf16x8 (&qr)[4], int r32, int hi, int mcol) {
    p0 = ozero16(); p1 = p0;
#pragma unroll
    for (int d0 = 0; d0 < 4; ++d0) { const int cb = (mcol + d0 * 16 + hi * 8) * 2;
        const bf16x8 b0 = *reinterpret_cast<const LAS bf16x8*>(Ks + FA_KSWZ(r32, cb));
        const bf16x8 b1 = *reinterpret_cast<const LAS bf16x8*>(Ks + FA_KSWZ(32 + r32, cb));
        p0 = __builtin_amdgcn_mfma_f32_32x32x16_bf16(b0, qr[d0], p0, 0, 0, 0);
        p1 = __builtin_amdgcn_mfma_f32_32x32x16_bf16(b1, qr[d0], p1, 0, 0, 0); }
}
__device__ __forceinline__ void qkt_load(bf16x8 (&kf)[8], const LAS char* Ks, int r32, int hi, int mcol) {
#pragma unroll
    for (int d0 = 0; d0 < 4; ++d0) { const int cb = (mcol + d0 * 16 + hi * 8) * 2;
        kf[2 * d0] = *reinterpret_cast<const LAS bf16x8*>(Ks + FA_KSWZ(r32, cb));
        kf[2 * d0 + 1] = *reinterpret_cast<const LAS bf16x8*>(Ks + FA_KSWZ(32 + r32, cb)); }
}
__device__ __forceinline__ void qkt_mma(f32x16& p0, f32x16& p1, const bf16x8 (&kf)[8], const bf16x8 (&qr)[4], const f32x16& z) {
    p0 = __builtin_amdgcn_mfma_f32_32x32x16_bf16(kf[0], qr[0], z, 0, 0, 0);
    p1 = __builtin_amdgcn_mfma_f32_32x32x16_bf16(kf[1], qr[0], z, 0, 0, 0);
#pragma unroll
    for (int d0 = 1; d0 < 4; ++d0) {
        p0 = __builtin_amdgcn_mfma_f32_32x32x16_bf16(kf[2 * d0], qr[d0], p0, 0, 0, 0);
        p1 = __builtin_amdgcn_mfma_f32_32x32x16_bf16(kf[2 * d0 + 1], qr[d0], p1, 0, 0, 0); }
#if ATT_X == 2
    { f32x16 d_;
#pragma unroll
      for (int i = 0; i < 8; ++i) asm volatile("v_mfma_f32_32x32x16_bf16 %0, %1, %2, 0" : "=v"(d_) : "v"(kf[i]), "v"(qr[i & 3])); }
#endif
}
__device__ __forceinline__ int v_st(int k, int c) { const int kk = (k & ~0xC) | ((k & 4) << 1) | ((k & 8) >> 1); return ((kk >> 3) * 4 + (c >> 5)) * 512 + ((kk & 7) * 32 + (c & 31)) * 2; }
__device__ __forceinline__ int v_rd_base(int lane) { return ((lane & 3) << 3) | (((lane >> 2) & 3) << 6) | (((lane >> 4) & 1) << 5) | (((lane >> 5) & 1) << 8); }
constexpr int v_rd_off(int d0, int ks, int half) { return d0 * 512 + ks * 4096 + half * 2048; }
template <int OFF> __device__ __forceinline__ s16x4 tr_read(int vb) { s16x4 r; asm volatile("ds_read_b64_tr_b16 %0, %1 offset:%2" : "=&v"(r) : "v"(vb), "i"(OFF) : "memory"); return r; }
template <int D0> __device__ __forceinline__ void pv_one(f32x16& od, int vb, bf16x8 pa0, bf16x8 pa1, bf16x8 pa2, bf16x8 pa3) {
    const s16x4 l0 = tr_read<v_rd_off(D0, 0, 0)>(vb), h0 = tr_read<v_rd_off(D0, 0, 1)>(vb), l1 = tr_read<v_rd_off(D0, 1, 0)>(vb), h1 = tr_read<v_rd_off(D0, 1, 1)>(vb);
    const s16x4 l2 = tr_read<v_rd_off(D0, 2, 0)>(vb), h2 = tr_read<v_rd_off(D0, 2, 1)>(vb), l3 = tr_read<v_rd_off(D0, 3, 0)>(vb), h3 = tr_read<v_rd_off(D0, 3, 1)>(vb);
    asm volatile("s_waitcnt lgkmcnt(0)" ::: "memory"); FA_SBAR();
#define FA_PK(L, H) (bf16x8){L[0], L[1], L[2], L[3], H[0], H[1], H[2], H[3]}
    od = __builtin_amdgcn_mfma_f32_32x32x16_bf16(pa0, FA_PK(l0, h0), od, 0, 0, 0);
    od = __builtin_amdgcn_mfma_f32_32x32x16_bf16(pa1, FA_PK(l1, h1), od, 0, 0, 0);
    od = __builtin_amdgcn_mfma_f32_32x32x16_bf16(pa2, FA_PK(l2, h2), od, 0, 0, 0);
    od = __builtin_amdgcn_mfma_f32_32x32x16_bf16(pa3, FA_PK(l3, h3), od, 0, 0, 0);
#undef FA_PK
}
__device__ __forceinline__ void pv_d0(f32x16 (&o)[4], int vb, bf16x8 pa0, bf16x8 pa1, bf16x8 pa2, bf16x8 pa3) {
    pv_one<0>(o[0], vb, pa0, pa1, pa2, pa3); pv_one<1>(o[1], vb, pa0, pa1, pa2, pa3); pv_one<2>(o[2], vb, pa0, pa1, pa2, pa3); pv_one<3>(o[3], vb, pa0, pa1, pa2, pa3);
}
__device__ __forceinline__ void attn_unit(const bf16_t* Q, const bf16_t* K, const bf16_t* V, bf16_t* O, int qrow0, int h, int klat0, int nlat, int kctx0, int NT,
                                          float lam, float oscale, const float* subln, LAS char* lds) {
    int tid = threadIdx.x; asm volatile("" : "+v"(tid));
    const int wid = __builtin_amdgcn_readfirstlane(tid >> 6), lane = tid & 63, r32 = lane & 31, hi = lane >> 5, map = wid >> 2, wq = wid & 3;
    LAS char* V_lds = lds; LAS char* K_lds = lds + 4 * SHM_V;
    LAS float* wsc = (LAS float*)(lds + 4 * SHM_V + 4 * SHM_K) + wid * 64; LAS float* li_l = wsc; LAS float* al_l = wsc + 32;
    float l_reg = 0; f32x16 o[4]; { const f32x16 z16 = ozero16(); o[0] = z16; o[1] = z16; o[2] = z16; o[3] = z16; } bf16x8 qr[4];
    { const bf16_t* Qw = Q + (size_t)(qrow0 + wq * 32 + r32) * 512 + h * 128 + map * 64 + hi * 8;
#pragma unroll
      for (int d0 = 0; d0 < 4; ++d0) qr[d0] = *reinterpret_cast<const bf16x8*>(Qw + d0 * 16); }
    unsigned kofs[2], vofs[2];
#pragma unroll
    for (int i = 0; i < 2; ++i) { const int p = 2 * wid + i, row = 4 * p + (lane >> 4); kofs[i] = (unsigned)(row * 1024 + ((16 * (lane & 15)) ^ ((row & 15) << 4)));
        const int sub = 2 * p + (lane >> 5), k = (sub >> 2) * 8 + ((lane & 31) >> 2), cc = (sub & 3) * 32 + (lane & 3) * 8;
        vofs[i] = (unsigned)(k * 1024 + cc * 2); }
    const char* Kg = (const char*)K + h * 256; const char* Vg = (const char*)V + h * 256;
    const int vrb = (int)(size_t)V_lds + v_rd_base(lane);
    const int mcol = map * 64;
    const unsigned offL = (unsigned)klat0 * 1024u, offC = (unsigned)(kctx0 - 64 * nlat) * 1024u;
#define FA_TOFF(t) (((t) < nlat ? offL : offC) + (unsigned)(t) * 65536u)
#define FA_DMA(G, D) __builtin_amdgcn_global_load_lds((const unsigned*)(G), (LAS unsigned*)(D), 16, 0, 0)
#define FA_ISSUE_K(t) do { const int t_ = (t); const char* g_ = Kg + FA_TOFF(t_); asm volatile("" : "+s"(g_)); LAS char* d_ = K_lds + (t_ & 3) * SHM_K + wid * 2048; FA_DMA(g_ + kofs[0], d_); FA_DMA(g_ + kofs[1], d_ + 1024); } while (0)
#define FA_ISSUE_V(t) do { const int t_ = (t); const char* g_ = Vg + FA_TOFF(t_); asm volatile("" : "+s"(g_)); LAS char* d_ = V_lds + (t_ & 3) * SHM_V + wid * 2048; FA_DMA(g_ + vofs[0], d_); FA_DMA(g_ + vofs[1], d_ + 1024); } while (0)
#define FA_TOP(N) do { asm volatile("s_waitcnt vmcnt(" #N ")" ::: "memory"); __builtin_amdgcn_s_barrier(); asm volatile("" ::: "memory"); FA_SBAR(); } while (0)
#define FA_RESC(a) do { if (__any((a) < 1.f)) { if (hi == 0) al_l[r32] = (a); asm volatile("s_waitcnt lgkmcnt(0)" ::: "memory"); \
    _Pragma("unroll") for (int d = 0; d < 4; ++d) _Pragma("unroll") for (int r = 0; r < 16; ++r) o[d][r] *= al_l[crow(r, hi)]; } } while (0)
    typedef float f32x2 __attribute__((ext_vector_type(2)));
    f32x16 p0, p1, negm; float al = 1.f, pm; bf16x8 pa[4], kf[8]; s16x4 vl[2][4], vh[2][4]; f32x2 sA, sB;
#define FA_PK(L, H) (bf16x8){L[0], L[1], L[2], L[3], H[0], H[1], H[2], H[3]}
#define FA_MM(D0, KS, SET) o[D0] = __builtin_amdgcn_mfma_f32_32x32x16_bf16(pa[KS], FA_PK(vl[SET][KS], vh[SET][KS]), o[D0], 0, 0, 0)
#define FA_VRD(D0, SET) do { vl[SET][0] = tr_read<v_rd_off(D0, 0, 0)>(vb_); vh[SET][0] = tr_read<v_rd_off(D0, 0, 1)>(vb_); vl[SET][1] = tr_read<v_rd_off(D0, 1, 0)>(vb_); vh[SET][1] = tr_read<v_rd_off(D0, 1, 1)>(vb_); \
    vl[SET][2] = tr_read<v_rd_off(D0, 2, 0)>(vb_); vh[SET][2] = tr_read<v_rd_off(D0, 2, 1)>(vb_); vl[SET][3] = tr_read<v_rd_off(D0, 3, 0)>(vb_); vh[SET][3] = tr_read<v_rd_off(D0, 3, 1)>(vb_); } while (0)
#define FA_LWAIT() do { asm volatile("s_waitcnt lgkmcnt(0)" ::: "memory"); FA_SBAR(); } while (0)
#define FA_MAX0() do { pm = p0[0]; _Pragma("unroll") for (int r = 1; r < 16; ++r) pm = fmaxf(pm, p0[r]); } while (0)
#define FA_MAX1() do { _Pragma("unroll") for (int r = 0; r < 16; ++r) pm = fmaxf(pm, p1[r]); auto rr_ = __builtin_amdgcn_permlane32_swap(__float_as_uint(pm), __float_as_uint(pm), false, false); \
    pm = fmaxf(__uint_as_float(rr_[0]), __uint_as_float(rr_[1])); } while (0)
#define FA_CHK() do { if (__builtin_expect(__all(pm <= THR * C), 1)) { al = 1.f; } else { const float d_ = fmaxf(pm, 0.f); al = __builtin_amdgcn_exp2f(-d_); \
    _Pragma("unroll") for (int r = 0; r < 16; ++r) { negm[r] -= d_; p0[r] -= d_; p1[r] -= d_; } } } while (0)
#define FA_EXP(P, A, B) do { _Pragma("unroll") for (int r = A; r < B; ++r) P[r] = __builtin_amdgcn_exp2f(P[r]); } while (0)
#define FA_P2(P, R) (f32x2){P[R], P[(R) + 1]}
#define FA_SUM0() do { sA = FA_P2(p0, 0) + FA_P2(p0, 2); sB = FA_P2(p0, 4) + FA_P2(p0, 6); } while (0)
#define FA_SUM1() do { sA += FA_P2(p0, 8); sB += FA_P2(p0, 10); sA += FA_P2(p0, 12); sB += FA_P2(p0, 14); } while (0)
#define FA_SUM2() do { sA += FA_P2(p1, 0); sB += FA_P2(p1, 2); sA += FA_P2(p1, 4); sB += FA_P2(p1, 6); } while (0)
#define FA_SUM3() do { sA += FA_P2(p1, 8); sB += FA_P2(p1, 10); sA += FA_P2(p1, 12); sB += FA_P2(p1, 14); sA += sB; float ps_ = sA[0] + sA[1]; \
    auto rr_ = __builtin_amdgcn_permlane32_swap(__float_as_uint(ps_), __float_as_uint(ps_), false, false); ps_ = __uint_as_float(rr_[0]) + __uint_as_float(rr_[1]); l_reg = l_reg * al + ps_; } while (0)
    FA_ISSUE_K(0); FA_ISSUE_K(1); FA_ISSUE_V(0); FA_ISSUE_K(2);
    FA_TOP(4);
    FA_ISSUE_K(3); FA_ISSUE_V(1); FA_SBAR();
    { const f32x16 z = {0.f, 0.f, 0.f, 0.f, 0.f, 0.f, 0.f, 0.f, 0.f, 0.f, 0.f, 0.f, 0.f, 0.f, 0.f, 0.f};
      qkt_load(kf, K_lds, r32, hi, mcol); FA_SBAR(); qkt_mma(p0, p1, kf, qr, z); asm volatile("" : "+v"(p0), "+v"(p1)); FA_SBAR(); }
    qkt_load(kf, K_lds + SHM_K, r32, hi, mcol);
    FA_MAX0(); FA_MAX1();
    { const float nm_ = -pm;
#pragma unroll
      for (int r = 0; r < 16; ++r) { negm[r] = nm_; p0[r] += nm_; p1[r] += nm_; } }
    FA_EXP(p0, 0, 16); FA_EXP(p1, 0, 16); FA_SUM0(); FA_SUM1(); FA_SUM2(); FA_SUM3();
    pa[0] = pk8<0>(p0); pa[1] = pk8<8>(p0); pa[2] = pk8<0>(p1); pa[3] = pk8<8>(p1); FA_SBAR();
#pragma unroll 1
    for (int j = 1; j < NT; ++j) {
        FA_TOP(4);
        const int vb_ = vrb + ((j - 1) & 3) * SHM_V;
        qkt_mma(p0, p1, kf, qr, negm); asm volatile("" : "+v"(p0), "+v"(p1)); FA_SBAR();
        FA_VRD(0, 0);
        { const int tk = (j + 3 < NT) ? j + 3 : NT - 1, tv = (j + 1 < NT) ? j + 1 : NT - 1; FA_ISSUE_K(tk); FA_ISSUE_V(tv); } FA_SBAR();
        FA_LWAIT();
        FA_MM(0, 0, 0); FA_VRD(1, 1); FA_SBAR();
        FA_MM(0, 1, 0); FA_MAX0(); FA_SBAR();
        FA_MM(0, 2, 0); FA_MAX1(); FA_SBAR();
        FA_MM(0, 3, 0); FA_CHK(); FA_EXP(p0, 0, 2); FA_SBAR();
        FA_LWAIT();
        FA_MM(1, 0, 1); FA_VRD(2, 0); FA_EXP(p0, 2, 4); FA_SBAR();
        FA_MM(1, 1, 1); FA_EXP(p0, 4, 7); FA_SBAR();
        FA_MM(1, 2, 1); FA_EXP(p0, 7, 10); FA_SBAR();
        FA_MM(1, 3, 1); FA_EXP(p0, 10, 13); FA_SBAR();
        FA_LWAIT();
        FA_MM(2, 0, 0); FA_VRD(3, 1); FA_EXP(p0, 13, 16); FA_SBAR();
        FA_MM(2, 1, 0); FA_EXP(p1, 0, 3); FA_SUM0(); FA_SBAR();
        FA_MM(2, 2, 0); FA_EXP(p1, 3, 6); FA_SUM1(); FA_SBAR();
        FA_MM(2, 3, 0); FA_EXP(p1, 6, 8); FA_SBAR();
        FA_LWAIT();
        FA_MM(3, 0, 1); FA_EXP(p1, 8, 10); pa[0] = pk8<0>(p0); FA_SBAR();
        FA_MM(3, 1, 1); FA_EXP(p1, 10, 12); pa[1] = pk8<8>(p0); FA_SBAR();
        FA_MM(3, 2, 1); FA_EXP(p1, 12, 14); FA_SUM2(); pa[2] = pk8<0>(p1); FA_SBAR();
        FA_MM(3, 3, 1); FA_EXP(p1, 14, 16); FA_SBAR();
        FA_SUM3(); pa[3] = pk8<8>(p1); FA_SBAR();
        qkt_load(kf, K_lds + ((j + 1) & 3) * SHM_K, r32, hi, mcol); FA_SBAR();
        FA_RESC(al); FA_SBAR();
    }
    FA_TOP(0);
    { const int vb_ = vrb + ((NT - 1) & 3) * SHM_V;
      FA_VRD(0, 0); FA_LWAIT(); FA_MM(0, 0, 0); FA_VRD(1, 1); FA_MM(0, 1, 0); FA_MM(0, 2, 0); FA_MM(0, 3, 0); FA_LWAIT();
      FA_MM(1, 0, 1); FA_VRD(2, 0); FA_MM(1, 1, 1); FA_MM(1, 2, 1); FA_MM(1, 3, 1); FA_LWAIT();
      FA_MM(2, 0, 0); FA_VRD(3, 1); FA_MM(2, 1, 0); FA_MM(2, 2, 0); FA_MM(2, 3, 0); FA_LWAIT();
      FA_MM(3, 0, 1); FA_MM(3, 1, 1); FA_MM(3, 2, 1); FA_MM(3, 3, 1); }
#undef FA_PK
#undef FA_MM
#undef FA_VRD
#undef FA_LWAIT
#undef FA_MAX0
#undef FA_MAX1
#undef FA_CHK
#undef FA_EXP
#undef FA_P2
#undef FA_SUM0
#undef FA_SUM1
#undef FA_SUM2
#undef FA_SUM3
#undef FA_TOFF
#undef FA_TOP
#undef FA_ISSUE_K
#undef FA_ISSUE_V
#undef FA_DMA
    if (hi == 0) li_l[r32] = l_reg; asm volatile("s_waitcnt lgkmcnt(0)" ::: "memory");
    float rli[16];
#pragma unroll
    for (int r = 0; r < 16; ++r) rli[r] = __builtin_amdgcn_rcpf(li_l[crow(r, hi)]);
    __syncthreads();
    LAS float* EX = (LAS float*)lds;
    if (map == 1) {
#pragma unroll
        for (int d0 = 0; d0 < 4; ++d0)
#pragma unroll
            for (int r = 0; r < 16; ++r) EX[(wq * 32 + crow(r, hi)) * 128 + d0 * 32 + r32] = o[d0][r] * rli[r];
    }
    __syncthreads();
    if (map == 0) {
        float ss[16];
#pragma unroll
        for (int r = 0; r < 16; ++r) ss[r] = 0.f;
#pragma unroll
        for (int d0 = 0; d0 < 4; ++d0)
#pragma unroll
            for (int r = 0; r < 16; ++r) { const float v = o[d0][r] * rli[r] - lam * EX[(wq * 32 + crow(r, hi)) * 128 + d0 * 32 + r32]; o[d0][r] = v; ss[r] += v * v; }
#pragma unroll
        for (int r = 0; r < 16; ++r) {
#pragma unroll
            for (int ofs = 1; ofs < 32; ofs <<= 1) ss[r] += __shfl_xor(ss[r], ofs);
            ss[r] = rsqrtf(ss[r] * (1.f / 128.f) + EPS) * oscale; }
#pragma unroll
        for (int d0 = 0; d0 < 4; ++d0) { const float sw = subln[d0 * 32 + r32];
#pragma unroll
            for (int r = 0; r < 16; ++r) O[(size_t)(qrow0 + wq * 32 + crow(r, hi)) * DM + h * 128 + d0 * 32 + r32] = (bf16_t)f2bf(o[d0][r] * ss[r] * sw); }
    }
    __syncthreads();
#undef FA_RESC
}
}
__device__ __forceinline__ void ph_attn_fast(const Ctx& c, int l, int qsel = 0) {
    const bf16_t* Q = c.wsp<bf16_t>(WS_Q); const bf16_t* Kb = c.wsp<bf16_t>(WS_K); const bf16_t* Vb = c.wsp<bf16_t>(WS_V); bf16_t* hb = c.wsp<bf16_t>(WS_HB);
    const float lam_init = 0.8f - 0.6f * __expf(-0.3f * (float)l);
    LAS float* lamp = (LAS float*)(c.lds + 4 * fa::SHM_V + 4 * fa::SHM_K + 8 * 256);
    if (c.wave == 0) { const float* dl = c.in(I_DALAM) + l * 256; const float s1 = wave_sum(dl[c.lane] * dl[64 + c.lane]), s2 = wave_sum(dl[128 + c.lane] * dl[192 + c.lane]);
        if (c.lane == 0) lamp[0] = __expf(s1) - __expf(s2) + lam_init; }
    __syncthreads();
    const float lam = lamp[0];
    const float* subln = c.in(I_DASUB) + l * 128;
    const int nq = 128 + (l == 0 ? 8 : 0);
    unsigned* qctr = c.wsp<unsigned>(WS_CTL) + CW_ATTQ + l * 64 + qsel * 32;
    LAS int* qslot = (LAS int*)(c.lds + 4 * fa::SHM_V + 4 * fa::SHM_K + 8 * 256 + 64);
    const int xcd = (int)(blockIdx.x & 7);
    int qcur = 0;
#pragma unroll 1
    for (;;) {
        if (c.tid == 0) { int it = -1, s_ = qcur;
#pragma unroll 1
            for (; s_ < 8; ++s_) { const int q = (xcd + s_) & 7; const int v = (int)atomicAdd(qctr + q, 1u); if (v < nq) { it = q * 256 + v; break; } }
            qslot[0] = it; qslot[1] = s_; }
        __syncthreads();
        const int item = __builtin_amdgcn_readfirstlane(qslot[0]); qcur = __builtin_amdgcn_readfirstlane(qslot[1]);
        __syncthreads();
        if (item < 0) break;
        const int q = item >> 8, idx = item & 255;
        int b, h, qrow0, nlat;
        if (idx < 128) { const int bh = q * 4 + (idx >> 5); b = bh >> 2; h = bh & 3; qrow0 = b * SEQ + (idx & 31) * 128; nlat = SEQ / 64; }
        else { const int it = idx - 128, bh = q * 4 + (it >> 1); b = bh >> 2; h = bh & 3; qrow0 = TL + b * NCTX + (it & 1) * 128; nlat = 0; }
        fa::attn_unit(Q, Kb, Vb, hb, qrow0, h, b * SEQ, nlat, TL + b * NCTX, nlat + NCTX / 64, lam, 1.f - lam_init, subln, (LAS char*)c.lds);
    }
}


__device__ __forceinline__ void ph_s5_prep(const Ctx& c) {
    LAS float* PW = (LAS float*)c.lds;
    LAS float* BB = PW + 2 * 64 * 33 * 2;
    LAS float* CC = BB + 2 * 64 * 16 * 2;
    LAS float* KL = CC + 2 * 16 * 64 * 2;
    LAS float* FF = KL + 63 * 256;
    const int tid = c.tid;
#pragma unroll 1
    for (int item = c.bid; item < 256; item += c.G) {
        const int l = item >> 7, g = (item >> 3) & 15, part = item & 7;
        bf16_t* Mt = c.wsp<bf16_t>(ws_s5m(l)); bf16_t* Ft = c.wsp<bf16_t>(ws_s5f(l)); float* D32 = (float*)(c.ws() + ws_s5g(l) + 256 * 1024);
        if (tid < 128) { const int dir = tid >> 6, p = tid & 63; const int pi = ((l * 2 + dir) * 16 + g) * 64 + p;
            const float lr = c.in(I_S5LRE)[pi], li = c.in(I_S5LIM)[pi], step = __expf(c.in(I_S5STEP)[(l * 2 + dir) * 16 + g]);
            const float mag = __expf(lr * step); const float are = mag * __cosf(li * step), aim = mag * __sinf(li * step);
            const float den = lr * lr + li * li, nr = are - 1.f, ni = aim; FF[tid * 2] = (nr * lr + ni * li) / den; FF[tid * 2 + 1] = (ni * lr - nr * li) / den;
            float pr = 1.f, pim = 0.f; LAS float* pw = PW + (dir * 64 + p) * 66;
            for (int m = 0; m <= 32; ++m) { pw[2 * m] = pr; pw[2 * m + 1] = pim; const float nr2 = pr * are - pim * aim, ni2 = pr * aim + pim * are; pr = nr2; pim = ni2; }
            if (part == 0) { D32[((dir * 16 + g) * 64 + p) * 2] = pw[64]; D32[((dir * 16 + g) * 64 + p) * 2 + 1] = pw[65]; } }
        __syncthreads();
        for (int idx = tid; idx < 2048; idx += 512) { const int dir = idx >> 10, rem = idx & 1023;
            const size_t base = ((size_t)(l * 2 + dir) * 16 + g) * 1024 + rem; const float br = c.in(I_S5BRE)[base], bi = c.in(I_S5BIM)[base]; const int p = rem >> 4;
            const float fre = FF[(dir * 64 + p) * 2], fim = FF[(dir * 64 + p) * 2 + 1];
            BB[(dir * 1024 + rem) * 2] = fre * br - fim * bi; BB[(dir * 1024 + rem) * 2 + 1] = fre * bi + fim * br;
            CC[(dir * 1024 + rem) * 2] = c.in(I_S5CRE)[base]; CC[(dir * 1024 + rem) * 2 + 1] = c.in(I_S5CIM)[base]; }
        __syncthreads();
        const int lg_lo = 4 * part, nlg = 35;
        for (int idx = tid; idx < nlg * 64; idx += 512) { const int h4 = (idx & 3) * 4, t_ = idx >> 2, lg = lg_lo + t_ % nlg, ho = t_ / nlg, lag = lg - 31; f32x4 acc = {0.f, 0.f, 0.f, 0.f};
#pragma unroll 1
            for (int dir = 0; dir < 2; ++dir) { if ((dir == 0 && lag < 0) || (dir == 1 && lag > 0)) continue; const int m = lag < 0 ? -lag : lag;
#pragma unroll 4
                for (int p = 0; p < 64; ++p) { const float cr = CC[((dir * 16 + ho) * 64 + p) * 2], ci = CC[((dir * 16 + ho) * 64 + p) * 2 + 1], pr = PW[(dir * 64 + p) * 66 + 2 * m], pi2 = PW[(dir * 64 + p) * 66 + 2 * m + 1];
                    const float gr = cr * pr - ci * pi2, gi = cr * pi2 + ci * pr;
                    const f32x4 b0 = *(const LAS f32x4*)(BB + ((dir * 64 + p) * 16 + h4) * 2), b1 = *(const LAS f32x4*)(BB + ((dir * 64 + p) * 16 + h4 + 2) * 2);
                    acc[0] += gr * b0[0] - gi * b0[1]; acc[1] += gr * b0[2] - gi * b0[3]; acc[2] += gr * b1[0] - gi * b1[1]; acc[3] += gr * b1[2] - gi * b1[3]; } }
            if (lag == 0 && ho >= h4 && ho < h4 + 4) { const float dv = c.in(I_S5D)[l * 256 + g * 16 + ho];
#pragma unroll
                for (int e = 0; e < 4; ++e) if (ho == h4 + e) acc[e] += dv; }
            *(LAS f32x4*)(KL + lg * 256 + ho * 16 + h4) = acc; }
        __syncthreads();
        for (int idx = tid; idx < 64 * 96; idx += 512) { const int n = part * 64 + idx / 96, k8 = (idx % 96) * 8, ko = n >> 4, ho = n & 15; float v[8];
            if (k8 < 512) { const int ki = k8 >> 4, h0 = k8 & 15;
#pragma unroll
                for (int e = 0; e < 8; ++e) v[e] = KL[((ko - ki + 31) * 16 + ho) * 16 + h0 + e]; }
            else { const int q = k8 - 512, dir = q >> 7, p0 = (q & 127) >> 1; const int ex = dir == 0 ? ko + 1 : 32 - ko;
#pragma unroll
                for (int e = 0; e < 4; ++e) { const int p = p0 + e; const float cr = CC[((dir * 16 + ho) * 64 + p) * 2], ci = CC[((dir * 16 + ho) * 64 + p) * 2 + 1], pr = PW[(dir * 64 + p) * 66 + 2 * ex], pi2 = PW[(dir * 64 + p) * 66 + 2 * ex + 1];
                    v[2 * e] = cr * pr - ci * pi2; v[2 * e + 1] = -(cr * pi2 + ci * pr); } }
            u32x4 w; w.x = pk2(v[0], v[1]); w.y = pk2(v[2], v[3]); w.z = pk2(v[4], v[5]); w.w = pk2(v[6], v[7]);
            *(u32x4*)(Mt + ((size_t)g * 512 + n) * 768 + k8) = w; }
        for (int idx = tid; idx < 32 * 64; idx += 512) { const int r = part * 32 + (idx >> 6), k8 = (idx & 63) * 8, dir = r >> 7, p = (r & 127) >> 1, cpart = r & 1, ki = k8 >> 4, h0 = k8 & 15; const int ex = dir == 0 ? 31 - ki : ki;
            const float pr = PW[(dir * 64 + p) * 66 + 2 * ex], pi2 = PW[(dir * 64 + p) * 66 + 2 * ex + 1]; float v[8];
#pragma unroll
            for (int e = 0; e < 8; ++e) { const float br = BB[((dir * 64 + p) * 16 + h0 + e) * 2], bi = BB[((dir * 64 + p) * 16 + h0 + e) * 2 + 1]; v[e] = cpart == 0 ? pr * br - pi2 * bi : pr * bi + pi2 * br; }
            u32x4 w; w.x = pk2(v[0], v[1]); w.y = pk2(v[2], v[3]); w.z = pk2(v[4], v[5]); w.w = pk2(v[6], v[7]);
            *(u32x4*)(Ft + ((size_t)g * 256 + r) * 512 + k8) = w; }
        __syncthreads();
    }
    { LAS float* scr = (LAS float*)(c.lds + c.wave * 16640);
      for (int it = c.gw; it < 32; it += c.NGW) { const int l = it >> 4, kb = (it >> 2) & 3, nb = it & 3; tr_item64(c.in(I_S5WGLU) + (size_t)l * 65536, 256, 256, kb * 64, nb * 64, c.wsp<bf16_t>(ws_s5g(l)), 256, nb * 64, false, scr, c.lane); } }
}
__device__ __forceinline__ void ph_s5_scan(const Ctx& c, int l) {
    bf16_t* A = c.wsp<bf16_t>(WS_S5A); const float* L = c.wsp<float>(WS_S5L); const float* D32 = (const float*)(c.ws() + ws_s5g(l) + 256 * 1024);
    if (c.bid < 64 || c.bid >= 96) return;
    for (int idx = (c.bid - 64) * 512 + c.tid; idx < NB * 16 * 2 * 64; idx += 32 * 512) {
        const int p = idx & 63, dir = (idx >> 6) & 1, g = (idx >> 7) & 15, b = idx >> 11;
        const float dr = D32[((dir * 16 + g) * 64 + p) * 2], di = D32[((dir * 16 + g) * 64 + p) * 2 + 1];
        float sr = 0.f, si = 0.f;
#pragma unroll 1
        for (int n0 = 0; n0 < 136; n0 += 8) {
            f32x2 lv[8]; size_t rows[8];
#pragma unroll
            for (int q = 0; q < 8; ++q) { const int n = n0 + q; const int cc = dir == 0 ? n : (n < 8 ? 7 - n : 143 - n); rows[q] = (size_t)g * S5R + b * 136 + cc; lv[q] = *(const f32x2*)(L + rows[q] * 256 + dir * 128 + 2 * p); }
#pragma unroll
            for (int q = 0; q < 8; ++q) { *(unsigned*)(A + rows[q] * 768 + 512 + dir * 128 + 2 * p) = pk2(sr, si);
                const float nr = dr * sr - di * si + lv[q][0], ni = dr * si + di * sr + lv[q][1]; sr = nr; si = ni; }
        }
    }
}

namespace gdn {
using f32x16 = __attribute__((ext_vector_type(16))) float;
__device__ __forceinline__ int crow(int r, int hi) { return (r & 3) + 8 * (r >> 2) + 4 * hi; }
__device__ __forceinline__ int chunk_row0(int b, int ck) { return ck < 4 ? TL + b * NCTX + 64 * ck : b * SEQ + 64 * (ck - 4); }
}

__device__ __forceinline__ void ph_gdn_g1(const Ctx& c, int l, int nsteps = 9) {
    using namespace gdn;
    constexpr int XS = 129;
    LAS bf16_t* qs = (LAS bf16_t*)c.lds;
    LAS bf16_t* ks = qs + 4096; LAS bf16_t* vs = ks + 4096;
    LAS float* AT = (LAS float*)(c.lds + 24576);
    LAS float* X = AT + 8192;
    LAS float* bet = X + 2 * 64 * XS;
    LAS float* gg = bet + 128;
    LAS float* gcs = gg + 128;
    LAS float* betp = gcs + 128;
    LAS bf16_t* QKs = (LAS bf16_t*)(betp + 128);
    LAS float* esc = (LAS float*)(QKs + 8192);
    LAS float* eg = esc + 128;
    LAS float* egl = eg + 128;
    constexpr int XTLD = 72;
    LAS bf16_t* XT = (LAS bf16_t*)X;
    const bf16_t* Gq = c.wsp<bf16_t>(WS_G); const float* BA = c.wsp<float>(WS_BA);
    const float* cw = c.in(I_GCONV) + (size_t)l * 5 * 768;
    float* GLp = c.wsp<float>(WS_GL);
#pragma unroll 1
    for (int u = c.bid; u < NGU; u += c.G) {
        int tid = threadIdx.x; asm volatile("" : "+v"(tid));
        const int lane = tid & 63, wave = __builtin_amdgcn_readfirstlane(tid >> 6), r32 = lane & 31, hi = lane >> 5;
        const int ck = u % 68, bh = u / 68, h = bh & 3, b = bh >> 2;
        const int row0 = chunk_row0(b, ck);
        const int segbase = ck < 4 ? TL + b * NCTX : b * SEQ, seglen = ck < 4 ? NCTX : SEQ;
        unsigned char* rec0 = c.ws() + WS_REC0 + (size_t)u * REC_BYTES; unsigned char* rec1 = c.ws() + WS_REC1 + (size_t)u * REC_BYTES;
        { const int i = tid >> 3, part = tid & 7; const int t = row0 - segbase + i;
#pragma unroll
          for (int m = 0; m < 3; ++m) { const int ch = m * 256 + h * 64 + part * 8; float acc[8];
#pragma unroll
              for (int e = 0; e < 8; ++e) acc[e] = 0.f;
#pragma unroll
              for (int j = 0; j < 5; ++j) { const int tt = t + j - 2; const bool ok = tt >= 0 && tt < seglen; const int tc = tt < 0 ? 0 : (tt >= seglen ? seglen - 1 : tt);
                  const bf16x8 x = *(const bf16x8*)(Gq + (size_t)(segbase + tc) * 768 + ch); const float mk = ok ? 1.f : 0.f; const f32x4 w0 = *(const f32x4*)(cw + j * 768 + ch) * mk, w1 = *(const f32x4*)(cw + j * 768 + ch + 4) * mk;
#pragma unroll
                  for (int e = 0; e < 4; ++e) { acc[e] += w0[e] * bf2f((unsigned short)x[e]); acc[4 + e] += w1[e] * bf2f((unsigned short)x[4 + e]); } }
              float ss = 0.f;
#pragma unroll
              for (int e = 0; e < 8; ++e) { acc[e] = siluf(acc[e]); ss += acc[e] * acc[e]; }
              if (m < 2) { ss += __shfl_xor(ss, 1); ss += __shfl_xor(ss, 2); ss += __shfl_xor(ss, 4); const float rr = rsqrtf(ss + EPS) * (m == 0 ? 0.125f : 1.f);
#pragma unroll
                  for (int e = 0; e < 8; ++e) acc[e] *= rr; }
              u32x4 w; w.x = pk2(acc[0], acc[1]); w.y = pk2(acc[2], acc[3]); w.z = pk2(acc[4], acc[5]); w.w = pk2(acc[6], acc[7]);
              *(LAS u32x4*)((m == 0 ? qs : (m == 1 ? ks : vs)) + i * 64 + part * 8) = w; }
          if (part < 2) { const int dir = part; const float xb = BA[(size_t)(row0 + i) * 16 + dir * 4 + h], xa = BA[(size_t)(row0 + i) * 16 + 8 + dir * 4 + h] + c.in(I_GDT)[l * 8 + dir * 4 + h];
              const float sp = xa > 20.f ? xa : (xa < -15.f ? __expf(xa) : __logf(1.f + __expf(xa)));
              bet[dir * 64 + i] = sigmf(xb); gg[dir * 64 + i] = -__expf(c.in(I_GALOG)[l * 8 + dir * 4 + h]) * sp; } }
        __syncthreads();
        if (nsteps < 2) continue;
        if ((wave & 3) == 0) { const int dir = wave >> 2; const int pi = dir ? 63 - lane : lane; float g = gg[dir * 64 + pi];
#pragma unroll
            for (int ofs = 1; ofs < 64; ofs <<= 1) { const float o_ = __shfl_up(g, ofs); if (lane >= ofs) g += o_; }
            const float bp = bet[dir * 64 + pi], e_ = __expf(g), gl_ = __shfl(g, 63);
            gcs[dir * 64 + lane] = g; betp[dir * 64 + lane] = bp; esc[dir * 64 + lane] = bp * e_; eg[dir * 64 + lane] = e_; egl[dir * 64 + lane] = __expf(gl_ - g); }
        __syncthreads();
        { const int mat = wave >> 2, rt = (wave >> 1) & 1, ct = wave & 1; const LAS bf16_t* As = mat ? qs : ks; f32x16 acc = ozero16();
#pragma unroll
          for (int sx = 0; sx < 4; ++sx) { const bf16x8 a = *(const LAS bf16x8*)(As + (32 * rt + r32) * 64 + 16 * sx + 8 * hi), bb = *(const LAS bf16x8*)(ks + (32 * ct + r32) * 64 + 16 * sx + 8 * hi);
              acc = __builtin_amdgcn_mfma_f32_32x32x16_bf16(a, bb, acc, 0, 0, 0); }
#pragma unroll
          for (int dir = 0; dir < 2; ++dir) {
              const int colo = 32 * ct + r32, j = dir ? 63 - colo : colo; const float gj = gcs[dir * 64 + j];
#pragma unroll
              for (int r = 0; r < 16; ++r) { const int rowo = 32 * rt + crow(r, hi), i = dir ? 63 - rowo : rowo; const float gi = gcs[dir * 64 + i];
                  if (mat == 0) { if (j < i) AT[dir * 4096 + i * 64 + j] = betp[dir * 64 + i] * acc[r] * __expf(gi - gj); }
                  else QKs[dir * 4096 + i * 64 + j] = (bf16_t)f2bf(j <= i ? acc[r] * __expf(gi - gj) : 0.f); } } }
        __syncthreads();
        if (nsteps < 3) continue;
        { const LAS u32x4* QK4 = (const LAS u32x4*)QKs;
#pragma unroll
          for (int q = 0; q < 2; ++q) { const int idx = tid + 512 * q, dir = idx >> 9, ch = idx & 511; *(u32x4*)((dir ? rec1 : rec0) + 32768 + ch * 16) = QK4[dir * 512 + ch]; }
#pragma unroll
          for (int q = 0; q < 2; ++q) { const int idx = tid + 512 * q, dir = idx >> 9, i = (idx >> 3) & 63, d8 = (idx & 7) * 8, pi = dir ? 63 - i : i; const float sc = eg[dir * 64 + i];
              const bf16x8 x = *(const LAS bf16x8*)(qs + pi * 64 + d8); u32x4 w;
              w.x = pk2(bf2f((unsigned short)x[0]) * sc, bf2f((unsigned short)x[1]) * sc); w.y = pk2(bf2f((unsigned short)x[2]) * sc, bf2f((unsigned short)x[3]) * sc);
              w.z = pk2(bf2f((unsigned short)x[4]) * sc, bf2f((unsigned short)x[5]) * sc); w.w = pk2(bf2f((unsigned short)x[6]) * sc, bf2f((unsigned short)x[7]) * sc);
              *(u32x4*)((dir ? rec1 : rec0) + 16384 + (i * 64 + d8) * 2) = w; }
#pragma unroll
          for (int q = 0; q < 2; ++q) { const int idx = tid + 512 * q, dir = idx >> 9, d = (idx >> 3) & 63, i8 = (idx & 7) * 8; float v[8];
              const f32x4 s0 = *(const LAS f32x4*)(egl + dir * 64 + i8), s1 = *(const LAS f32x4*)(egl + dir * 64 + i8 + 4);
#pragma unroll
              for (int e = 0; e < 8; ++e) { const int ii = i8 + e, pii = dir ? 63 - ii : ii; v[e] = bf2f(ks[pii * 64 + d]) * (e < 4 ? s0[e & 3] : s1[e & 3]); }
              u32x4 w; w.x = pk2(v[0], v[1]); w.y = pk2(v[2], v[3]); w.z = pk2(v[4], v[5]); w.w = pk2(v[6], v[7]);
              *(u32x4*)((dir ? rec1 : rec0) + 24576 + (d * 64 + i8) * 2) = w; }
          if (tid < 2) GLp[tid * NGU + u] = eg[tid * 64 + 63]; }
        __syncthreads();
        if (nsteps < 4) continue;
        const int dir = wave >> 2;
        LAS bf16_t* Ub = QKs;
        if (tid < 128) { const int d_ = tid >> 6, blk = (tid >> 4) & 3, cc = tid & 15; const LAS float* Ab = AT + d_ * 4096 + (16 * blk) * 64 + 16 * blk; float x[16];
#pragma unroll
            for (int r = 0; r < 16; ++r) x[r] = (r == cc) ? 1.f : 0.f;
#pragma unroll
            for (int r = 1; r < 16; ++r) { f32x4 a[4];
#pragma unroll
                for (int q = 0; q < 4; ++q) if (4 * q < r) a[q] = *(const LAS f32x4*)(Ab + r * 64 + 4 * q);
                float acc = x[r];
#pragma unroll
                for (int c2 = 0; c2 < r; ++c2) acc -= a[c2 >> 2][c2 & 3] * x[c2];
                x[r] = acc; }
            LAS bf16_t* up = Ub + ((d_ * 4 + blk) * 16) * 16 + cc;
#pragma unroll
            for (int r = 0; r < 16; ++r) up[r * 16] = (bf16_t)f2bf(x[r]); }
        __syncthreads();
        { const int fr = lane & 15, g = lane >> 4, dw = wave & 3; const LAS float* A = AT + dir * 4096;
          LAS bf16_t* XTd = XT + dir * 128 * XTLD; const LAS bf16_t* Ud = Ub + dir * 4 * 256;
#pragma unroll
          for (int i = 0; i < 4; ++i) {
#pragma unroll
              for (int tt = 0; tt < 2; ++tt) { const int ct = dw * 2 + tt, col = 16 * ct + fr; f32x4 acc;
                  const LAS bf16_t* src = (ct < 4 ? vs : ks) + (col & 63); const LAS float* scp = (ct < 4 ? betp : esc) + dir * 64;
#pragma unroll
                  for (int r = 0; r < 4; ++r) { const int row = 16 * i + 4 * g + r, pi = dir ? 63 - row : row; acc[r] = scp[row] * bf2f(src[pi * 64]); }
#pragma unroll
                  for (int kk = 0; kk < (i + 1) / 2; ++kk) { const LAS float* ap = A + (16 * i + fr) * 64 + 32 * kk + 8 * g;
                      const f32x4 a0 = *(const LAS f32x4*)ap, a1 = *(const LAS f32x4*)(ap + 4); const bool ok = 32 * kk + 8 * g < 16 * i;
                      u32x4 aw; aw.x = ok ? pk2(-a0[0], -a0[1]) : 0u; aw.y = ok ? pk2(-a0[2], -a0[3]) : 0u; aw.z = ok ? pk2(-a1[0], -a1[1]) : 0u; aw.w = ok ? pk2(-a1[2], -a1[3]) : 0u;
                      u32x4 bw = *(const LAS u32x4*)(XTd + col * XTLD + 32 * kk + 8 * g); if (!ok) bw = (u32x4){0u, 0u, 0u, 0u};
                      const bf16x8 bfr = __builtin_bit_cast(bf16x8, bw);
                      acc = __builtin_amdgcn_mfma_f32_16x16x32_bf16(__builtin_bit_cast(bf16x8, aw), bfr, acc, 0, 0, 0); }
                  const u32x2 uu = *(const LAS u32x2*)(Ud + (i * 16 + fr) * 16 + 4 * g);
                  const u32x4 uw = {uu.x, uu.y, 0u, 0u}, tw = {pk2(acc[0], acc[1]), pk2(acc[2], acc[3]), 0u, 0u};
                  const f32x4 xi = __builtin_amdgcn_mfma_f32_16x16x32_bf16(__builtin_bit_cast(bf16x8, uw), __builtin_bit_cast(bf16x8, tw), ozero4(), 0, 0, 0);
                  { u32x2 xw; xw.x = pk2(xi[0], xi[1]); xw.y = pk2(xi[2], xi[3]); *(LAS u32x2*)(XTd + col * XTLD + 16 * i + 4 * g) = xw; } }
              if (i < 3) __syncthreads(); } }
        __syncthreads();
        if (nsteps < 5) continue;
        { const int ht = tid & 255; unsigned char* rec = dir ? rec1 : rec0; const LAS bf16_t* XTd = XT + dir * 128 * XTLD;
#pragma unroll
          for (int q = 0; q < 2; ++q) { const int idx = ht + 256 * q, dv = idx >> 3, c8 = (idx & 7) * 8; *(u32x4*)(rec + (dv * 64 + c8) * 2) = *(const LAS u32x4*)(XTd + dv * XTLD + c8); }
#pragma unroll
          for (int q = 0; q < 2; ++q) { const int idx = ht + 256 * q, ci = idx >> 3, d8 = (idx & 7) * 8; unsigned v[8];
#pragma unroll
              for (int e = 0; e < 8; ++e) v[e] = (unsigned)XTd[(64 + d8 + e) * XTLD + ci] ^ 0x8000u;
              u32x4 w; w.x = v[0] | (v[1] << 16); w.y = v[2] | (v[3] << 16); w.z = v[4] | (v[5] << 16); w.w = v[6] | (v[7] << 16); *(u32x4*)(rec + 8192 + (ci * 64 + d8) * 2) = w; } }
        __syncthreads();
    }
}
struct G2Ops { bf16x8 A1[4], A2[4]; u32x2 ut[4]; float glast; int row0; };
__device__ __forceinline__ void ph_gdn_g2(const Ctx& c, int l) {
    using namespace gdn;
    LAS bf16_t* ST = (LAS bf16_t*)c.lds;
    LAS bf16_t* VT = ST + 4096;
    bf16_t* GO = c.wsp<bf16_t>(WS_GO); const float* GLp = c.wsp<float>(WS_GL);
    const int tid = c.tid, lane = c.lane, wave = c.wave, r32 = lane & 31, hi = lane >> 5, role = wave >> 2, rt = (wave >> 1) & 1, ct = wave & 1;
#define G2_LOAD(OP, n_) do { const int n__ = (n_); const int ck_ = dir == 0 ? n__ : (n__ < 4 ? 3 - n__ : 71 - n__); const int u_ = bh * 68 + ck_; \
        const unsigned char* rec_ = wsb + (dir ? WS_REC1 : WS_REC0) + (size_t)u_ * REC_BYTES; OP.glast = GLp[dir * NGU + u_]; OP.row0 = chunk_row0(b, ck_); \
        const bf16_t* a1_ = (const bf16_t*)(rec_ + (role ? 16384 : 8192)) + (size_t)(32 * rt + r32) * 64 + 8 * hi; const bf16_t* a2_ = (const bf16_t*)(rec_ + (role ? 32768 : 24576)) + (size_t)(32 * rt + r32) * 64 + 8 * hi; \
        _Pragma("unroll") for (int sx = 0; sx < 4; ++sx) { OP.A1[sx] = *(const bf16x8*)(a1_ + 16 * sx); OP.A2[sx] = *(const bf16x8*)(a2_ + 16 * sx); } \
        const bf16_t* ut_ = (const bf16_t*)rec_ + (size_t)(32 * ct + r32) * 64 + 32 * rt + 4 * hi; \
        _Pragma("unroll") for (int g = 0; g < 4; ++g) OP.ut[g] = *(const u32x2*)(ut_ + 8 * g); } while (0)
#define G2_STEP(OP) do { \
        f32x16 acc = ozero16(); \
        if (role == 0) { _Pragma("unroll") for (int g = 0; g < 4; ++g) { const u32x2 w = OP.ut[g]; acc[4 * g] = __builtin_bit_cast(float, w.x << 16); acc[4 * g + 1] = __builtin_bit_cast(float, w.x & 0xffff0000u); \
            acc[4 * g + 2] = __builtin_bit_cast(float, w.y << 16); acc[4 * g + 3] = __builtin_bit_cast(float, w.y & 0xffff0000u); } } \
        _Pragma("unroll") for (int sx = 0; sx < 4; ++sx) { const bf16x8 bs = *(const LAS bf16x8*)(ST + (32 * ct + r32) * 64 + 16 * sx + 8 * hi); acc = __builtin_amdgcn_mfma_f32_32x32x16_bf16(OP.A1[sx], bs, acc, 0, 0, 0); } \
        if (role == 0) { _Pragma("unroll") for (int g = 0; g < 4; ++g) { u32x2 w; w.x = pk2(acc[4 * g], acc[4 * g + 1]); w.y = pk2(acc[4 * g + 2], acc[4 * g + 3]); *(LAS u32x2*)(VT + (32 * ct + r32) * 64 + 32 * rt + 8 * g + 4 * hi) = w; } } \
        __syncthreads(); \
        if (role == 0) { Sacc = Sacc * OP.glast; \
            _Pragma("unroll") for (int sx = 0; sx < 4; ++sx) { const bf16x8 bv = *(const LAS bf16x8*)(VT + (32 * ct + r32) * 64 + 16 * sx + 8 * hi); Sacc = __builtin_amdgcn_mfma_f32_32x32x16_bf16(OP.A2[sx], bv, Sacc, 0, 0, 0); } \
            _Pragma("unroll") for (int g = 0; g < 4; ++g) { u32x2 w; w.x = pk2(Sacc[4 * g], Sacc[4 * g + 1]); w.y = pk2(Sacc[4 * g + 2], Sacc[4 * g + 3]); *(LAS u32x2*)(ST + (32 * ct + r32) * 64 + 32 * rt + 8 * g + 4 * hi) = w; } \
        } else { \
            _Pragma("unroll") for (int sx = 0; sx < 4; ++sx) { const bf16x8 bv = *(const LAS bf16x8*)(VT + (32 * ct + r32) * 64 + 16 * sx + 8 * hi); acc = __builtin_amdgcn_mfma_f32_32x32x16_bf16(OP.A2[sx], bv, acc, 0, 0, 0); } \
            _Pragma("unroll") for (int r = 0; r < 16; ++r) { const int i = 32 * rt + crow(r, hi); const int pi = dir ? 63 - i : i; GO[((size_t)dir * MT + OP.row0 + pi) * 256 + h * 64 + 32 * ct + r32] = (bf16_t)f2bf(acc[r]); } \
        } \
        __syncthreads(); } while (0)
#pragma unroll 1
    for (int item = c.bid; item < NB * 4 * 2; item += c.G) {
        const int dir = item & 1, bh = item >> 1, h = bh & 3, b = bh >> 2;
        const unsigned char* wsb = c.ws();
        for (int i = tid; i < 2048; i += 512) ((LAS unsigned*)ST)[i] = 0u;
        f32x16 Sacc = ozero16();
        G2Ops opA, opB;
        G2_LOAD(opA, 0);
        __syncthreads();
#pragma unroll 1
        for (int n = 0; n < 68; n += 2) {
            G2_LOAD(opB, n + 1);
            G2_STEP(opA);
            G2_LOAD(opA, n + 2 < 68 ? n + 2 : 67);
            G2_STEP(opB);
        }
    }
#undef G2_LOAD
#undef G2_STEP
}
__device__ __forceinline__ void ph_gdn_finish(const Ctx& c, int l, int nrows) {
    const bf16_t* GO = c.wsp<bf16_t>(WS_GO); const bf16_t* Z = c.wsp<bf16_t>(WS_Z); bf16_t* hb = c.wsp<bf16_t>(WS_HB);
    const float nw = c.in(I_GNORM)[l * 64 + c.lane];
    for (int m = c.gw; m < nrows; m += c.NGW) {
#pragma unroll
        for (int h = 0; h < 4; ++h) { const float os = bf2f(GO[(size_t)m * 256 + h * 64 + c.lane]) + bf2f(GO[((size_t)MT + m) * 256 + h * 64 + c.lane]); const float ms = wave_sum(os * os) * (1.f / 64.f);
            const float z = bf2f(Z[(size_t)m * 256 + h * 64 + c.lane]); hb[(size_t)m * DM + 768 + h * 64 + c.lane] = (bf16_t)f2bf(os * rsqrtf(ms + EPS) * nw * siluf(z)); }
    }
}

__device__ __forceinline__ void ph_norm2(const Ctx& c, int l, int nrows) {
    const float* mods = c.wsp<float>(WS_MODS) + (size_t)l * 9 * 6144;
    bf16_t* hb = c.wsp<bf16_t>(WS_HB); bf16_t* lo = c.wsp<bf16_t>(WS_LO);
    for (int m = c.gw; m < nrows; m += c.NGW) { const int j = m < TL ? m / SEQ : 8;
        const float* xr = m < TL ? c.out() + (size_t)m * DM : c.wsp<float>(WS_XC) + (size_t)(m - TL) * DM;
        norm_mod_row<true>(xr, c.in(I_N2W) + l * DM, mods + j * 6144 + 4 * 1024, mods + j * 6144 + 3 * 1024, hb + (size_t)m * DM, lo + (size_t)m * DM, c.lane); }
}
__device__ __forceinline__ void ph_wr2(const Ctx& c, int l) {
    const float* W = c.in(I_WR) + (size_t)l * 65536; bf16_t* WR2 = c.wsp<bf16_t>(WS_WR2);
    for (int idx = c.bid * 512 + c.tid; idx < 2 * 256 * 128; idx += c.G * 512) { const int k8 = (idx & 127) * 8, n = (idx >> 7) & 255, g = idx >> 15;
        u32x4 w = {0u, 0u, 0u, 0u};
        const int kind = g == 0 ? (n < 64 ? 0 : (n < 128 ? 1 : 2)) : (n < 64 ? 0 : 2);
        if (kind < 2) { float v[8];
#pragma unroll
            for (int e = 0; e < 8; ++e) { const float x = W[(size_t)(k8 + e) * 64 + (n & 63)]; const float h = __builtin_bit_cast(float, f2bf(x) << 16); v[e] = kind == 0 ? x : x - h; }
            w.x = pk2(v[0], v[1]); w.y = pk2(v[2], v[3]); w.z = pk2(v[4], v[5]); w.w = pk2(v[6], v[7]); }
        *(u32x4*)(WR2 + ((size_t)g * 256 + n) * 1024 + k8) = w; }
}
constexpr int TOK_PER_BLK = 136;
constexpr size_t WS_BH = 9 * MiB + 512 * 1024;
__device__ __forceinline__ void ph_topk(const Ctx& c, int l, int nrows) {
    LAS int* hist = (LAS int*)c.lds;
    const float* lg = c.wsp<float>(WS_LOG); const float rbias = c.in(I_RB)[l * 64 + c.lane];
    int* tki = c.wsp<int>(WS_TKI); float* tkw = c.wsp<float>(WS_TKW); int* BH = c.wsp<int>(WS_BH);
    unsigned* cnt = c.wsp<unsigned>(WS_CTL) + CW_CNT + l * 128;
    if (c.tid < 64) hist[c.tid] = 0;
    __syncthreads();
    const int lane = c.lane, t_lo = c.bid * TOK_PER_BLK, t_hi = min(nrows, t_lo + TOK_PER_BLK);
    int mycount = 0;
    for (int t = t_lo + c.wave; t < t_hi; t += 8) {
        const float lgt = lg[(size_t)t * 128 + lane] + lg[(size_t)t * 128 + 64 + lane] + lg[((size_t)MT + t) * 128 + lane];
        const float sc = sigmf(lgt), s = sc + rbias;
        float m1 = s; m1 = fmaxf(m1, __shfl_xor(m1, 1)); m1 = fmaxf(m1, __shfl_xor(m1, 2)); m1 = fmaxf(m1, __shfl_xor(m1, 4));
        const unsigned long long eqm = __ballot(s == m1); const int gbase = lane & ~7; const unsigned gm = (unsigned)(eqm >> gbase) & 0xffu; const int first = gbase + __builtin_ctz(gm);
        float s2 = (lane == first) ? -3.0e38f : s; s2 = fmaxf(s2, __shfl_xor(s2, 1)); s2 = fmaxf(s2, __shfl_xor(s2, 2)); s2 = fmaxf(s2, __shfl_xor(s2, 4));
        const float gs = m1 + s2; const int g = lane >> 3;
        int grank = 0;
#pragma unroll
        for (int g2 = 0; g2 < 8; ++g2) { const float o = __builtin_bit_cast(float, __builtin_amdgcn_readlane(__builtin_bit_cast(int, gs), g2 * 8)); grank += (o > gs || (o == gs && g2 < g)) ? 1 : 0; }
        const float v = grank < 4 ? s : -3.0e38f;
        int rank = 0;
#pragma unroll
        for (int e2 = 0; e2 < 64; ++e2) { const float o = __builtin_bit_cast(float, __builtin_amdgcn_readlane(__builtin_bit_cast(int, v), e2)); rank += (o > v || (o == v && e2 < lane)) ? 1 : 0; }
        const bool chosen = rank < 8 && grank < 4;
        const float w = chosen ? sc : 0.f; const float wsum = wave_sum(w);
        if (chosen) { tki[(size_t)t * 8 + rank] = lane; tkw[(size_t)t * 8 + rank] = w * (2.5f / wsum); ++mycount; }
    }
    if (mycount) __hip_atomic_fetch_add(&hist[lane], mycount, __ATOMIC_RELAXED, __HIP_MEMORY_SCOPE_WORKGROUP);
    __syncthreads();
    if (c.tid < 64) { const int hv = hist[c.tid]; BH[c.bid * 64 + c.tid] = hv; if (hv > 0) atomicAdd(&cnt[c.tid], (unsigned)hv); }
}
__device__ __forceinline__ int moe_tstart(const Ctx& c, int l, int nrows, LAS int* tstart) {
    const unsigned* cnt = c.wsp<unsigned>(WS_CTL) + CW_CNT + l * 128;
    if (c.wave == 0) {
        const int n = (int)__hip_atomic_load(cnt + c.lane, __ATOMIC_RELAXED, __HIP_MEMORY_SCOPE_AGENT); const int t = (n + 255) >> 8; int inc = t;
#pragma unroll
        for (int ofs = 1; ofs < 64; ofs <<= 1) { const int o_ = __shfl_up(inc, ofs); if (c.lane >= ofs) inc += o_; }
        tstart[c.lane] = inc - t;
        if (c.lane == 63) { tstart[64] = inc; tstart[NE1] = inc + ((nrows + 255) >> 8); } }
    __syncthreads();
    return tstart[NE1];
}
__device__ __forceinline__ void ph_lists(const Ctx& c, int l, int nrows) {
    LAS int* tstart = (LAS int*)(c.lds + LDS_MISC - 1024);
    LAS int* base = (LAS int*)c.lds;
    moe_tstart(c, l, nrows, tstart);
    const unsigned* cnt = c.wsp<unsigned>(WS_CTL) + CW_CNT + l * 128; const int* BH = c.wsp<int>(WS_BH);
    const int* tki = c.wsp<int>(WS_TKI); const float* tkw = c.wsp<float>(WS_TKW);
    int* pos = c.wsp<int>(WS_POS); int* ltok = c.wsp<int>(WS_LTOK); float* lgate = c.wsp<float>(WS_LGATE);
    if (c.tid < 64) base[c.tid] = tstart[c.tid] * 256;
    __syncthreads();
    { const int e = c.tid & 63, part = c.tid >> 6; int acc = 0;
#pragma unroll 8
      for (int b2 = part; b2 < c.bid; b2 += 8) acc += BH[b2 * 64 + e];
      if (acc) __hip_atomic_fetch_add(&base[e], acc, __ATOMIC_RELAXED, __HIP_MEMORY_SCOPE_WORKGROUP); }
    __syncthreads();
    const int t_lo = c.bid * TOK_PER_BLK, t_hi = min(nrows, t_lo + TOK_PER_BLK);
    for (int idx = c.tid; idx < (t_hi - t_lo) * 8; idx += 512) { const int t = t_lo + (idx >> 3), k = idx & 7; const int e = tki[(size_t)t * 8 + k];
        const int p = __hip_atomic_fetch_add(&base[e], 1, __ATOMIC_RELAXED, __HIP_MEMORY_SCOPE_WORKGROUP);
        ltok[p] = t; lgate[p] = tkw[(size_t)t * 8 + k]; pos[(size_t)t * 8 + k] = p; }
    for (int t = t_lo + c.tid; t < t_hi; t += 512) { const int ps = tstart[64] * 256 + t; ltok[ps] = t; lgate[ps] = 1.f; }
    for (int e = c.bid; e < NE1; e += c.G) {
        const int n = e < 64 ? (int)__hip_atomic_load(cnt + e, __ATOMIC_RELAXED, __HIP_MEMORY_SCOPE_AGENT) : nrows; const int np = ((n + 255) >> 8) << 8;
        for (int j = n + c.tid; j < np; j += 512) { ltok[tstart[e] * 256 + j] = 0; lgate[tstart[e] * 256 + j] = 0.f; }
    }
}
__device__ __forceinline__ void ph_moe_reduce(const Ctx& c, int l, int q, int nrows) {
    LAS int* tstart = (LAS int*)(c.lds + LDS_MISC - 1024);
    moe_tstart(c, l, nrows, tstart);
    const int sbase = tstart[64] * 256;
    const unsigned char* ws = c.ws(); const int* pos = c.wsp<int>(WS_POS);
    const float* mods = c.wsp<float>(WS_MODS) + (size_t)l * 9 * 6144;
    typedef float f32x2v __attribute__((ext_vector_type(2)));
    int pn_[8];
    if (c.gw < nrows) {
#pragma unroll
        for (int k = 0; k < 8; ++k) pn_[k] = pos[(size_t)c.gw * 8 + k]; }
    for (int m = c.gw; m < nrows; m += c.NGW) {
        const int j = m < TL ? m / SEQ : 8;
        float* xr = (m < TL ? c.out() + (size_t)m * DM : c.wsp<float>(WS_XC) + (size_t)(m - TL) * DM) + 16 * c.lane;
        float* xw = q > 0 ? c.wsp<float>(WS_PROJ) + (size_t)m * DM + 16 * c.lane : xr;
        int pc_[8];
#pragma unroll
        for (int k = 0; k < 8; ++k) pc_[k] = pn_[k];
        if (m + c.NGW < nrows) {
#pragma unroll
            for (int k = 0; k < 8; ++k) pn_[k] = pos[(size_t)(m + c.NGW) * 8 + k]; }
        u32x4 w[9];
#pragma unroll
        for (int k = 0; k < 9; ++k) { const int p = k < 8 ? pc_[k] : sbase + m;
            const unsigned char* pr = p < PAIR_RA ? ws + WS_PAIRA + (size_t)p * 1024 : ws + WS_PAIRB + (size_t)(p - PAIR_RA) * 1024;
            w[k] = *(const u32x4*)(pr + 16 * c.lane); }
        float sacc[16];
#pragma unroll
        for (int e = 0; e < 16; ++e) sacc[e] = 0.f;
#pragma unroll
        for (int k = 0; k < 9; ++k)
#pragma unroll
            for (int d = 0; d < 4; ++d) { const int wd = (int)w[k][d]; const f32x2v lo = __builtin_amdgcn_cvt_pk_f32_fp8(wd, false), hi = __builtin_amdgcn_cvt_pk_f32_fp8(wd, true);
                sacc[4 * d] += lo[0]; sacc[4 * d + 1] += lo[1]; sacc[4 * d + 2] += hi[0]; sacc[4 * d + 3] += hi[1]; }
        const float* gp = mods + j * 6144 + 5 * 1024 + 16 * c.lane;
        f32x4 y[4]; float ss = 0.f;
#pragma unroll
        for (int d = 0; d < 4; ++d) { const f32x4 g = *(const f32x4*)(gp + 4 * d) * (1.f / PAIR_SCALE); const f32x4 sv = {sacc[4 * d], sacc[4 * d + 1], sacc[4 * d + 2], sacc[4 * d + 3]};
            y[d] = *(const f32x4*)(xr + 4 * d) + g * sv; ss += (y[d][0] * y[d][0] + y[d][1] * y[d][1]) + (y[d][2] * y[d][2] + y[d][3] * y[d][3]); }
        if (l == 1) { const float rstd = rsqrtf(wave_sum(ss) * (1.f / DM) + EPS); const float* fw = c.in(I_FNW) + 16 * c.lane;
#pragma unroll
            for (int d = 0; d < 4; ++d) y[d] = y[d] * rstd * *(const f32x4*)(fw + 4 * d); }
#pragma unroll
        for (int d = 0; d < 4; ++d) *(f32x4*)(xw + 4 * d) = y[d];
    }
}
__device__ __forceinline__ void ph_final(const Ctx& c) {
    const float* fw = c.in(I_FNW);
    for (int m = c.gw; m < TL; m += c.NGW) {
        float* xr = c.out() + (size_t)m * DM; f32x4 v[4]; float ss = 0.f;
#pragma unroll
        for (int j = 0; j < 4; ++j) { v[j] = ((const f32x4*)xr)[c.lane + 64 * j]; ss += (v[j][0] * v[j][0] + v[j][1] * v[j][1]) + (v[j][2] * v[j][2] + v[j][3] * v[j][3]); }
        const float rstd = rsqrtf(wave_sum(ss) * (1.f / DM) + EPS);
#pragma unroll
        for (int j = 0; j < 4; ++j) { const f32x4 w = *(const f32x4*)(fw + 4 * c.lane + 256 * j); ((f32x4*)xr)[c.lane + 64 * j] = v[j] * rstd * w; }
    }
}

enum { PH_PRE = 0, PH_B, PH_INP, PH_D, PH_D2, PH_E2, PH_E3, PH_OUTP, PH_N2, PH_N2B, PH_TOPK, PH_LISTS, PH_UP, PH_DOWN, PH_RED, PH_FINAL, PH_COUNT };

__device__ __forceinline__ void ph_ba(const Ctx& c) {
    const bf16_t* A = c.wsp<bf16_t>(WS_HB); const bf16_t* W = c.wsp<bf16_t>(WS_WIN) + (size_t)(NINP - 256) * 1024; float* BA = c.wsp<float>(WS_BA);
    int tid = c.tid; asm volatile("" : "+v"(tid));
    const int lane = tid & 63, fr = lane & 15, g = lane >> 4;
    constexpr int WLD = 1024 + 8;
    LAS bf16_t* Ws = (LAS bf16_t*)c.lds;
    __syncthreads();
#pragma unroll
    for (int q = 0; q < 4; ++q) { const int idx = tid + 512 * q, n = idx >> 7, k8 = (idx & 127) * 8; *(LAS u32x4*)(Ws + n * WLD + k8) = *(const u32x4*)(W + (size_t)n * 1024 + k8); }
    __syncthreads();
    const LAS bf16_t* wp = Ws + fr * WLD + 8 * g;
#pragma unroll 1
    for (int t = c.wave * c.G + c.bid; t < MT / 16; t += c.NGW) {
        const bf16_t* ap = A + (size_t)(t * 16 + fr) * 1024 + 8 * g;
        bf16x8 a[32];
#pragma unroll
        for (int kk = 0; kk < 32; ++kk) a[kk] = *(const bf16x8*)(ap + 32 * kk);
        f32x4 acc = ozero4();
#pragma unroll
        for (int kk = 0; kk < 32; ++kk) { const bf16x8 b = *(const LAS bf16x8*)(wp + 32 * kk); acc = __builtin_amdgcn_mfma_f32_16x16x32_bf16(a[kk], b, acc, 0, 0, 0); }
#pragma unroll
        for (int r = 0; r < 4; ++r) BA[(size_t)(t * 16 + 4 * g + r) * 16 + fr] = acc[r];
    }
    __syncthreads();
}
template <int PH> __device__ __forceinline__ void run_phase(const Ctx& c, int l, int q) {
    const int nrows_out = (l == 0) ? MT : TL;
    if constexpr (PH == PH_PRE) { ph_pre(c); __syncthreads(); ph_s5_prep(c); }
    if constexpr (PH == PH_B) { ph_wprep<0>(c, l); ph_norm1(c, l); }
    if constexpr (PH == PH_INP) {
        pg8::DenseSched<1024> S; S.init(c.wsp<void>(WS_HB), c.wsp<void>(WS_WIN), MT, NINP - 256, c.G, c.bid);
        EpiInProj E{c.ws(), c.wsp<f32x2>(WS_ROPE)};
        pg8::gemm_phase<1024>(c.lds, S, E);
        ph_ba(c);
    }
    if constexpr (PH == PH_D) {
        { GroupSched<512> S; S.A = c.wsp<char>(WS_S5A); S.a_gs = (size_t)S5R * 768 * 2; S.lda = 768; S.Bt = c.wsp<char>(ws_s5f(l)); S.b_gs = (size_t)256 * 512 * 2; S.nM = 5; S.nN = 1; S.nwg = 80; S.G = c.G; S.c = (c.bid + 128) & 255;
          EpiS5L E{c.wsp<float>(WS_S5L)}; pg8::gemm_phase<512>(c.lds, S, E); }
        __syncthreads();
        { int n_ = (DUP_SUB > 0 && DUP_SUB < 100) ? 2 : 1; asm volatile("" : "+s"(n_));
#pragma unroll 1
          for (int r_ = 0; r_ < n_; ++r_) { ph_gdn_g1(c, l, r_ == n_ - 1 ? 9 : DUP_SUB); __syncthreads(); } }
    }
    if constexpr (PH == PH_D2) { ph_gdn_g2(c, l); ph_s5_scan(c, l); __syncthreads(); ph_attn_fast(c, l, q); __syncthreads(); ph_wprep13_dyn(c, l, q);
        if (DUP_SUB == 101) { __syncthreads(); ph_attn_fast(c, l, q + 1); }
        if (DUP_SUB == 102) { __syncthreads(); ph_gdn_g2(c, l); }
        if (DUP_SUB == 103) { __syncthreads(); ph_s5_scan(c, l); } }
    if constexpr (PH == PH_E2) {
        ph_gdn_finish(c, l, nrows_out);
        { GroupSched<768> S; S.A = c.wsp<char>(WS_S5A); S.a_gs = (size_t)S5R * 768 * 2; S.lda = 768; S.Bt = c.wsp<char>(ws_s5m(l)); S.b_gs = (size_t)512 * 768 * 2; S.nM = 5; S.nN = 2; S.nwg = 160; S.G = c.G; S.c = c.bid;
          EpiS5Y E{c.wsp<bf16_t>(WS_ZS)}; pg8::gemm_phase<768>(c.lds, S, E); }
    }
    if constexpr (PH == PH_E3) {
        pg8::DenseSched<256> S; S.init(c.wsp<void>(WS_ZS), c.wsp<void>(ws_s5g(l)), nrows_out, 256, c.G, c.bid);
        EpiGlu E{c.wsp<bf16_t>(WS_ZS), c.wsp<bf16_t>(WS_HB), c.in(I_S5BGLU) + l * 256};
        pg8::gemm_phase<256>(c.lds, S, E);
    }
    if constexpr (PH == PH_OUTP) {
        pg8::DenseSched<1024> S; S.init(c.wsp<void>(WS_HB), c.wsp<void>(WS_WOUT), nrows_out, 1024, c.G, c.bid);
        EpiResid E{l == 0 ? c.in(I_X) : c.out(), l == 0 ? c.in(I_CTX) : c.wsp<float>(WS_XC), c.out(), c.wsp<float>(WS_XC), c.wsp<float>(WS_MODS) + (size_t)l * 9 * 6144, 2};
        pg8::gemm_phase<1024>(c.lds, S, E);
        if (l == 0) ph_wprep2_dyn(c, l, q);
    }
    if constexpr (PH == PH_N2) { ph_wr2(c, l); __syncthreads(); ph_norm2(c, l, nrows_out); }
    if constexpr (PH == PH_N2B) {
        GroupSched<1024> S; S.A = c.wsp<char>(WS_HB); S.a_gs = (size_t)(WS_LO - WS_HB); S.lda = 1024; S.Bt = c.wsp<char>(WS_WR2); S.b_gs = (size_t)256 * 1024 * 2; S.nM = nrows_out / 256; S.nN = 1; S.nwg = 2 * (nrows_out / 256); S.G = c.G; S.c = c.bid;
        EpiLogits E{c.wsp<float>(WS_LOG)}; pg8::gemm_phase<1024>(c.lds, S, E);
    }
    if constexpr (PH == PH_TOPK) { ph_topk(c, l, nrows_out); }
    if constexpr (PH == PH_LISTS) { ph_lists(c, l, nrows_out); }
    if constexpr (PH == PH_UP) {
        LAS int* tstart = (LAS int*)(c.lds + LDS_MISC - 1024);
        const int ntiles = moe_tstart(c, l, nrows_out, tstart);
        pg8::MoeSched<1024, true, true> S; S.A = c.wsp<char>(WS_HB); S.Bt = c.wsp<char>(WS_W13); S.ltok = c.wsp<int>(WS_LTOK); S.tstart = tstart; S.ntiles = ntiles; S.nN = 2; S.nwg = ntiles * 2; S.G = c.G; S.c = c.bid;
        S.bstride_e = (size_t)512 * 1024 * 2; S.bcol0 = 0;
        EpiMoeUp E{c.wsp<bf16_t>(WS_HID), c.wsp<float>(WS_LGATE)};
        pg8::gemm_phase<1024>(c.lds, S, E);
        if (l == 1) ph_wprep2_dyn(c, l, q);
    }
    if constexpr (PH == PH_DOWN) {
        LAS int* tstart = (LAS int*)(c.lds + LDS_MISC - 1024);
        const int ntiles = moe_tstart(c, l, nrows_out, tstart);
        pg8::MoeSched<256, false, true> S; S.A = c.wsp<char>(WS_HID); S.Bt = c.wsp<char>(WS_W2); S.ltok = nullptr; S.tstart = tstart; S.ntiles = ntiles; S.nN = 4; S.nwg = ntiles * 4; S.G = c.G; S.c = c.bid;
        S.bstride_e = (size_t)1024 * 256 * 2; S.bcol0 = 0;
        EpiMoeDown E{c.ws()};
        pg8::gemm_phase<256>(c.lds, S, E);
    }
    if constexpr (PH == PH_RED) { ph_moe_reduce(c, l, q, nrows_out); }
    if constexpr (PH == PH_FINAL) { ph_final(c); }
}

constexpr int LDS_PARAMS = LDS_MISC - 512;
__device__ __forceinline__ void stash_params(unsigned char* lds) {
    const __attribute__((address_space(4))) unsigned* ka = (const __attribute__((address_space(4))) unsigned*)__builtin_amdgcn_kernarg_segment_ptr();
    if (threadIdx.x < sizeof(Params) / 4) ((LAS unsigned*)((LAS unsigned char*)lds + LDS_PARAMS))[threadIdx.x] = ka[threadIdx.x];
    __syncthreads();
}
__device__ __forceinline__ Ctx make_ctx(unsigned char* lds) {
    Ctx c; c.pl = (const LAS unsigned*)((LAS unsigned char*)lds + LDS_PARAMS); c.lds = (LAS unsigned char*)lds; { int t_ = threadIdx.x; asm volatile("" : "+v"(t_)); c.tid = t_; } c.lane = c.tid & 63; c.wave = __builtin_amdgcn_readfirstlane(c.tid >> 6);
    c.G = gridDim.x; c.bid = blockIdx.x; c.gw = c.bid * 8 + c.wave; c.NGW = c.G * 8; return c;
}

template <int PH> __global__ void __launch_bounds__(512, 2) k_phase(Params p, int l, int q) {
    extern __shared__ __attribute__((aligned(16))) unsigned char lds[];
    stash_params(lds);
    const Ctx c = make_ctx(lds);
    run_phase<PH>(c, l, q);
}

#if ONE_LAUNCH
__global__ void __launch_bounds__(512, 2) k_mega(Params p) {
    extern __shared__ __attribute__((aligned(16))) unsigned char lds[];
    volatile LAS unsigned* misc = (volatile LAS unsigned*)((LAS unsigned char*)lds + LDS_MISC);
    if (threadIdx.x < 4) misc[threadIdx.x] = 0u;
    stash_params(lds);
    XcdBarrier bar = xcd_barrier_post((unsigned*)(p.ws + WS_CTL) + CW_BAR, misc);
#define GB() xcd_barrier(bar)
#ifndef REP_MASK
#define REP_MASK 0
#endif
#define RUN(PH, l, q) do { int n_ = ((REP_MASK >> PH) & 1) ? 2 : 1; asm volatile("" : "+s"(n_)); _Pragma("unroll 1") for (int r_ = 0; r_ < n_; ++r_) { if (r_) GB(); const Ctx c_ = make_ctx(lds); run_phase<PH>(c_, l, (q) + (n_ - 1 - r_)); } \
    if ((DUP_MASK >> PH) & 1) { GB(); const Ctx c2_ = make_ctx(lds); run_phase<PH>(c2_, l, (q) + 1); } } while (0)
    RUN(PH_PRE, 0, 0); GB();
#pragma unroll 1
    for (int l = 0; l < 2; ++l) {
        RUN(PH_B, l, 0); GB();
        RUN(PH_INP, l, 0); GB();
        RUN(PH_D, l, 0); GB();
        RUN(PH_D2, l, 0); GB();
        RUN(PH_E2, l, 0); GB();
        RUN(PH_E3, l, 0); GB();
        RUN(PH_OUTP, l, 0); GB();
        RUN(PH_N2, l, 0); GB();
        RUN(PH_N2B, l, 0); GB();
        RUN(PH_TOPK, l, 0); GB();
        RUN(PH_LISTS, l, 0); GB();
        RUN(PH_UP, l, 0); GB();
#pragma unroll 1
        RUN(PH_DOWN, l, 0); GB(); RUN(PH_RED, l, 0); if (l == 0) GB();
    }
#undef GB
#undef RUN
}
#endif


template <int PH> static void launch_phase(const Params& p, int l, int q, int grid, hipStream_t stream) {
    static bool attr = false;
    if (!attr) { (void)hipFuncSetAttribute((const void*)k_phase<PH>, hipFuncAttributeMaxDynamicSharedMemorySize, LDS_BYTES); attr = true; }
    hipLaunchKernelGGL(k_phase<PH>, dim3(grid), dim3(512), LDS_BYTES, stream, p, l, q);
}

extern "C" void kernel_launch(void* const* d_in, const int* in_sizes, int n_in, void* d_out, int out_size, void* d_ws, size_t ws_size, hipStream_t stream) {
    static int grid = 0;
    if (grid == 0) {
        if (n_in != 35 || out_size != TL * DM || ws_size < WS_END || (size_t)WS_END > ws_size) { fprintf(stderr, "kernel_launch: unexpected shapes n_in %d out %d ws %zu (need %zu)\n", n_in, out_size, ws_size, (size_t)WS_END); grid = -1; return; }
        int dev = 0, cus = 0;
        if (hipGetDevice(&dev) != hipSuccess || hipDeviceGetAttribute(&cus, hipDeviceAttributeMultiprocessorCount, dev) != hipSuccess) { grid = -1; return; }
#if ONE_LAUNCH
        (void)hipFuncSetAttribute((const void*)k_mega, hipFuncAttributeMaxDynamicSharedMemorySize, LDS_BYTES);
#endif
        grid = cus;
        if (grid != 256) { fprintf(stderr, "kernel_launch: built for a 256-CU device (got %d)\n", cus); grid = -1; return; }
    }
    if (grid < 0) return;
    (void)hipMemsetAsync((char*)d_ws + WS_CTL, 0, CTL_BYTES, stream);
    Params p{};
    for (int i = 0; i < 35; ++i) p.in[i] = (const float*)d_in[i];
    p.out = (float*)d_out; p.ws = (unsigned char*)d_ws;
#if ONE_LAUNCH
    hipLaunchKernelGGL(k_mega, dim3(grid), dim3(512), LDS_BYTES, stream, p);
#else
    launch_phase<PH_PRE>(p, 0, 0, grid, stream);
    for (int l = 0; l < 2; ++l) {
        launch_phase<PH_B>(p, l, 0, grid, stream);
        launch_phase<PH_INP>(p, l, 0, grid, stream);
        launch_phase<PH_D>(p, l, 0, grid, stream);
        launch_phase<PH_D2>(p, l, 0, grid, stream);
        launch_phase<PH_E2>(p, l, 0, grid, stream);
        launch_phase<PH_E3>(p, l, 0, grid, stream);
        launch_phase<PH_OUTP>(p, l, 0, grid, stream);
        launch_phase<PH_N2>(p, l, 0, grid, stream);
        launch_phase<PH_N2B>(p, l, 0, grid, stream);
        launch_phase<PH_TOPK>(p, l, 0, grid, stream);
        launch_phase<PH_LISTS>(p, l, 0, grid, stream);
        launch_phase<PH_UP>(p, l, 0, grid, stream);
        launch_phase<PH_DOWN>(p, l, 0, grid, stream); launch_phase<PH_RED>(p, l, 0, grid, stream);
    }
#endif
}
```

```cpp
#include <hip/hip_runtime.h>
#include <cstdio>
#include <cstdint>

#define ABL_ZERO_S5 0
#define ABL_ZERO_GDN 0
#define ABL_ZERO_ATT 0
#define ABL_NOCTXKEYS 0
#define ABL_CTXORIG 0
#define DBG_CHECK 0
#ifndef DUP_SUB
#define DUP_SUB 0
#endif
#ifndef ATT_X
#define ATT_X 0
#endif
#ifndef DUP_MASK
#define DUP_MASK 0
#endif
#ifndef ONE_LAUNCH
#define ONE_LAUNCH 1
#endif

#define LAS __attribute__((address_space(3)))
typedef unsigned short bf16_t;
typedef short bf16x8 __attribute__((ext_vector_type(8)));
typedef float f32x4 __attribute__((ext_vector_type(4)));
typedef float f32x2 __attribute__((ext_vector_type(2)));
typedef unsigned u32x4 __attribute__((ext_vector_type(4)));
typedef unsigned u32x2 __attribute__((ext_vector_type(2)));

constexpr int NB = 8, SEQ = 4096, DM = 1024, NCTX = 256;
constexpr int TL = NB * SEQ, TC = NB * NCTX, MT = TL + TC;
constexpr int NIN = 2832, NINP = 3072;
constexpr int NE1 = 65;
constexpr int PAIRS_PAD = 329728;
constexpr float EPS = 1e-6f;

constexpr size_t MiB = 1u << 20;
constexpr size_t WS_CTL = 0, CTL_BYTES = 1 * MiB;
constexpr size_t WS_MODS = 1 * MiB;
constexpr size_t WS_ROPE = 1 * MiB + 512 * 1024;
constexpr size_t WS_WIN = 2 * MiB;
constexpr size_t WS_WOUT = 8 * MiB;
constexpr size_t WS_W2 = 10 * MiB;
constexpr size_t WS_W13 = 43 * MiB;
constexpr size_t WS_HB = 108 * MiB;
constexpr size_t WS_XC = 365 * MiB;
constexpr size_t WS_WR2 = 8 * MiB;
constexpr size_t WS_TKI = 2 * MiB;
constexpr size_t WS_TKW = WS_TKI + 1152 * 1024;
constexpr size_t WS_POS = WS_TKW + 1152 * 1024;
constexpr size_t WS_LTOK = WS_POS + 1152 * 1024;
constexpr size_t WS_LGATE = WS_LTOK + 1344 * 1024;
constexpr size_t WS_PROJ = 204 * MiB;
constexpr size_t WS_Q = WS_PROJ, WS_K = WS_Q + 34 * MiB, WS_V = WS_K + 34 * MiB, WS_U = WS_V + 34 * MiB, WS_G = WS_U + 17 * MiB,
                 WS_Z = WS_G + 51 * MiB, WS_BA = WS_Z + 17 * MiB;
constexpr size_t WS_LOG = WS_PROJ;
constexpr size_t WS_HID = WS_PROJ;
constexpr size_t WS_MIX = 394 * MiB;
constexpr size_t WS_LO = WS_MIX;
constexpr size_t WS_S5A = WS_MIX;
constexpr size_t WS_S5L = WS_S5A + 30 * MiB;
constexpr size_t WS_S5M = WS_S5L + 20 * MiB;
constexpr size_t WS_S5F = WS_S5M + 12 * MiB;
constexpr size_t WS_S5G = WS_S5F + 4 * MiB;
constexpr size_t WS_REC1 = WS_S5G + 1 * MiB;
constexpr size_t WS_GL = WS_REC1 + 85 * MiB;
constexpr size_t WS_GO = WS_GL + 1 * MiB;
constexpr size_t WS_REC0 = WS_W2;
constexpr size_t WS_ZS = WS_U;
constexpr size_t REC_BYTES = 40960; constexpr int NGU = NB * 4 * 68;
static_assert((size_t)NGU * REC_BYTES <= 97 * MiB, "rec");
constexpr size_t WS_PAIRA = WS_W13;
constexpr size_t WS_PAIRB = 373 * MiB;
constexpr int PAIR_RA = 164864;
constexpr size_t WS_S5W1 = WS_GO + 34 * MiB;
constexpr size_t WS_END = WS_S5W1 + 17 * MiB;
constexpr int S5R = 1280, S5RV = 1088;
static_assert(WS_BA + (size_t)MT * 16 * 4 <= WS_MIX, "proj region");
static_assert(WS_HID + (size_t)PAIRS_PAD * 512 <= WS_MIX, "hid region");
static_assert(WS_PAIRA + (size_t)PAIR_RA * 1024 <= WS_HID && WS_PAIRB + (size_t)(PAIRS_PAD - PAIR_RA) * 1024 <= WS_END && WS_XC + 8 * MiB <= WS_PAIRB && WS_LGATE + 1344 * 1024 <= WS_WR2 && WS_HID + (size_t)PAIRS_PAD * 512 <= WS_XC, "pair region");
static_assert(WS_END <= 600 * MiB && WS_S5F == WS_S5M + 12 * MiB && WS_S5G == WS_S5F + 4 * MiB, "ws");
__host__ __device__ constexpr size_t ws_s5m(int l) { return l == 0 ? WS_S5M : WS_S5W1; }
__host__ __device__ constexpr size_t ws_s5f(int l) { return ws_s5m(l) + 12 * MiB; }
__host__ __device__ constexpr size_t ws_s5g(int l) { return ws_s5m(l) + 16 * MiB; }
static_assert(WS_REC1 + 85 * MiB <= WS_GL && WS_W2 + 33 * MiB <= WS_W13 && WS_W13 + 65 * MiB <= WS_HB, "mix");

constexpr int CW_BAR = 4096;
constexpr int CW_CNT = 16384;
constexpr int CW_FILL = 16384 + 256;
constexpr int CW_ATTQ = 16384 + 512;

constexpr int LDS_BYTES = 147456;
constexpr int LDS_MISC = 144 * 1024 - 256;

__device__ __forceinline__ float wave_sum(float v) {
#pragma unroll
    for (int o = 32; o > 0; o >>= 1) v += __shfl_xor(v, o);
    return v;
}
__device__ __forceinline__ unsigned f2bf(float f) { unsigned u = __builtin_bit_cast(unsigned, f); return (u + 0x7fffu + ((u >> 16) & 1u)) >> 16; }
__device__ __forceinline__ unsigned pk2(float lo, float hi) { return f2bf(lo) | (f2bf(hi) << 16); }
__device__ __forceinline__ float bf2f(unsigned short b) { return __builtin_bit_cast(float, ((unsigned)b) << 16); }
__device__ __forceinline__ float siluf(float x) { return x / (1.f + __expf(-x)); }
__device__ __forceinline__ float sigmf(float x) { return 1.f / (1.f + __expf(-x)); }
__device__ __forceinline__ int dimperm(int r) { return 16 * ((r >> 2) & 1) + 4 * (r >> 3) + (r & 3); }
#define LDS_WAIT() asm volatile("s_waitcnt lgkmcnt(0)" ::: "memory")
__device__ __forceinline__ float ozero() { float z; asm volatile("v_mov_b32 %0, 0" : "=v"(z)); return z; }
__device__ __forceinline__ f32x4 ozero4() { const float z = ozero(); return (f32x4){z, z, z, z}; }
typedef float f32x16_t __attribute__((ext_vector_type(16)));
__device__ __forceinline__ f32x16_t ozero16() { const float z = ozero(); return (f32x16_t){z, z, z, z, z, z, z, z, z, z, z, z, z, z, z, z}; }

struct Params {
    const float* in[35];
    float* out;
    unsigned char* ws;
};
enum { I_X = 0, I_C, I_CTX, I_CCTX, I_N1W, I_N2W, I_WMOD, I_BMOD, I_WIN, I_WOUT, I_DALAM, I_DASUB, I_S5LRE, I_S5LIM, I_S5STEP, I_S5BRE, I_S5BIM,
       I_S5CRE, I_S5CIM, I_S5D, I_S5WGLU, I_S5BGLU, I_GCONV, I_GALOG, I_GDT, I_GNORM, I_WR, I_RB, I_W1, I_W3, I_W2, I_WS1, I_WS3, I_WS2, I_FNW };

#define XB_TMO      128
#define XB_XCNT(j)  (256  + 64 * (j))
#define XB_XSUB(j)  (1280 + 64 * (j))
#define XB_XGEN(j)  (2304 + 64 * (j))
#define XB_TOP      3328
#define XB_TOPGEN   3392
#define XCD_BAR_WORDS 3456
#define XB_SPIN_CAP (1u << 22)
__device__ __forceinline__ unsigned xb_ld(unsigned* p)              { return __hip_atomic_load(p, __ATOMIC_RELAXED, __HIP_MEMORY_SCOPE_AGENT); }
__device__ __forceinline__ unsigned xb_add(unsigned* p, unsigned v) { return __hip_atomic_fetch_add(p, v, __ATOMIC_RELAXED, __HIP_MEMORY_SCOPE_AGENT); }
__device__ __forceinline__ unsigned xb_xcc_id() { return (unsigned)__builtin_amdgcn_s_getreg((3 << 11) | 20) & 0xFu; }
#define XB_SPIN(cond, bar) do { unsigned _sp = 0; while (cond) { __builtin_amdgcn_s_sleep(1); \
    if ((++_sp & 255u) == 0u) { if (xb_ld(&(bar)[XB_TMO])) break; if (_sp > XB_SPIN_CAP) { atomicAdd(&(bar)[XB_TMO], 1u); break; } } } } while (0)
struct XcdBarrier { unsigned* bar; unsigned x; volatile LAS unsigned* st; };
__device__ __forceinline__ XcdBarrier xcd_barrier_post(unsigned* bar, volatile LAS unsigned* st) {
    XcdBarrier b; b.bar = bar; b.x = xb_xcc_id(); b.st = st;
    if (threadIdx.x == 0) (void)xb_add(&bar[XB_XCNT(b.x)], 1u);
    return b;
}
__device__ __forceinline__ void xcd_barrier_complete(unsigned* bar, unsigned x, unsigned& nloc, unsigned& nx) {
    const unsigned G = gridDim.x * gridDim.y * gridDim.z;
    unsigned sum, cnt, mine, sp = 0u;
    for (;;) {
        sum = 0u; cnt = 0u; mine = 0u;
#pragma unroll
        for (unsigned j = 0; j < 16; ++j) { const unsigned c = xb_ld(&bar[XB_XCNT(j)]); sum += c; cnt += (c > 0u) ? 1u : 0u; mine = (j == x) ? c : mine; }
        if (sum == G) break;
        __builtin_amdgcn_s_sleep(1);
        if ((++sp & 255u) == 0u) { if (xb_ld(&bar[XB_TMO])) break; if (sp > XB_SPIN_CAP) { atomicAdd(&bar[XB_TMO], 1u); break; } }
    }
    nloc = mine > 0u ? mine : 1u; nx = cnt > 0u ? cnt : 1u;
}
__device__ __forceinline__ void xcd_barrier(const XcdBarrier& b) {
    asm volatile("s_waitcnt vmcnt(0)" ::: "memory");
    __syncthreads();
    if (threadIdx.x == 0) {
        unsigned* bar = b.bar; asm volatile("" : "+s"(bar)); unsigned bx_ = __builtin_amdgcn_readfirstlane(b.x); asm volatile("" : "+s"(bx_));
        __builtin_amdgcn_s_waitcnt(0);
        unsigned nloc = b.st[0], nx = b.st[1];
        if (nloc == 0u) { xcd_barrier_complete(bar, bx_, nloc, nx); b.st[0] = nloc; b.st[1] = nx; }
        const unsigned old = xb_add(&bar[XB_XSUB(bx_)], 1u);
        const unsigned gen = old / nloc;
        if (old + 1u == (gen + 1u) * nloc) {
            __builtin_amdgcn_fence(__ATOMIC_RELEASE, "agent");
            asm volatile("s_waitcnt vmcnt(0)" ::: "memory");
            const unsigned og = xb_add(&bar[XB_TOP], 1u);
            const unsigned tg = og / nx;
            if (og + 1u == (tg + 1u) * nx) xb_add(&bar[XB_TOPGEN], 1u);
            else XB_SPIN(xb_ld(&bar[XB_TOPGEN]) == tg, bar);
            __builtin_amdgcn_fence(__ATOMIC_ACQUIRE, "agent");
            xb_add(&bar[XB_XGEN(bx_)], 1u);
            asm volatile("s_waitcnt vmcnt(0)" ::: "memory");
        } else {
            XB_SPIN(xb_ld(&bar[XB_XGEN(bx_)]) == gen, bar);
            __builtin_amdgcn_fence(__ATOMIC_ACQUIRE, "agent");
            asm volatile("s_waitcnt vmcnt(0)" ::: "memory");
        }
    }
    __syncthreads();
}

namespace pg8 {
constexpr int BM = 256, BK = 64, HALF = 128, HTB = HALF * BK * 2, STAGE_BYTES = 8 * HTB, NXCD = 8, WGM = 8;
__device__ __forceinline__ int lds_byte(int r, int c) { const int st = (r >> 4) * 2 + (c >> 5), rr = r & 15, cc = c & 31, ob = rr * 64 + cc * 2; return st * 1024 + (ob ^ (((ob >> 9) & 1) << 5)); }
__device__ __forceinline__ void stage_rc(int b, int& R, int& C) { const int st = b / 1024, sb = b % 1024, swz = sb ^ (((sb >> 9) & 1) << 5); R = (st >> 1) * 16 + swz / 64; C = (st & 1) * 32 + (swz % 64) / 2; }
__device__ __forceinline__ int perm32(int rho) { const int n = rho >> 4, i = rho & 15; return 8 * (i >> 2) + 4 * n + (i & 3); }
__device__ __forceinline__ unsigned cvt_pk_bf16(float lo, float hi) { unsigned r; asm volatile("v_cvt_pk_bf16_f32 %0, %1, %2" : "=v"(r) : "v"(lo), "v"(hi)); return r; }

struct Unit { int pm, pn, e, row0; };

__device__ __forceinline__ int xcd_remap(int wgid, int nwg) { const int q = nwg / NXCD, r = nwg % NXCD, xcd = wgid % NXCD, off = wgid / NXCD; return (xcd < r ? xcd * (q + 1) : r * (q + 1) + (xcd - r) * q) + off; }

template <int K, class Epi, class Sched, bool ALIGN_EPI = true, bool SP2 = true>
__device__ __forceinline__ void gemm_phase(LAS unsigned char* lds, const Sched& S, const Epi& E) {
    int tid = threadIdx.x; asm volatile("" : "+v"(tid));
    const int wid = __builtin_amdgcn_readfirstlane(tid >> 6), lane = tid & 63, wr = wid >> 2, wc = wid & 3, fr = lane & 15, fq = lane >> 4;
    constexpr int nt = K / BK;
    unsigned voffB[2];
#pragma unroll
    for (int i = 0; i < 2; ++i) { int R, C; stage_rc(tid * 16 + i * 8192, R, C); const int Rb = Epi::PERM ? ((R & ~31) + perm32(R & 31)) : R; voffB[i] = (unsigned)(Rb * K + C) * 2u; }
    constexpr size_t kstep = (size_t)(BK * 2);
    constexpr size_t hstep = (size_t)HALF * K * 2;
    const unsigned ldsw = (unsigned)wid * 1024u;
    const int aoff = lds_byte(wr * 64 + fr, fq * 8), boff = lds_byte(wc * 32 + fr, fq * 8);
#define PG8_SA(b, h) (((b) * 2 + (h)) * HTB)
#define PG8_SB(b, h) ((4 + (b) * 2 + (h)) * HTB)
#define PG8_STAGE2(bufoff, gbase, v0, v1) do { \
        __builtin_amdgcn_global_load_lds((const unsigned*)((const char*)(gbase) + (v0)), (LAS unsigned*)(lds + (bufoff) + ldsw), 16, 0, 0); \
        __builtin_amdgcn_global_load_lds((const unsigned*)((const char*)(gbase) + (v1)), (LAS unsigned*)(lds + (bufoff) + ldsw + 8192), 16, 0, 0); } while (0)
#define PG8_STAGEB(bufoff, gbase) PG8_STAGE2(bufoff, gbase, voffB[0], voffB[1])
#define PG8_LDA(dst, b, h) do { _Pragma("unroll") for (int m = 0; m < 4; ++m) _Pragma("unroll") for (int k = 0; k < 2; ++k) dst[m][k] = *(const LAS bf16x8*)(lds + PG8_SA(b, h) + aoff + m * 2048 + k * 1024); } while (0)
#define PG8_LDB(dst, b, h) do { _Pragma("unroll") for (int n = 0; n < 2; ++n) _Pragma("unroll") for (int k = 0; k < 2; ++k) dst[n][k] = *(const LAS bf16x8*)(lds + PG8_SB(b, h) + boff + n * 2048 + k * 1024); } while (0)
#define PG8_MMA(ai, bj, At, Bt) do { __builtin_amdgcn_s_setprio(1); _Pragma("unroll") for (int m = 0; m < 4; ++m) _Pragma("unroll") for (int n = 0; n < 2; ++n) _Pragma("unroll") for (int k = 0; k < 2; ++k) \
        acc[ai][bj][m][n] = __builtin_amdgcn_mfma_f32_16x16x32_bf16(Bt[n][k], At[m][k], acc[ai][bj][m][n], 0, 0, 0); __builtin_amdgcn_s_setprio(0); } while (0)
#define PG8_WAIT_V(n) asm volatile("s_waitcnt vmcnt(" #n ")" ::: "memory")
#define PG8_WAIT_L(n) asm volatile("s_waitcnt lgkmcnt(" #n ")" ::: "memory")
#define PG8_BAR __builtin_amdgcn_s_barrier()
#define PG8_SCHED __builtin_amdgcn_sched_barrier(0)
    Unit cur, nxt; int ui = 0;
    if (!S.next(0, cur)) return;
    f32x4 acc[2][2][4][2];
    float zero_ = 0.f; asm volatile("" : "+v"(zero_));
#pragma unroll
    for (int a = 0; a < 2; ++a)
#pragma unroll
        for (int b = 0; b < 2; ++b)
#pragma unroll
            for (int m = 0; m < 4; ++m)
#pragma unroll
                for (int n = 0; n < 2; ++n) acc[a][b][m][n] = (f32x4){zero_, zero_, zero_, zero_};
    bf16x8 At[4][2], B0[2][2], B1[2][2];
    unsigned vA[2][2], nvA[2][2];
    S.a_voff(cur, tid, vA);
    const char* cA = S.a_base(cur); const char* cB = S.b_base(cur);
    if constexpr (SP2) {
        PG8_STAGEB(PG8_SB(0, 0), cB); PG8_STAGEB(PG8_SB(0, 1), cB + hstep); PG8_STAGE2(PG8_SA(0, 0), cA, vA[0][0], vA[0][1]); PG8_STAGE2(PG8_SA(0, 1), cA, vA[1][0], vA[1][1]);
        if (wr == 1) PG8_BAR;
        PG8_WAIT_V(2); PG8_BAR;
        PG8_STAGEB(PG8_SB(1, 0), cB + kstep); PG8_STAGE2(PG8_SA(1, 0), cA + kstep, vA[0][0], vA[0][1]); PG8_STAGEB(PG8_SB(1, 1), cB + hstep + kstep);
        PG8_WAIT_V(6); PG8_BAR;
    } else {
        PG8_STAGEB(PG8_SB(0, 0), cB); PG8_STAGE2(PG8_SA(0, 0), cA, vA[0][0], vA[0][1]); PG8_STAGEB(PG8_SB(0, 1), cB + hstep); PG8_STAGE2(PG8_SA(0, 1), cA, vA[1][0], vA[1][1]);
        if (wr == 1) PG8_BAR;
        PG8_WAIT_V(4); PG8_BAR;
        PG8_STAGEB(PG8_SB(1, 0), cB + kstep); PG8_STAGE2(PG8_SA(1, 0), cA + kstep, vA[0][0], vA[0][1]); PG8_STAGEB(PG8_SB(1, 1), cB + hstep + kstep);
        PG8_WAIT_V(6); PG8_BAR;
    }
    for (;;) {
        const bool has_next = S.next(ui + 1, nxt);
        const char* nA = cA; const char* nB = cB;
#pragma unroll
        for (int h = 0; h < 2; ++h)
#pragma unroll
            for (int i = 0; i < 2; ++i) nvA[h][i] = vA[h][i];
        if (has_next) { S.a_voff(nxt, tid, nvA); nA = S.a_base(nxt); nB = S.b_base(nxt); }
#pragma unroll 1
        for (int t = 0; t < nt; t += 2) {
            const bool last = (t == nt - 2);
            const char* a1 = cA + (size_t)(t + 1) * kstep;
            const char* a2 = last ? nA : cA + (size_t)(t + 2) * kstep; const char* b2 = last ? nB : cB + (size_t)(t + 2) * kstep;
            const char* a3 = a2 + kstep; const char* b3 = b2 + kstep;
            const unsigned s00 = last ? nvA[0][0] : vA[0][0], s01 = last ? nvA[0][1] : vA[0][1], s10 = last ? nvA[1][0] : vA[1][0], s11 = last ? nvA[1][1] : vA[1][1];
            if constexpr (SP2) {
            PG8_LDB(B0, 0, 0); PG8_LDB(B1, 0, 1); PG8_SCHED; PG8_LDA(At, 0, 0); PG8_STAGE2(PG8_SA(1, 1), a1, vA[1][0], vA[1][1]);
            PG8_WAIT_V(8); PG8_WAIT_L(0); PG8_BAR; PG8_MMA(0, 0, At, B0); PG8_MMA(0, 1, At, B1); PG8_BAR; PG8_SCHED;
            PG8_LDA(At, 0, 1); PG8_STAGEB(PG8_SB(0, 0), b2); PG8_STAGEB(PG8_SB(0, 1), b2 + hstep); PG8_STAGE2(PG8_SA(0, 0), a2, s00, s01);
            PG8_WAIT_V(8); PG8_WAIT_L(0); PG8_BAR; PG8_MMA(1, 0, At, B0); PG8_MMA(1, 1, At, B1); PG8_BAR; PG8_SCHED;
            PG8_LDB(B0, 1, 0); PG8_LDB(B1, 1, 1); PG8_SCHED; PG8_LDA(At, 1, 0); PG8_STAGE2(PG8_SA(0, 1), a2, s10, s11);
            PG8_WAIT_V(8); PG8_WAIT_L(0); PG8_BAR; PG8_MMA(0, 0, At, B0); PG8_MMA(0, 1, At, B1); PG8_BAR; PG8_SCHED;
            PG8_LDA(At, 1, 1); PG8_STAGEB(PG8_SB(1, 0), b3); PG8_STAGEB(PG8_SB(1, 1), b3 + hstep); PG8_STAGE2(PG8_SA(1, 0), a3, s00, s01);
            PG8_WAIT_V(8); PG8_WAIT_L(0); PG8_BAR; PG8_MMA(1, 0, At, B0); PG8_MMA(1, 1, At, B1); PG8_BAR; PG8_SCHED;
            } else {
            PG8_LDB(B0, 0, 0); PG8_SCHED; PG8_LDA(At, 0, 0); PG8_STAGE2(PG8_SA(1, 1), a1, vA[1][0], vA[1][1]);
            PG8_WAIT_L(8); PG8_BAR; PG8_WAIT_L(0); PG8_MMA(0, 0, At, B0); PG8_BAR; PG8_SCHED;
            PG8_LDB(B1, 0, 1); PG8_STAGEB(PG8_SB(0, 0), b2);
            PG8_BAR; PG8_WAIT_L(0); PG8_MMA(0, 1, At, B1); PG8_BAR;
            PG8_LDA(At, 0, 1); PG8_STAGE2(PG8_SA(0, 0), a2, s00, s01);
            PG8_BAR; PG8_WAIT_L(0); PG8_MMA(1, 0, At, B0); PG8_BAR; PG8_SCHED;
            PG8_STAGEB(PG8_SB(0, 1), b2 + hstep);
            PG8_WAIT_V(6); PG8_BAR; PG8_MMA(1, 1, At, B1); PG8_BAR;
            PG8_LDB(B0, 1, 0); PG8_SCHED; PG8_LDA(At, 1, 0); PG8_STAGE2(PG8_SA(0, 1), a2, s10, s11);
            PG8_WAIT_L(8); PG8_BAR; PG8_WAIT_L(0); PG8_MMA(0, 0, At, B0); PG8_BAR; PG8_SCHED;
            PG8_LDB(B1, 1, 1); PG8_STAGEB(PG8_SB(1, 0), b3);
            PG8_BAR; PG8_WAIT_L(0); PG8_MMA(0, 1, At, B1); PG8_BAR;
            PG8_LDA(At, 1, 1); PG8_STAGE2(PG8_SA(1, 0), a3, s00, s01);
            PG8_BAR; PG8_WAIT_L(0); PG8_MMA(1, 0, At, B0); PG8_BAR; PG8_SCHED;
            PG8_STAGEB(PG8_SB(1, 1), b3 + hstep);
            PG8_WAIT_V(6); PG8_BAR; PG8_MMA(1, 1, At, B1); PG8_BAR;
            }
        }
        if constexpr (ALIGN_EPI) { if (wr == 0) PG8_BAR; }
        E(acc, cur, wr, wc, fr, fq);
        if (!has_next) break;
        asm volatile("v_mov_b32 %0, 0" : "=v"(zero_));
#pragma unroll
        for (int a = 0; a < 2; ++a)
#pragma unroll
            for (int b = 0; b < 2; ++b)
#pragma unroll
                for (int m = 0; m < 4; ++m)
#pragma unroll
                    for (int n = 0; n < 2; ++n) acc[a][b][m][n] = (f32x4){zero_, zero_, zero_, zero_};
        cur = nxt; cA = nA; cB = nB; ++ui;
#pragma unroll
        for (int h = 0; h < 2; ++h)
#pragma unroll
            for (int i = 0; i < 2; ++i) vA[h][i] = nvA[h][i];
        if constexpr (ALIGN_EPI) { if (wr == 1) PG8_BAR; }
    }
    PG8_WAIT_V(0);
    if constexpr (!ALIGN_EPI) { if (wr == 0) PG8_BAR; }
    PG8_BAR;
#undef PG8_SA
#undef PG8_SB
#undef PG8_STAGE2
#undef PG8_STAGEB
#undef PG8_LDA
#undef PG8_LDB
#undef PG8_MMA
#undef PG8_WAIT_V
#undef PG8_WAIT_L
#undef PG8_BAR
#undef PG8_SCHED
}

template <int K> struct DenseSched {
    const char* A; const char* Bt; int nM, nN, nwg, G, c;
    __device__ __forceinline__ void init(const void* A_, const void* Bt_, int M, int N, int G_, int c_) { A = (const char*)A_; Bt = (const char*)Bt_; nM = M / BM; nN = N / BM; nwg = nM * nN; G = G_; c = c_; }
    __device__ __forceinline__ bool next(int i, Unit& u) const {
        const long L = (long)i * G + c; if (L >= nwg) return false;
        const int wgid = xcd_remap((int)L, nwg);
        const int nig = WGM * nN, gid = wgid / nig, fm = gid * WGM, gsz = (nM - fm) < WGM ? (nM - fm) : WGM;
        u.pm = fm + ((wgid % nig) % gsz); u.pn = (wgid % nig) / gsz; u.e = 0; u.row0 = u.pm * BM; return true;
    }
    __device__ __forceinline__ const char* a_base(const Unit& u) const { return A + (size_t)u.pm * BM * K * 2; }
    __device__ __forceinline__ const char* b_base(const Unit& u) const { return Bt + (size_t)u.pn * BM * K * 2; }
    __device__ __forceinline__ void a_voff(const Unit&, int tid, unsigned (&v)[2][2]) const {
#pragma unroll
        for (int i = 0; i < 2; ++i) { int R, C; stage_rc(tid * 16 + i * 8192, R, C); v[0][i] = (unsigned)(R * K + C) * 2u; v[1][i] = (unsigned)((R + HALF) * K + C) * 2u; }
    }
};
template <int K, bool GATHER, bool SPREAD = false> struct MoeSched {
    const char* A; const char* Bt; const int* ltok; const LAS int* tstart; int ntiles, nN, nwg, G, c; size_t bstride_e; int bcol0;
    __device__ __forceinline__ bool next(int i, Unit& u) const {
        int wgid;
        if (SPREAD) {
            const int xcd = c & 7, off = i * (G >> 3) + (c >> 3); const int Ru = tstart[64] * nN, Su = nwg - Ru;
            const int r0 = (int)((long)xcd * Ru / 8), r1 = (int)((long)(xcd + 1) * Ru / 8), s0 = (int)((long)xcd * Su / 8), s1 = (int)((long)(xcd + 1) * Su / 8);
            if (off < r1 - r0) wgid = r0 + off; else if (off < (r1 - r0) + (s1 - s0)) wgid = Ru + s0 + off - (r1 - r0); else return false;
        } else {
            const long L = (long)i * G + c; if (L >= nwg) return false;
            wgid = xcd_remap((int)L, nwg);
        }
        const int rt = wgid / nN; u.pn = wgid % nN; u.pm = rt; u.row0 = rt * BM;
        int lo = 0, hi = NE1;
        while (hi - lo > 1) { const int mid = (lo + hi) >> 1; if (tstart[mid] <= rt) lo = mid; else hi = mid; }
        u.e = lo; return true;
    }
    __device__ __forceinline__ const char* a_base(const Unit& u) const { return GATHER ? A : A + (size_t)u.row0 * K * 2; }
    __device__ __forceinline__ const char* b_base(const Unit& u) const { return Bt + (size_t)u.e * bstride_e + (size_t)(bcol0 + u.pn * BM) * K * 2; }
    __device__ __forceinline__ void a_voff(const Unit& u, int tid, unsigned (&v)[2][2]) const {
#pragma unroll
        for (int i = 0; i < 2; ++i) { int R, C; stage_rc(tid * 16 + i * 8192, R, C);
            if (GATHER) { const int t0 = ltok[u.row0 + R], t1 = ltok[u.row0 + HALF + R]; v[0][i] = (unsigned)(t0 * K + C) * 2u; v[1][i] = (unsigned)(t1 * K + C) * 2u; }
            else { v[0][i] = (unsigned)(R * K + C) * 2u; v[1][i] = (unsigned)((R + HALF) * K + C) * 2u; } }
    }
};
}
using pg8::Unit;

struct EpiInProj {
    static constexpr bool PERM = true;
    unsigned char* ws; const f32x2* rope;
    __device__ __forceinline__ void operator()(const f32x4 (&acc)[2][2][4][2], const Unit& u, int wr, int wc, int fr, int fq) const {
        const int pn = u.pn; const int row0 = u.pm * 256 + wr * 64 + fr;
        bf16_t* dst; int ld, colt;
        if (pn < 2) { dst = (bf16_t*)(ws + WS_Q); ld = 512; colt = pn * 256; }
        else if (pn < 4) { dst = (bf16_t*)(ws + WS_K); ld = 512; colt = (pn - 2) * 256; }
        else if (pn < 6) { dst = (bf16_t*)(ws + WS_V); ld = 512; colt = (pn - 4) * 256; }
        else if (pn == 6) { dst = nullptr; ld = 0; colt = 0; }
        else if (pn < 10) { dst = (bf16_t*)(ws + WS_G); ld = 768; colt = (pn - 7) * 256; }
        else { dst = (bf16_t*)(ws + WS_Z); ld = 256; colt = 0; }
        const bool rope_on = (pn < 4) && (u.pm < TL / 256);
        const float qs = pn < 2 ? 0.125f * 1.4426950408889634f : 1.f;
        float* BA = (float*)(ws + WS_BA);
#pragma unroll
        for (int ai = 0; ai < 2; ++ai)
#pragma unroll
            for (int m = 0; m < 4; ++m) {
                const int r = row0 + ai * 128 + m * 16;
                if (pn == 6) {
                    int b_, cc_, k_; if (r < TL) { b_ = r >> 12; const int t = r & (SEQ - 1); cc_ = 8 + (t >> 5); k_ = t & 31; } else { const int t = (r - TL) & (NCTX - 1); b_ = (r - TL) >> 8; cc_ = t >> 5; k_ = t & 31; }
#pragma unroll
                    for (int bj = 0; bj < 2; ++bj) { const int ch = bj * 128 + wc * 32 + 8 * fq; const f32x4 v0 = acc[ai][bj][m][0], v1 = acc[ai][bj][m][1];
                        u32x4 w; w.x = pg8::cvt_pk_bf16(v0[0], v0[1]); w.y = pg8::cvt_pk_bf16(v0[2], v0[3]); w.z = pg8::cvt_pk_bf16(v1[0], v1[1]); w.w = pg8::cvt_pk_bf16(v1[2], v1[3]);
                        *(u32x4*)((bf16_t*)(ws + WS_S5A) + ((size_t)(ch >> 4) * S5R + b_ * 136 + cc_) * 768 + k_ * 16 + (ch & 15)) = w; }
                } else if (pn == 11) {
                    if (wc == 0 && fq < 2) { *(f32x4*)(BA + (size_t)r * 16 + 8 * fq) = acc[ai][0][m][0]; *(f32x4*)(BA + (size_t)r * 16 + 8 * fq + 4) = acc[ai][0][m][1]; }
                } else {
                    f32x4 cs0 = {1.f, 0.f, 1.f, 0.f}, cs1 = {1.f, 0.f, 1.f, 0.f};
                    if (rope_on) { const int t = r & (SEQ - 1); const int pos = (wc & 1) ? (t & 63) : (t >> 6); const f32x4* rp = (const f32x4*)(rope + pos * 16 + 4 * fq); cs0 = rp[0]; cs1 = rp[1]; }
#pragma unroll
                    for (int bj = 0; bj < 2; ++bj) {
                        f32x4 v0 = acc[ai][bj][m][0], v1 = acc[ai][bj][m][1];
                        if (rope_on) {
                            const f32x4 c = {cs0[0], cs0[2], cs1[0], cs1[2]}, s = {cs0[1], cs0[3], cs1[1], cs1[3]};
                            const f32x4 x1 = v0, x2 = v1; v0 = x1 * c - x2 * s; v1 = x1 * s + x2 * c;
                        }
                        v0 = v0 * qs; v1 = v1 * qs;
                        u32x4 w; w.x = pg8::cvt_pk_bf16(v0[0], v0[1]); w.y = pg8::cvt_pk_bf16(v0[2], v0[3]); w.z = pg8::cvt_pk_bf16(v1[0], v1[1]); w.w = pg8::cvt_pk_bf16(v1[2], v1[3]);
                        *(u32x4*)(dst + (size_t)r * ld + colt + bj * 128 + wc * 32 + 8 * fq) = w;
                    }
                }
            }
    }
};
struct EpiResid {
    static constexpr bool PERM = false;
    const float* xin_lat; const float* xin_ctx; float* xo_lat; float* xo_ctx; const float* mod; int gidx;
    __device__ __forceinline__ void operator()(const f32x4 (&acc)[2][2][4][2], const Unit& u, int wr, int wc, int fr, int fq) const {
        const bool lat = u.pm < TL / 256;
        const int j = lat ? (u.pm >> 4) : 8  ;
        const float* gv = mod + j * 6144 + gidx * 1024 + u.pn * 256 + wc * 32 + 4 * fq;
        const float* src = (lat ? xin_lat + (size_t)u.pm * 256 * DM : xin_ctx + (size_t)(u.pm - TL / 256) * 256 * DM) + (size_t)(wr * 64 + fr) * DM + u.pn * 256 + wc * 32 + 4 * fq;
        float* dst = (lat ? xo_lat + (size_t)u.pm * 256 * DM : xo_ctx + (size_t)(u.pm - TL / 256) * 256 * DM) + (size_t)(wr * 64 + fr) * DM + u.pn * 256 + wc * 32 + 4 * fq;
        f32x4 g[2][2];
#pragma unroll
        for (int bj = 0; bj < 2; ++bj)
#pragma unroll
            for (int n = 0; n < 2; ++n) g[bj][n] = *(const f32x4*)(gv + bj * 128 + n * 16);
#pragma unroll
        for (int ai = 0; ai < 2; ++ai)
#pragma unroll
            for (int mh = 0; mh < 2; ++mh) {
                f32x4 x[2][2][2];
#pragma unroll
                for (int m2 = 0; m2 < 2; ++m2)
#pragma unroll
                    for (int bj = 0; bj < 2; ++bj)
#pragma unroll
                        for (int n = 0; n < 2; ++n) x[m2][bj][n] = *(const f32x4*)(src + (size_t)(ai * 128 + (2 * mh + m2) * 16) * DM + bj * 128 + n * 16);
#pragma unroll
                for (int m2 = 0; m2 < 2; ++m2)
#pragma unroll
                    for (int bj = 0; bj < 2; ++bj)
#pragma unroll
                        for (int n = 0; n < 2; ++n) *(f32x4*)(dst + (size_t)(ai * 128 + (2 * mh + m2) * 16) * DM + bj * 128 + n * 16) = x[m2][bj][n] + g[bj][n] * acc[ai][bj][2 * mh + m2][n];
            }
    }
};
struct EpiMoeUp {
    static constexpr bool PERM = true;
    bf16_t* hid; const float* lgate;
    __device__ __forceinline__ void operator()(const f32x4 (&acc)[2][2][4][2], const Unit& u, int wr, int wc, int fr, int fq) const {
        float gt[2][4];
#pragma unroll
        for (int ai = 0; ai < 2; ++ai)
#pragma unroll
            for (int m = 0; m < 4; ++m) gt[ai][m] = lgate[u.row0 + wr * 64 + fr + ai * 128 + m * 16];
#pragma unroll
        for (int ai = 0; ai < 2; ++ai)
#pragma unroll
            for (int m = 0; m < 4; ++m) {
                const int r = u.row0 + wr * 64 + fr + ai * 128 + m * 16;
                f32x4 h0, h1;
#pragma unroll
                for (int j = 0; j < 4; ++j) { const float a0 = acc[ai][0][m][0][j], a1 = acc[ai][0][m][1][j]; h0[j] = siluf(a0) * acc[ai][1][m][0][j] * gt[ai][m]; h1[j] = siluf(a1) * acc[ai][1][m][1][j] * gt[ai][m]; }
                u32x4 w; w.x = pg8::cvt_pk_bf16(h0[0], h0[1]); w.y = pg8::cvt_pk_bf16(h0[2], h0[3]); w.z = pg8::cvt_pk_bf16(h1[0], h1[1]); w.w = pg8::cvt_pk_bf16(h1[2], h1[3]);
                *(u32x4*)(hid + (size_t)r * 256 + u.pn * 128 + wc * 32 + 8 * fq) = w;
            }
    }
};
constexpr float PAIR_SCALE = 8.f;
struct EpiMoeDown {
    static constexpr bool PERM = true;
    unsigned char* ws;
    __device__ __forceinline__ void operator()(const f32x4 (&acc)[2][2][4][2], const Unit& u, int wr, int wc, int fr, int fq) const {
        unsigned char* base = u.row0 < PAIR_RA ? ws + WS_PAIRA + (size_t)u.row0 * 1024 : ws + WS_PAIRB + (size_t)(u.row0 - PAIR_RA) * 1024;
        const int odd = fq & 1;
#pragma unroll
        for (int ai = 0; ai < 2; ++ai)
#pragma unroll
            for (int mp = 0; mp < 2; ++mp) {
                const int r = wr * 64 + fr + ai * 128 + (2 * mp + odd) * 16;
#pragma unroll
                for (int bj = 0; bj < 2; ++bj) {
                    unsigned x[2], y[2];
#pragma unroll
                    for (int h = 0; h < 2; ++h) { const f32x4 va = acc[ai][bj][2 * mp][h] * PAIR_SCALE, vb = acc[ai][bj][2 * mp + 1][h] * PAIR_SCALE;
                        int wa = __builtin_amdgcn_cvt_pk_fp8_f32(va[0], va[1], 0, false); wa = __builtin_amdgcn_cvt_pk_fp8_f32(va[2], va[3], wa, true);
                        int wb = __builtin_amdgcn_cvt_pk_fp8_f32(vb[0], vb[1], 0, false); wb = __builtin_amdgcn_cvt_pk_fp8_f32(vb[2], vb[3], wb, true);
                        x[h] = (unsigned)wa; y[h] = (unsigned)wb; }
                    auto s0 = __builtin_amdgcn_permlane16_swap(x[0], y[0], false, false); auto s1 = __builtin_amdgcn_permlane16_swap(x[1], y[1], false, false);
                    const u32x4 w = {s0[0], s1[0], s0[1], s1[1]};
                    *(u32x4*)(base + (size_t)r * 1024 + u.pn * 256 + bj * 128 + wc * 32 + 8 * (fq & ~1)) = w;
                }
            }
    }
};

template <int K> struct GroupSched {
    const char* A; size_t a_gs; int lda; const char* Bt; size_t b_gs; int nM, nN, nwg, G, c;
    __device__ __forceinline__ bool next(int i, Unit& u) const {
        const long L = (long)i * G + c; if (L >= nwg) return false;
        const int wgid = pg8::xcd_remap((int)L, nwg); const int per = nM * nN, g = wgid / per, rem = wgid % per;
        u.e = g; u.pn = rem % nN; u.pm = rem / nN; u.row0 = u.pm * 256; return true;
    }
    __device__ __forceinline__ const char* a_base(const Unit& u) const { return A + (size_t)u.e * a_gs + (size_t)u.pm * 256 * lda * 2; }
    __device__ __forceinline__ const char* b_base(const Unit& u) const { return Bt + (size_t)u.e * b_gs + (size_t)u.pn * 256 * K * 2; }
    __device__ __forceinline__ void a_voff(const Unit&, int tid, unsigned (&v)[2][2]) const {
#pragma unroll
        for (int i = 0; i < 2; ++i) { int R, C; pg8::stage_rc(tid * 16 + i * 8192, R, C); v[0][i] = (unsigned)(R * lda + C) * 2u; v[1][i] = (unsigned)((R + 128) * lda + C) * 2u; }
    }
};
struct EpiLogits {
    static constexpr bool PERM = false;
    float* LOG;
    __device__ __forceinline__ void operator()(const f32x4 (&acc)[2][2][4][2], const Unit& u, int wr, int wc, int fr, int fq) const {
#pragma unroll
        for (int ai = 0; ai < 2; ++ai)
#pragma unroll
            for (int m = 0; m < 4; ++m) { const int r = u.row0 + wr * 64 + fr + ai * 128 + m * 16; float* rowp = LOG + ((size_t)u.e * MT + r) * 128;
#pragma unroll
                for (int n = 0; n < 2; ++n) *(f32x4*)(rowp + wc * 32 + n * 16 + 4 * fq) = acc[ai][0][m][n]; }
    }
};
struct EpiS5L {
    static constexpr bool PERM = false;
    float* L;
    __device__ __forceinline__ void operator()(const f32x4 (&acc)[2][2][4][2], const Unit& u, int wr, int wc, int fr, int fq) const {
#pragma unroll
        for (int ai = 0; ai < 2; ++ai)
#pragma unroll
            for (int m = 0; m < 4; ++m) { const int r = u.row0 + wr * 64 + fr + ai * 128 + m * 16; float* rowp = L + ((size_t)u.e * S5R + r) * 256;
#pragma unroll
                for (int bj = 0; bj < 2; ++bj)
#pragma unroll
                    for (int n = 0; n < 2; ++n) *(f32x4*)(rowp + bj * 128 + wc * 32 + n * 16 + 4 * fq) = acc[ai][bj][m][n]; }
    }
};
__device__ __forceinline__ float gelu_tanh(float x) { const float t = 0.7978845608028654f * (x + 0.044715f * x * x * x); const float th = 1.f - 2.f / (1.f + __expf(2.f * t)); return 0.5f * x * (1.f + th); }
struct EpiS5Y {
    static constexpr bool PERM = true;
    bf16_t* Zs;
    __device__ __forceinline__ void operator()(const f32x4 (&acc)[2][2][4][2], const Unit& u, int wr, int wc, int fr, int fq) const {
#pragma unroll
        for (int ai = 0; ai < 2; ++ai)
#pragma unroll
            for (int m = 0; m < 4; ++m) { const int r = u.row0 + wr * 64 + fr + ai * 128 + m * 16;
                if (r < S5RV) { const int b_ = r / 136, cc_ = r % 136; const int tok0 = cc_ < 8 ? TL + b_ * NCTX + cc_ * 32 : b_ * SEQ + (cc_ - 8) * 32;
#pragma unroll
                    for (int bj = 0; bj < 2; ++bj) { const int n = u.pn * 256 + bj * 128 + wc * 32 + 8 * fq; const f32x4 v0 = acc[ai][bj][m][0], v1 = acc[ai][bj][m][1];
                        u32x4 w; w.x = pg8::cvt_pk_bf16(gelu_tanh(v0[0]), gelu_tanh(v0[1])); w.y = pg8::cvt_pk_bf16(gelu_tanh(v0[2]), gelu_tanh(v0[3]));
                        w.z = pg8::cvt_pk_bf16(gelu_tanh(v1[0]), gelu_tanh(v1[1])); w.w = pg8::cvt_pk_bf16(gelu_tanh(v1[2]), gelu_tanh(v1[3]));
                        *(u32x4*)(Zs + (size_t)(tok0 + (n >> 4)) * 256 + u.e * 16 + (n & 15)) = w; } } }
    }
};
struct EpiGlu {
    static constexpr bool PERM = true;
    const bf16_t* Zs; bf16_t* hb; const float* bg;
    __device__ __forceinline__ void operator()(const f32x4 (&acc)[2][2][4][2], const Unit& u, int wr, int wc, int fr, int fq) const {
        f32x4 b0[2], b1[2];
#pragma unroll
        for (int bj = 0; bj < 2; ++bj) { const int col = bj * 128 + wc * 32 + 8 * fq; b0[bj] = *(const f32x4*)(bg + col); b1[bj] = *(const f32x4*)(bg + col + 4); }
#pragma unroll
        for (int ai = 0; ai < 2; ++ai) {
            u32x4 zz[4][2];
#pragma unroll
            for (int m = 0; m < 4; ++m)
#pragma unroll
                for (int bj = 0; bj < 2; ++bj) zz[m][bj] = *(const u32x4*)(Zs + (size_t)(u.row0 + wr * 64 + fr + ai * 128 + m * 16) * 256 + bj * 128 + wc * 32 + 8 * fq);
#pragma unroll
            for (int m = 0; m < 4; ++m) { const int r = u.row0 + wr * 64 + fr + ai * 128 + m * 16;
#pragma unroll
                for (int bj = 0; bj < 2; ++bj) { const int col = bj * 128 + wc * 32 + 8 * fq; const u32x4 z4 = zz[m][bj];
                    const f32x4 v0 = acc[ai][bj][m][0] + b0[bj], v1 = acc[ai][bj][m][1] + b1[bj];
                    float z[8]; z[0] = __builtin_bit_cast(float, z4.x << 16); z[1] = __builtin_bit_cast(float, z4.x & 0xffff0000u); z[2] = __builtin_bit_cast(float, z4.y << 16); z[3] = __builtin_bit_cast(float, z4.y & 0xffff0000u);
                    z[4] = __builtin_bit_cast(float, z4.z << 16); z[5] = __builtin_bit_cast(float, z4.z & 0xffff0000u); z[6] = __builtin_bit_cast(float, z4.w << 16); z[7] = __builtin_bit_cast(float, z4.w & 0xffff0000u);
                    u32x4 w; w.x = pg8::cvt_pk_bf16(z[0] * sigmf(v0[0]), z[1] * sigmf(v0[1])); w.y = pg8::cvt_pk_bf16(z[2] * sigmf(v0[2]), z[3] * sigmf(v0[3]));
                    w.z = pg8::cvt_pk_bf16(z[4] * sigmf(v1[0]), z[5] * sigmf(v1[1])); w.w = pg8::cvt_pk_bf16(z[6] * sigmf(v1[2]), z[7] * sigmf(v1[3]));
                    *(u32x4*)(hb + (size_t)r * DM + 512 + col) = w; } } }
    }
};


struct Ctx {
    const LAS unsigned* pl;
    LAS unsigned char* lds; int tid, lane, wave, G, bid, gw, NGW;
    __device__ __forceinline__ const float* ptr(int i) const { unsigned a_ = (unsigned)(size_t)pl; asm volatile("" : "+v"(a_));
        const LAS unsigned* q = (const LAS unsigned*)(size_t)a_; const unsigned lo = __builtin_amdgcn_readfirstlane(q[2 * i]), hi = __builtin_amdgcn_readfirstlane(q[2 * i + 1]); return (const float*)(((unsigned long long)hi << 32) | lo); }
    __device__ __forceinline__ const float* in(int i) const { return ptr(i); }
    __device__ __forceinline__ float* out() const { return (float*)ptr(35); }
    __device__ __forceinline__ unsigned char* ws() const { return (unsigned char*)ptr(36); }
    template <class T> __device__ __forceinline__ T* wsp(size_t off) const { return (T*)(ws() + off); }
};

__device__ __forceinline__ void ph_pre(const Ctx& c) {
    LAS float* act = (LAS float*)c.lds;
    const float* cv = c.in(I_C); const float* cc = c.in(I_CCTX);
    for (int i = c.tid; i < 9216; i += 512) { const int j = i >> 10, k = i & 1023; const float v = j < 8 ? cv[j * 1024 + k] : cc[k]; act[i] = siluf(v); }
    __syncthreads();
    float* mods = c.wsp<float>(WS_MODS);
    LAS float* red = act + 9216;
    for (int item = c.bid; item < 192; item += c.G) {
        const int l = item / 96, n0 = (item % 96) * 64, cg = c.tid & 15, ks = c.tid >> 4;
        f32x4 a[9];
#pragma unroll
        for (int j = 0; j < 9; ++j) a[j] = (f32x4){0.f, 0.f, 0.f, 0.f};
        const float* w = c.in(I_WMOD) + ((size_t)l * 1024 + ks * 32) * 6144 + n0 + 4 * cg;
#pragma unroll 8
        for (int k = 0; k < 32; ++k) { const f32x4 wv = *(const f32x4*)(w + (size_t)k * 6144);
#pragma unroll
            for (int j = 0; j < 9; ++j) a[j] += wv * act[j * 1024 + ks * 32 + k]; }
#pragma unroll
        for (int j = 0; j < 9; ++j) *(LAS f32x4*)(red + (ks * 9 + j) * 64 + 4 * cg) = a[j];
        __syncthreads();
        for (int o = c.tid; o < 576; o += 512) { const int j = o >> 6, n = o & 63; float sacc = 0.f;
#pragma unroll 8
            for (int q = 0; q < 32; ++q) sacc += red[(q * 9 + j) * 64 + n];
            mods[((size_t)l * 9 + j) * 6144 + n0 + n] = sacc + c.in(I_BMOD)[l * 6144 + n0 + n]; }
        __syncthreads();
    }
    if (c.bid == c.G - 1) {
        f32x2* rope = c.wsp<f32x2>(WS_ROPE);
        for (int i = c.tid; i < 1024; i += 512) { const int pos = i >> 4, f = i & 15; const float inv = exp2f(-(float)f * (13.287712379549449f / 16.f)); const float a = (float)pos * inv;
            rope[i] = (f32x2){__cosf(a), __sinf(a)}; }
    }
}

__device__ __forceinline__ void tr_item64(const float* W, int ldw, int ncols, int k0, int n0, bf16_t* WT, int Kdim, int drow0, bool perm, LAS float* scr, int lane) {
    const int lc = 4 * (lane & 15), lr = lane >> 4;
    f32x4 v[16];
#pragma unroll
    for (int i = 0; i < 16; ++i) { const int kk = 4 * i + lr; const int col = n0 + lc;
        v[i] = (col + 3 < ncols) ? *(const f32x4*)(W + (size_t)(k0 + kk) * ldw + col) : (f32x4){col < ncols ? W[(size_t)(k0 + kk) * ldw + col] : 0.f, col + 1 < ncols ? W[(size_t)(k0 + kk) * ldw + col + 1] : 0.f, col + 2 < ncols ? W[(size_t)(k0 + kk) * ldw + col + 2] : 0.f, 0.f}; }
#pragma unroll
    for (int i = 0; i < 16; ++i) { const int kk = 4 * i + lr; LAS float* d = scr + kk * 65 + lc; d[0] = v[i][0]; d[1] = v[i][1]; d[2] = v[i][2]; d[3] = v[i][3]; }
    LDS_WAIT(); asm volatile("" ::: "memory");
    const int cch = lane & 7;
#pragma unroll
    for (int j = 0; j < 8; ++j) { const int n = (lane >> 3) + 8 * j; const int sn = perm ? (n & ~31) + dimperm(n & 31) : n; const LAS float* s = scr + (8 * cch) * 65 + sn;
        u32x4 o; o.x = pk2(s[0 * 65], s[1 * 65]); o.y = pk2(s[2 * 65], s[3 * 65]); o.z = pk2(s[4 * 65], s[5 * 65]); o.w = pk2(s[6 * 65], s[7 * 65]);
        *(u32x4*)(WT + (size_t)(drow0 + n) * Kdim + k0 + 8 * cch) = o; }
    LDS_WAIT(); asm volatile("" ::: "memory");
}
__device__ __forceinline__ void wprep13_item(const Ctx& c, int l, int e, int q, LAS float* scr) {
    const bool is3 = q >= 64; q &= 63; const int kb = q / 4, nb = q % 4, n0 = nb * 64;
    const float* src = e < 64 ? c.in(is3 ? I_W3 : I_W1) + ((size_t)l * 64 + e) * 1024 * 256 : c.in(is3 ? I_WS3 : I_WS1) + (size_t)l * 1024 * 256;
    tr_item64(src, 256, 256, kb * 64, n0, c.wsp<bf16_t>(WS_W13) + (size_t)e * 512 * 1024, 1024, (n0 >> 7) * 256 + (n0 & 127) + (is3 ? 128 : 0), false, scr, c.lane);
}
__device__ __forceinline__ void ph_wprep13_dyn(const Ctx& c, int l, int qsel) {
    LAS float* scr = (LAS float*)(c.lds + c.wave * 16640);
    unsigned* qctr = c.wsp<unsigned>(WS_CTL) + CW_ATTQ + l * 64 + qsel * 32 + 16;
    LAS int* qslot = (LAS int*)(c.lds + 8 * 16640);
    constexpr int NIT = NE1 * 128;
#pragma unroll 1
    for (;;) {
        if (c.tid == 0) qslot[0] = (int)atomicAdd(qctr, 8u);
        __syncthreads();
        const int base = __builtin_amdgcn_readfirstlane(qslot[0]);
        __syncthreads();
        if (base >= NIT) break;
        const int it = base + c.wave;
        if (it < NIT) wprep13_item(c, l, it >> 7, it & 127, scr);
    }
}
__device__ __forceinline__ void ph_wprep2_dyn(const Ctx& c, int l, int qsel) {
    LAS float* scr = (LAS float*)(c.lds + c.wave * 16640);
    unsigned* qctr = c.wsp<unsigned>(WS_CTL) + CW_ATTQ + l * 64 + qsel * 32 + 17;
    LAS int* qslot = (LAS int*)(c.lds + 8 * 16640);
    constexpr int NIT = NE1 * 64;
    __syncthreads();
#pragma unroll 1
    for (;;) {
        if (c.tid == 0) qslot[0] = (int)atomicAdd(qctr, 8u);
        __syncthreads();
        const int base = __builtin_amdgcn_readfirstlane(qslot[0]);
        __syncthreads();
        if (base >= NIT) break;
        const int it = base + c.wave;
        if (it < NIT) { const int e = it >> 6, q = it & 63, kb = q / 16, nb = q % 16;
            const float* src = e < 64 ? c.in(I_W2) + ((size_t)l * 64 + e) * 256 * 1024 : c.in(I_WS2) + (size_t)l * 256 * 1024;
            tr_item64(src, 1024, 1024, kb * 64, nb * 64, c.wsp<bf16_t>(WS_W2) + (size_t)e * 1024 * 256, 256, nb * 64, false, scr, c.lane); }
    }
}
template <int PART> __device__ __forceinline__ void ph_wprep(const Ctx& c, int l) {
    LAS float* scr = (LAS float*)(c.lds + c.wave * 16640);
    constexpr int I_IN = 16 * 48, I_OUT = 16 * 16, I_EXP = 192;
    constexpr int NITEMS = PART == 0 ? I_IN + I_OUT : (PART == 1 ? NE1 * I_EXP : NE1 * 64);
    for (int it = c.gw; it < NITEMS; it += c.NGW) {
        int r = PART == 0 ? it : (PART == 1 ? it + I_IN + I_OUT : (it >> 6) * I_EXP + 128 + (it & 63) + I_IN + I_OUT);
        if (r < I_IN) { const int kb = r / 48, nb = r % 48; tr_item64(c.in(I_WIN) + (size_t)l * 1024 * NIN, NIN, NIN, kb * 64, nb * 64, c.wsp<bf16_t>(WS_WIN), 1024, nb * 64, nb * 64 < 1024, scr, c.lane); continue; }
        r -= I_IN;
        if (r < I_OUT) { const int kb = r / 16, nb = r % 16; tr_item64(c.in(I_WOUT) + (size_t)l * 1024 * 1024, 1024, 1024, kb * 64, nb * 64, c.wsp<bf16_t>(WS_WOUT), 1024, nb * 64, false, scr, c.lane); continue; }
        r -= I_OUT;
        const int e = r / I_EXP; int q = r % I_EXP;
        if (q < 128) wprep13_item(c, l, e, q, scr);
        else {
            q -= 128; const int kb = q / 16, nb = q % 16;
            const float* src = e < 64 ? c.in(I_W2) + ((size_t)l * 64 + e) * 256 * 1024 : c.in(I_WS2) + (size_t)l * 256 * 1024;
            tr_item64(src, 1024, 1024, kb * 64, nb * 64, c.wsp<bf16_t>(WS_W2) + (size_t)e * 1024 * 256, 256, nb * 64, false, scr, c.lane);
        }
    }
}

template <bool LOPART> __device__ __forceinline__ void norm_mod_row(const float* xrow, const float* nw, const float* sc, const float* sh, bf16_t* orow, bf16_t* lorow, int lane) {
    f32x4 v[4]; float ss = 0.f;
#pragma unroll
    for (int j = 0; j < 4; ++j) { v[j] = ((const f32x4*)xrow)[lane + 64 * j]; ss += (v[j][0] * v[j][0] + v[j][1] * v[j][1]) + (v[j][2] * v[j][2] + v[j][3] * v[j][3]); }
    ss = wave_sum(ss);
    const float rstd = rsqrtf(ss * (1.f / DM) + EPS);
#pragma unroll
    for (int j = 0; j < 4; ++j) { const int col = 4 * lane + 256 * j;
        const f32x4 w = *(const f32x4*)(nw + col), a = *(const f32x4*)(sc + col), s = *(const f32x4*)(sh + col);
        const f32x4 y = (v[j] * rstd) * w * (a + 1.f) + s;
        u32x2 o; o.x = pk2(y[0], y[1]); o.y = pk2(y[2], y[3]);
        *(u32x2*)(orow + col) = o;
        if (LOPART) { const float r0 = y[0] - __builtin_bit_cast(float, o.x << 16), r1 = y[1] - __builtin_bit_cast(float, o.x & 0xffff0000u), r2 = y[2] - __builtin_bit_cast(float, o.y << 16), r3 = y[3] - __builtin_bit_cast(float, o.y & 0xffff0000u);
            u32x2 lo; lo.x = pk2(r0, r1); lo.y = pk2(r2, r3); *(u32x2*)(lorow + col) = lo; } }
}
__device__ __forceinline__ const float* xrow_ptr(const Ctx& c, int l, int m) {
    if (m < TL) return (l == 0 ? c.in(I_X) : c.out()) + (size_t)m * DM;
    return ((l == 0 || ABL_CTXORIG) ? c.in(I_CTX) : c.wsp<float>(WS_XC)) + (size_t)(m - TL) * DM;
}
__device__ __forceinline__ void ph_norm1(const Ctx& c, int l) {
    const float* mods = c.wsp<float>(WS_MODS) + (size_t)l * 9 * 6144;
    bf16_t* hb = c.wsp<bf16_t>(WS_HB);
    for (int m = c.gw; m < MT; m += c.NGW) {
        const int j = m < TL ? m / SEQ : 8;
        norm_mod_row<false>(xrow_ptr(c, l, m), c.in(I_N1W) + l * DM, mods + j * 6144 + 1 * 1024, mods + j * 6144 + 0 * 1024, hb + (size_t)m * DM, nullptr, c.lane);
    }
}


namespace fa {
using f32x16 = __attribute__((ext_vector_type(16))) float;
using s16x4 = __attribute__((ext_vector_type(4))) short;
constexpr int SHM_V = 64 * 128 * 2, SHM_K = 64 * 128 * 2;
constexpr float THR = 8.f, C = 1.4426950408889634f;
#define FA_KSWZ(row, colB) ((row) * 256 + ((colB) ^ (((row) & 15) << 4)))
#define FA_SBAR() __builtin_amdgcn_sched_barrier(0)
__device__ __forceinline__ int crow(int r, int hi) { return (r & 3) + 8 * (r >> 2) + 4 * hi; }
__device__ __forceinline__ unsigned cvtpk(float lo, float hi) { unsigned r; asm volatile("v_cvt_pk_bf16_f32 %0, %1, %2" : "=v"(r) : "v"(lo), "v"(hi)); return r; }
template <int BASE> __device__ __forceinline__ bf16x8 pk8(const f32x16& P) {
    u32x4 w = {cvtpk(P[BASE + 0], P[BASE + 1]), cvtpk(P[BASE + 2], P[BASE + 3]), cvtpk(P[BASE + 4], P[BASE + 5]), cvtpk(P[BASE + 6], P[BASE + 7])};
    return *reinterpret_cast<bf16x8*>(&w);
}
__device__ __forceinline__ void partialSM(f32x16& p0, f32x16& p1, float& m_reg, float& mn, float& alpha) {
    float pmax = p0[0];
#pragma unroll
    for (int r = 1; r < 16; ++r) pmax = fmaxf(pmax, p0[r]);
#pragma unroll
    for (int r = 0; r < 16; ++r) pmax = fmaxf(pmax, p1[r]);
    { auto rr = __builtin_amdgcn_permlane32_swap(__float_as_uint(pmax), __float_as_uint(pmax), false, false); pmax = fmaxf(__uint_as_float(rr[0]), __uint_as_float(rr[1])); }
    if (__builtin_expect(__all(pmax - m_reg <= THR), 1)) { mn = m_reg; alpha = 1.f; }
    else { mn = fmaxf(m_reg, pmax); alpha = __builtin_amdgcn_exp2f((m_reg - mn) * C); m_reg = mn; }
    const float mnC = -mn * C;
#pragma unroll
    for (int r = 0; r < 16; ++r) p0[r] = fmaf(p0[r], C, mnC);
#pragma unroll
    for (int r = 0; r < 16; ++r) p1[r] = fmaf(p1[r], C, mnC);
#pragma unroll
    for (int r = 0; r < 16; ++r) p0[r] = __builtin_amdgcn_exp2f(p0[r]);
}
__device__ __forceinline__ void finishSM(f32x16& p0, f32x16& p1, float alpha, float& l_reg, bf16x8& pa0, bf16x8& pa1, bf16x8& pa2, bf16x8& pa3) {
#pragma unroll
    for (int r = 0; r < 16; ++r) p1[r] = __builtin_amdgcn_exp2f(p1[r]);
#if ATT_X == 1
#pragma unroll
    for (int r = 0; r < 16; ++r) { float t_; asm volatile("v_exp_f32 %0, %1" : "=v"(t_) : "v"(p1[r])); asm volatile("v_exp_f32 %0, %1" : "=v"(t_) : "v"(p0[r])); }
#endif
    float ps = 0;
#pragma unroll
    for (int r = 0; r < 16; ++r) ps += p0[r];
#pragma unroll
    for (int r = 0; r < 16; ++r) ps += p1[r];
    { auto rr = __builtin_amdgcn_permlane32_swap(__float_as_uint(ps), __float_as_uint(ps), false, false); ps = __uint_as_float(rr[0]) + __uint_as_float(rr[1]); }
    l_reg = l_reg * alpha + ps;
#define FA_PK4(P, BASE, OUT) do { unsigned a0 = cvtpk(P[BASE + 0], P[BASE + 1]), a1 = cvtpk(P[BASE + 2], P[BASE + 3]);   \
    unsigned b0 = cvtpk(P[BASE + 4], P[BASE + 5]), b1 = cvtpk(P[BASE + 6], P[BASE + 7]);                              \
    auto r0 = __builtin_amdgcn_permlane32_swap(a0, b0, false, false); auto r1 = __builtin_amdgcn_permlane32_swap(a1, b1, false, false); \
    u32x4 w = {r0[0], r1[0], r0[1], r1[1]}; OUT = *reinterpret_cast<bf16x8*>(&w); } while (0)
    FA_PK4(p0, 0, pa0); FA_PK4(p0, 8, pa1); FA_PK4(p1, 0, pa2); FA_PK4(p1, 8, pa3);
#undef FA_PK4
}
__device__ __forceinline__ void qkt(f32x16& p0, f32x16& p1, const LAS char* Ks, const bf16x8 (&qr)[4], int r32, int hi, int mcol) {
    p0 = ozero16(); p1 = p0;
#pragma unroll
    for (int d0 = 0; d0 < 4; ++d0) { const int cb = (mcol + d0 * 16 + hi * 8) * 2;
        const bf16x8 b0 = *reinterpret_cast<const LAS bf16x8*>(Ks + FA_KSWZ(r32, cb));
        const bf16x8 b1 = *reinterpret_cast<const LAS bf16x8*>(Ks + FA_KSWZ(32 + r32, cb));
        p0 = __builtin_amdgcn_mfma_f32_32x32x16_bf16(b0, qr[d0], p0, 0, 0, 0);
        p1 = __builtin_amdgcn_mfma_f32_32x32x16_bf16(b1, qr[d0], p1, 0, 0, 0); }
}
__device__ __forceinline__ void qkt_load(bf16x8 (&kf)[8], const LAS char* Ks, int r32, int hi, int mcol) {
#pragma unroll
    for (int d0 = 0; d0 < 4; ++d0) { const int cb = (mcol + d0 * 16 + hi * 8) * 2;
        kf[2 * d0] = *reinterpret_cast<const LAS bf16x8*>(Ks + FA_KSWZ(r32, cb));
        kf[2 * d0 + 1] = *reinterpret_cast<const LAS bf16x8*>(Ks + FA_KSWZ(32 + r32, cb)); }
}
__device__ __forceinline__ void qkt_mma(f32x16& p0, f32x16& p1, const bf16x8 (&kf)[8], const bf16x8 (&qr)[4], const f32x16& z) {
    p0 = __builtin_amdgcn_mfma_f32_32x32x16_bf16(kf[0], qr[0], z, 0, 0, 0);
    p1 = __builtin_amdgcn_mfma_f32_32x32x16_bf16(kf[1], qr[0], z, 0, 0, 0);
#pragma unroll
    for (int d0 = 1; d0 < 4; ++d0) {
        p0 = __builtin_amdgcn_mfma_f32_32x32x16_bf16(kf[2 * d0], qr[d0], p0, 0, 0, 0);
        p1 = __builtin_amdgcn_mfma_f32_32x32x16_bf16(kf[2 * d0 + 1], qr[d0], p1, 0, 0, 0); }
#if ATT_X == 2
    { f32x16 d_;
#pragma unroll
      for (int i = 0; i < 8; ++i) asm volatile("v_mfma_f32_32x32x16_bf16 %0, %1, %2, 0" : "=v"(d_) : "v"(kf[i]), "v"(qr[i & 3])); }
#endif
}
__device__ __forceinline__ int v_st(int k, int c) { const int kk = (k & ~0xC) | ((k & 4) << 1) | ((k & 8) >> 1); return ((kk >> 3) * 4 + (c >> 5)) * 512 + ((kk & 7) * 32 + (c & 31)) * 2; }
__device__ __forceinline__ int v_rd_base(int lane) { return ((lane & 3) << 3) | (((lane >> 2) & 3) << 6) | (((lane >> 4) & 1) << 5) | (((lane >> 5) & 1) << 8); }
constexpr int v_rd_off(int d0, int ks, int half) { return d0 * 512 + ks * 4096 + half * 2048; }
template <int OFF> __device__ __forceinline__ s16x4 tr_read(int vb) { s16x4 r; asm volatile("ds_read_b64_tr_b16 %0, %1 offset:%2" : "=&v"(r) : "v"(vb), "i"(OFF) : "memory"); return r; }
template <int D0> __device__ __forceinline__ void pv_one(f32x16& od, int vb, bf16x8 pa0, bf16x8 pa1, bf16x8 pa2, bf16x8 pa3) {
    const s16x4 l0 = tr_read<v_rd_off(D0, 0, 0)>(vb), h0 = tr_read<v_rd_off(D0, 0, 1)>(vb), l1 = tr_read<v_rd_off(D0, 1, 0)>(vb), h1 = tr_read<v_rd_off(D0, 1, 1)>(vb);
    const s16x4 l2 = tr_read<v_rd_off(D0, 2, 0)>(vb), h2 = tr_read<v_rd_off(D0, 2, 1)>(vb), l3 = tr_read<v_rd_off(D0, 3, 0)>(vb), h3 = tr_read<v_rd_off(D0, 3, 1)>(vb);
    asm volatile("s_waitcnt lgkmcnt(0)" ::: "memory"); FA_SBAR();
#define FA_PK(L, H) (bf16x8){L[0], L[1], L[2], L[3], H[0], H[1], H[2], H[3]}
    od = __builtin_amdgcn_mfma_f32_32x32x16_bf16(pa0, FA_PK(l0, h0), od, 0, 0, 0);
    od = __builtin_amdgcn_mfma_f32_32x32x16_bf16(pa1, FA_PK(l1, h1), od, 0, 0, 0);
    od = __builtin_amdgcn_mfma_f32_32x32x16_bf16(pa2, FA_PK(l2, h2), od, 0, 0, 0);
    od = __builtin_amdgcn_mfma_f32_32x32x16_bf16(pa3, FA_PK(l3, h3), od, 0, 0, 0);
#undef FA_PK
}
__device__ __forceinline__ void pv_d0(f32x16 (&o)[4], int vb, bf16x8 pa0, bf16x8 pa1, bf16x8 pa2, bf16x8 pa3) {
    pv_one<0>(o[0], vb, pa0, pa1, pa2, pa3); pv_one<1>(o[1], vb, pa0, pa1, pa2, pa3); pv_one<2>(o[2], vb, pa0, pa1, pa2, pa3); pv_one<3>(o[3], vb, pa0, pa1, pa2, pa3);
}
__device__ __forceinline__ void attn_unit(const bf16_t* Q, const bf16_t* K, const bf16_t* V, bf16_t* O, int qrow0, int h, int klat0, int nlat, int kctx0, int NT,
                                          float lam, float oscale, const float* subln, LAS char* lds) {
    int tid = threadIdx.x; asm volatile("" : "+v"(tid));
    const int wid = __builtin_amdgcn_readfirstlane(tid >> 6), lane = tid & 63, r32 = lane & 31, hi = lane >> 5, map = wid >> 2, wq = wid & 3;
    LAS char* V_lds = lds; LAS char* K_lds = lds + 4 * SHM_V;
    LAS float* wsc = (LAS float*)(lds + 4 * SHM_V + 4 * SHM_K) + wid * 64; LAS float* li_l = wsc; LAS float* al_l = wsc + 32;
    float l_reg = 0; f32x16 o[4]; { const f32x16 z16 = ozero16(); o[0] = z16; o[1] = z16; o[2] = z16; o[3] = z16; } bf16x8 qr[4];
    { const bf16_t* Qw = Q + (size_t)(qrow0 + wq * 32 + r32) * 512 + h * 128 + map * 64 + hi * 8;
#pragma unroll
      for (int d0 = 0; d0 < 4; ++d0) qr[d0] = *reinterpret_cast<const bf16x8*>(Qw + d0 * 16); }
    unsigned kofs[2], vofs[2];
#pragma unroll
    for (int i = 0; i < 2; ++i) { const int p = 2 * wid + i, row = 4 * p + (lane >> 4); kofs[i] = (unsigned)(row * 1024 + ((16 * (lane & 15)) ^ ((row & 15) << 4)));
        const int sub = 2 * p + (lane >> 5), k = (sub >> 2) * 8 + ((lane & 31) >> 2), cc = (sub & 3) * 32 + (lane & 3) * 8;
        vofs[i] = (unsigned)(k * 1024 + cc * 2); }
    const char* Kg = (const char*)K + h * 256; const char* Vg = (const char*)V + h * 256;
    const int vrb = (int)(size_t)V_lds + v_rd_base(lane);
    const int mcol = map * 64;
    const unsigned offL = (unsigned)klat0 * 1024u, offC = (unsigned)(kctx0 - 64 * nlat) * 1024u;
#define FA_TOFF(t) (((t) < nlat ? offL : offC) + (unsigned)(t) * 65536u)
#define FA_DMA(G, D) __builtin_amdgcn_global_load_lds((const unsigned*)(G), (LAS unsigned*)(D), 16, 0, 0)
#define FA_ISSUE_K(t) do { const int t_ = (t); const char* g_ = Kg + FA_TOFF(t_); asm volatile("" : "+s"(g_)); LAS char* d_ = K_lds + (t_ & 3) * SHM_K + wid * 2048; FA_DMA(g_ + kofs[0], d_); FA_DMA(g_ + kofs[1], d_ + 1024); } while (0)
#define FA_ISSUE_V(t) do { const int t_ = (t); const char* g_ = Vg + FA_TOFF(t_); asm volatile("" : "+s"(g_)); LAS char* d_ = V_lds + (t_ & 3) * SHM_V + wid * 2048; FA_DMA(g_ + vofs[0], d_); FA_DMA(g_ + vofs[1], d_ + 1024); } while (0)
#define FA_TOP(N) do { asm volatile("s_waitcnt vmcnt(" #N ")" ::: "memory"); __builtin_amdgcn_s_barrier(); asm volatile("" ::: "memory"); FA_SBAR(); } while (0)
#define FA_RESC(a) do { if (__any((a) < 1.f)) { if (hi == 0) al_l[r32] = (a); asm volatile("s_waitcnt lgkmcnt(0)" ::: "memory"); \
    _Pragma("unroll") for (int d = 0; d < 4; ++d) _Pragma("unroll") for (int r = 0; r < 16; ++r) o[d][r] *= al_l[crow(r, hi)]; } } while (0)
    typedef float f32x2 __attribute__((ext_vector_type(2)));
    f32x16 p0, p1, negm; float al = 1.f, pm; bf16x8 pa[4], kf[8]; s16x4 vl[2][4], vh[2][4]; f32x2 sA, sB;
#define FA_PK(L, H) (bf16x8){L[0], L[1], L[2], L[3], H[0], H[1], H[2], H[3]}
#define FA_MM(D0, KS, SET) o[D0] = __builtin_amdgcn_mfma_f32_32x32x16_bf16(pa[KS], FA_PK(vl[SET][KS], vh[SET][KS]), o[D0], 0, 0, 0)
#define FA_VRD(D0, SET) do { vl[SET][0] = tr_read<v_rd_off(D0, 0, 0)>(vb_); vh[SET][0] = tr_read<v_rd_off(D0, 0, 1)>(vb_); vl[SET][1] = tr_read<v_rd_off(D0, 1, 0)>(vb_); vh[SET][1] = tr_read<v_rd_off(D0, 1, 1)>(vb_); \
    vl[SET][2] = tr_read<v_rd_off(D0, 2, 0)>(vb_); vh[SET][2] = tr_read<v_rd_off(D0, 2, 1)>(vb_); vl[SET][3] = tr_read<v_rd_off(D0, 3, 0)>(vb_); vh[SET][3] = tr_read<v_rd_off(D0, 3, 1)>(vb_); } while (0)
#define FA_LWAIT() do { asm volatile("s_waitcnt lgkmcnt(0)" ::: "memory"); FA_SBAR(); } while (0)
#define FA_MAX0() do { pm = p0[0]; _Pragma("unroll") for (int r = 1; r < 16; ++r) pm = fmaxf(pm, p0[r]); } while (0)
#define FA_MAX1() do { _Pragma("unroll") for (int r = 0; r < 16; ++r) pm = fmaxf(pm, p1[r]); auto rr_ = __builtin_amdgcn_permlane32_swap(__float_as_uint(pm), __float_as_uint(pm), false, false); \
    pm = fmaxf(__uint_as_float(rr_[0]), __uint_as_float(rr_[1])); } while (0)
#define FA_CHK() do { if (__builtin_expect(__all(pm <= THR * C), 1)) { al = 1.f; } else { const float d_ = fmaxf(pm, 0.f); al = __builtin_amdgcn_exp2f(-d_); \
    _Pragma("unroll") for (int r = 0; r < 16; ++r) { negm[r] -= d_; p0[r] -= d_; p1[r] -= d_; } } } while (0)
#define FA_EXP(P, A, B) do { _Pragma("unroll") for (int r = A; r < B; ++r) P[r] = __builtin_amdgcn_exp2f(P[r]); } while (0)
#define FA_P2(P, R) (f32x2){P[R], P[(R) + 1]}
#define FA_SUM0() do { sA = FA_P2(p0, 0) + FA_P2(p0, 2); sB = FA_P2(p0, 4) + FA_P2(p0, 6); } while (0)
#define FA_SUM1() do { sA += FA_P2(p0, 8); sB += FA_P2(p0, 10); sA += FA_P2(p0, 12); sB += FA_P2(p0, 14); } while (0)
#define FA_SUM2() do { sA += FA_P2(p1, 0); sB += FA_P2(p1, 2); sA += FA_P2(p1, 4); sB += FA_P2(p1, 6); } while (0)
#define FA_SUM3() do { sA += FA_P2(p1, 8); sB += FA_P2(p1, 10); sA += FA_P2(p1, 12); sB += FA_P2(p1, 14); sA += sB; float ps_ = sA[0] + sA[1]; \
    auto rr_ = __builtin_amdgcn_permlane32_swap(__float_as_uint(ps_), __float_as_uint(ps_), false, false); ps_ = __uint_as_float(rr_[0]) + __uint_as_float(rr_[1]); l_reg = l_reg * al + ps_; } while (0)
    FA_ISSUE_K(0); FA_ISSUE_K(1); FA_ISSUE_V(0); FA_ISSUE_K(2);
    FA_TOP(4);
    FA_ISSUE_K(3); FA_ISSUE_V(1); FA_SBAR();
    { const f32x16 z = {0.f, 0.f, 0.f, 0.f, 0.f, 0.f, 0.f, 0.f, 0.f, 0.f, 0.f, 0.f, 0.f, 0.f, 0.f, 0.f};
      qkt_load(kf, K_lds, r32, hi, mcol); FA_SBAR(); qkt_mma(p0, p1, kf, qr, z); asm volatile("" : "+v"(p0), "+v"(p1)); FA_SBAR(); }
    qkt_load(kf, K_lds + SHM_K, r32, hi, mcol);
    FA_MAX0(); FA_MAX1();
    { const float nm_ = -pm;
#pragma unroll
      for (int r = 0; r < 16; ++r) { negm[r] = nm_; p0[r] += nm_; p1[r] += nm_; } }
    FA_EXP(p0, 0, 16); FA_EXP(p1, 0, 16); FA_SUM0(); FA_SUM1(); FA_SUM2(); FA_SUM3();
    pa[0] = pk8<0>(p0); pa[1] = pk8<8>(p0); pa[2] = pk8<0>(p1); pa[3] = pk8<8>(p1); FA_SBAR();
#pragma unroll 1
    for (int j = 1; j < NT; ++j) {
        FA_TOP(4);
        const int vb_ = vrb + ((j - 1) & 3) * SHM_V;
        qkt_mma(p0, p1, kf, qr, negm); asm volatile("" : "+v"(p0), "+v"(p1)); FA_SBAR();
        FA_VRD(0, 0);
        { const int tk = (j + 3 < NT) ? j + 3 : NT - 1, tv = (j + 1 < NT) ? j + 1 : NT - 1; FA_ISSUE_K(tk); FA_ISSUE_V(tv); } FA_SBAR();
        FA_LWAIT();
        FA_MM(0, 0, 0); FA_VRD(1, 1); FA_SBAR();
        FA_MM(0, 1, 0); FA_MAX0(); FA_SBAR();
        FA_MM(0, 2, 0); FA_MAX1(); FA_SBAR();
        FA_MM(0, 3, 0); FA_CHK(); FA_EXP(p0, 0, 2); FA_SBAR();
        FA_LWAIT();
        FA_MM(1, 0, 1); FA_VRD(2, 0); FA_EXP(p0, 2, 4); FA_SBAR();
        FA_MM(1, 1, 1); FA_EXP(p0, 4, 7); FA_SBAR();
        FA_MM(1, 2, 1); FA_EXP(p0, 7, 10); FA_SBAR();
        FA_MM(1, 3, 1); FA_EXP(p0, 10, 13); FA_SBAR();
        FA_LWAIT();
        FA_MM(2, 0, 0); FA_VRD(3, 1); FA_EXP(p0, 13, 16); FA_SBAR();
        FA_MM(2, 1, 0); FA_EXP(p1, 0, 3); FA_SUM0(); FA_SBAR();
        FA_MM(2, 2, 0); FA_EXP(p1, 3, 6); FA_SUM1(); FA_SBAR();
        FA_MM(2, 3, 0); FA_EXP(p1, 6, 8); FA_SBAR();
        FA_LWAIT();
        FA_MM(3, 0, 1); FA_EXP(p1, 8, 10); pa[0] = pk8<0>(p0); FA_SBAR();
        FA_MM(3, 1, 1); FA_EXP(p1, 10, 12); pa[1] = pk8<8>(p0); FA_SBAR();
        FA_MM(3, 2, 1); FA_EXP(p1, 12, 14); FA_SUM2(); pa[2] = pk8<0>(p1); FA_SBAR();
        FA_MM(3, 3, 1); FA_EXP(p1, 14, 16); FA_SBAR();
        FA_SUM3(); pa[3] = pk8<8>(p1); FA_SBAR();
        qkt_load(kf, K_lds + ((j + 1) & 3) * SHM_K, r32, hi, mcol); FA_SBAR();
        FA_RESC(al); FA_SBAR();
    }
    FA_TOP(0);
    { const int vb_ = vrb + ((NT - 1) & 3) * SHM_V;
      FA_VRD(0, 0); FA_LWAIT(); FA_MM(0, 0, 0); FA_VRD(1, 1); FA_MM(0, 1, 0); FA_MM(0, 2, 0); FA_MM(0, 3, 0); FA_LWAIT();
      FA_MM(1, 0, 1); FA_VRD(2, 0); FA_MM(1, 1, 1); FA_MM(1, 2, 1); FA_MM(1, 3, 1); FA_LWAIT();
      FA_MM(2, 0, 0); FA_VRD(3, 1); FA_MM(2, 1, 0); FA_MM(2, 2, 0); FA_MM(2, 3, 0); FA_LWAIT();
      FA_MM(3, 0, 1); FA_MM(3, 1, 1); FA_MM(3, 2, 1); FA_MM(3, 3, 1); }
#undef FA_PK
#undef FA_MM
#undef FA_VRD
#undef FA_LWAIT
#undef FA_MAX0
#undef FA_MAX1
#undef FA_CHK
#undef FA_EXP
#undef FA_P2
#undef FA_SUM0
#undef FA_SUM1
#undef FA_SUM2
#undef FA_SUM3
#undef FA_TOFF
#undef FA_TOP
#undef FA_ISSUE_K
#undef FA_ISSUE_V
#undef FA_DMA
    if (hi == 0) li_l[r32] = l_reg; asm volatile("s_waitcnt lgkmcnt(0)" ::: "memory");
    float rli[16];
#pragma unroll
    for (int r = 0; r < 16; ++r) rli[r] = __builtin_amdgcn_rcpf(li_l[crow(r, hi)]);
    __syncthreads();
    LAS float* EX = (LAS float*)lds;
    if (map == 1) {
#pragma unroll
        for (int d0 = 0; d0 < 4; ++d0)
#pragma unroll
            for (int r = 0; r < 16; ++r) EX[(wq * 32 + crow(r, hi)) * 128 + d0 * 32 + r32] = o[d0][r] * rli[r];
    }
    __syncthreads();
    if (map == 0) {
        float ss[16];
#pragma unroll
        for (int r = 0; r < 16; ++r) ss[r] = 0.f;
#pragma unroll
        for (int d0 = 0; d0 < 4; ++d0)
#pragma unroll
            for (int r = 0; r < 16; ++r) { const float v = o[d0][r] * rli[r] - lam * EX[(wq * 32 + crow(r, hi)) * 128 + d0 * 32 + r32]; o[d0][r] = v; ss[r] += v * v; }
#pragma unroll
        for (int r = 0; r < 16; ++r) {
#pragma unroll
            for (int ofs = 1; ofs < 32; ofs <<= 1) ss[r] += __shfl_xor(ss[r], ofs);
            ss[r] = rsqrtf(ss[r] * (1.f / 128.f) + EPS) * oscale; }
#pragma unroll
        for (int d0 = 0; d0 < 4; ++d0) { const float sw = subln[d0 * 32 + r32];
#pragma unroll
            for (int r = 0; r < 16; ++r) O[(size_t)(qrow0 + wq * 32 + crow(r, hi)) * DM + h * 128 + d0 * 32 + r32] = (bf16_t)f2bf(o[d0][r] * ss[r] * sw); }
    }
    __syncthreads();
#undef FA_RESC
}
}
__device__ __forceinline__ void ph_attn_fast(const Ctx& c, int l, int qsel = 0) {
    const bf16_t* Q = c.wsp<bf16_t>(WS_Q); const bf16_t* Kb = c.wsp<bf16_t>(WS_K); const bf16_t* Vb = c.wsp<bf16_t>(WS_V); bf16_t* hb = c.wsp<bf16_t>(WS_HB);
    const float lam_init = 0.8f - 0.6f * __expf(-0.3f * (float)l);
    LAS float* lamp = (LAS float*)(c.lds + 4 * fa::SHM_V + 4 * fa::SHM_K + 8 * 256);
    if (c.wave == 0) { const float* dl = c.in(I_DALAM) + l * 256; const float s1 = wave_sum(dl[c.lane] * dl[64 + c.lane]), s2 = wave_sum(dl[128 + c.lane] * dl[192 + c.lane]);
        if (c.lane == 0) lamp[0] = __expf(s1) - __expf(s2) + lam_init; }
    __syncthreads();
    const float lam = lamp[0];
    const float* subln = c.in(I_DASUB) + l * 128;
    const int nq = 128 + (l == 0 ? 8 : 0);
    unsigned* qctr = c.wsp<unsigned>(WS_CTL) + CW_ATTQ + l * 64 + qsel * 32;
    LAS int* qslot = (LAS int*)(c.lds + 4 * fa::SHM_V + 4 * fa::SHM_K + 8 * 256 + 64);
    const int xcd = (int)(blockIdx.x & 7);
    int qcur = 0;
#pragma unroll 1
    for (;;) {
        if (c.tid == 0) { int it = -1, s_ = qcur;
#pragma unroll 1
            for (; s_ < 8; ++s_) { const int q = (xcd + s_) & 7; const int v = (int)atomicAdd(qctr + q, 1u); if (v < nq) { it = q * 256 + v; break; } }
            qslot[0] = it; qslot[1] = s_; }
        __syncthreads();
        const int item = __builtin_amdgcn_readfirstlane(qslot[0]); qcur = __builtin_amdgcn_readfirstlane(qslot[1]);
        __syncthreads();
        if (item < 0) break;
        const int q = item >> 8, idx = item & 255;
        int b, h, qrow0, nlat;
        if (idx < 128) { const int bh = q * 4 + (idx >> 5); b = bh >> 2; h = bh & 3; qrow0 = b * SEQ + (idx & 31) * 128; nlat = SEQ / 64; }
        else { const int it = idx - 128, bh = q * 4 + (it >> 1); b = bh >> 2; h = bh & 3; qrow0 = TL + b * NCTX + (it & 1) * 128; nlat = 0; }
        fa::attn_unit(Q, Kb, Vb, hb, qrow0, h, b * SEQ, nlat, TL + b * NCTX, nlat + NCTX / 64, lam, 1.f - lam_init, subln, (LAS char*)c.lds);
    }
}


__device__ __forceinline__ void ph_s5_prep(const Ctx& c) {
    LAS float* PW = (LAS float*)c.lds;
    LAS float* BB = PW + 2 * 64 * 33 * 2;
    LAS float* CC = BB + 2 * 64 * 16 * 2;
    LAS float* KL = CC + 2 * 16 * 64 * 2;
    LAS float* FF = KL + 63 * 256;
    const int tid = c.tid;
#pragma unroll 1
    for (int item = c.bid; item < 256; item += c.G) {
        const int l = item >> 7, g = (item >> 3) & 15, part = item & 7;
        bf16_t* Mt = c.wsp<bf16_t>(ws_s5m(l)); bf16_t* Ft = c.wsp<bf16_t>(ws_s5f(l)); float* D32 = (float*)(c.ws() + ws_s5g(l) + 256 * 1024);
        if (tid < 128) { const int dir = tid >> 6, p = tid & 63; const int pi = ((l * 2 + dir) * 16 + g) * 64 + p;
            const float lr = c.in(I_S5LRE)[pi], li = c.in(I_S5LIM)[pi], step = __expf(c.in(I_S5STEP)[(l * 2 + dir) * 16 + g]);
            const float mag = __expf(lr * step); const float are = mag * __cosf(li * step), aim = mag * __sinf(li * step);
            const float den = lr * lr + li * li, nr = are - 1.f, ni = aim; FF[tid * 2] = (nr * lr + ni * li) / den; FF[tid * 2 + 1] = (ni * lr - nr * li) / den;
            float pr = 1.f, pim = 0.f; LAS float* pw = PW + (dir * 64 + p) * 66;
            for (int m = 0; m <= 32; ++m) { pw[2 * m] = pr; pw[2 * m + 1] = pim; const float nr2 = pr * are - pim * aim, ni2 = pr * aim + pim * are; pr = nr2; pim = ni2; }
            if (part == 0) { D32[((dir * 16 + g) * 64 + p) * 2] = pw[64]; D32[((dir * 16 + g) * 64 + p) * 2 + 1] = pw[65]; } }
        __syncthreads();
        for (int idx = tid; idx < 2048; idx += 512) { const int dir = idx >> 10, rem = idx & 1023;
            const size_t base = ((size_t)(l * 2 + dir) * 16 + g) * 1024 + rem; const float br = c.in(I_S5BRE)[base], bi = c.in(I_S5BIM)[base]; const int p = rem >> 4;
            const float fre = FF[(dir * 64 + p) * 2], fim = FF[(dir * 64 + p) * 2 + 1];
            BB[(dir * 1024 + rem) * 2] = fre * br - fim * bi; BB[(dir * 1024 + rem) * 2 + 1] = fre * bi + fim * br;
            CC[(dir * 1024 + rem) * 2] = c.in(I_S5CRE)[base]; CC[(dir * 1024 + rem) * 2 + 1] = c.in(I_S5CIM)[base]; }
        __syncthreads();
        const int lg_lo = 4 * part, nlg = 35;
        for (int idx = tid; idx < nlg * 64; idx += 512) { const int h4 = (idx & 3) * 4, t_ = idx >> 2, lg = lg_lo + t_ % nlg, ho = t_ / nlg, lag = lg - 31; f32x4 acc = {0.f, 0.f, 0.f, 0.f};
#pragma unroll 1
            for (int dir = 0; dir < 2; ++dir) { if ((dir == 0 && lag < 0) || (dir == 1 && lag > 0)) continue; const int m = lag < 0 ? -lag : lag;
#pragma unroll 4
                for (int p = 0; p < 64; ++p) { const float cr = CC[((dir * 16 + ho) * 64 + p) * 2], ci = CC[((dir * 16 + ho) * 64 + p) * 2 + 1], pr = PW[(dir * 64 + p) * 66 + 2 * m], pi2 = PW[(dir * 64 + p) * 66 + 2 * m + 1];
                    const float gr = cr * pr - ci * pi2, gi = cr * pi2 + ci * pr;
                    const f32x4 b0 = *(const LAS f32x4*)(BB + ((dir * 64 + p) * 16 + h4) * 2), b1 = *(const LAS f32x4*)(BB + ((dir * 64 + p) * 16 + h4 + 2) * 2);
                    acc[0] += gr * b0[0] - gi * b0[1]; acc[1] += gr * b0[2] - gi * b0[3]; acc[2] += gr * b1[0] - gi * b1[1]; acc[3] += gr * b1[2] - gi * b1[3]; } }
            if (lag == 0 && ho >= h4 && ho < h4 + 4) { const float dv = c.in(I_S5D)[l * 256 + g * 16 + ho];
#pragma unroll
                for (int e = 0; e < 4; ++e) if (ho == h4 + e) acc[e] += dv; }
            *(LAS f32x4*)(KL + lg * 256 + ho * 16 + h4) = acc; }
        __syncthreads();
        for (int idx = tid; idx < 64 * 96; idx += 512) { const int n = part * 64 + idx / 96, k8 = (idx % 96) * 8, ko = n >> 4, ho = n & 15; float v[8];
            if (k8 < 512) { const int ki = k8 >> 4, h0 = k8 & 15;
#pragma unroll
                for (int e = 0; e < 8; ++e) v[e] = KL[((ko - ki + 31) * 16 + ho) * 16 + h0 + e]; }
            else { const int q = k8 - 512, dir = q >> 7, p0 = (q & 127) >> 1; const int ex = dir == 0 ? ko + 1 : 32 - ko;
#pragma unroll
                for (int e = 0; e < 4; ++e) { const int p = p0 + e; const float cr = CC[((dir * 16 + ho) * 64 + p) * 2], ci = CC[((dir * 16 + ho) * 64 + p) * 2 + 1], pr = PW[(dir * 64 + p) * 66 + 2 * ex], pi2 = PW[(dir * 64 + p) * 66 + 2 * ex + 1];
                    v[2 * e] = cr * pr - ci * pi2; v[2 * e + 1] = -(cr * pi2 + ci * pr); } }
            u32x4 w; w.x = pk2(v[0], v[1]); w.y = pk2(v[2], v[3]); w.z = pk2(v[4], v[5]); w.w = pk2(v[6], v[7]);
            *(u32x4*)(Mt + ((size_t)g * 512 + n) * 768 + k8) = w; }
        for (int idx = tid; idx < 32 * 64; idx += 512) { const int r = part * 32 + (idx >> 6), k8 = (idx & 63) * 8, dir = r >> 7, p = (r & 127) >> 1, cpart = r & 1, ki = k8 >> 4, h0 = k8 & 15; const int ex = dir == 0 ? 31 - ki : ki;
            const float pr = PW[(dir * 64 + p) * 66 + 2 * ex], pi2 = PW[(dir * 64 + p) * 66 + 2 * ex + 1]; float v[8];
#pragma unroll
            for (int e = 0; e < 8; ++e) { const float br = BB[((dir * 64 + p) * 16 + h0 + e) * 2], bi = BB[((dir * 64 + p) * 16 + h0 + e) * 2 + 1]; v[e] = cpart == 0 ? pr * br - pi2 * bi : pr * bi + pi2 * br; }
            u32x4 w; w.x = pk2(v[0], v[1]); w.y = pk2(v[2], v[3]); w.z = pk2(v[4], v[5]); w.w = pk2(v[6], v[7]);
            *(u32x4*)(Ft + ((size_t)g * 256 + r) * 512 + k8) = w; }
        __syncthreads();
    }
    { LAS float* scr = (LAS float*)(c.lds + c.wave * 16640);
      for (int it = c.gw; it < 32; it += c.NGW) { const int l = it >> 4, kb = (it >> 2) & 3, nb = it & 3; tr_item64(c.in(I_S5WGLU) + (size_t)l * 65536, 256, 256, kb * 64, nb * 64, c.wsp<bf16_t>(ws_s5g(l)), 256, nb * 64, false, scr, c.lane); } }
}
__device__ __forceinline__ void ph_s5_scan(const Ctx& c, int l) {
    bf16_t* A = c.wsp<bf16_t>(WS_S5A); const float* L = c.wsp<float>(WS_S5L); const float* D32 = (const float*)(c.ws() + ws_s5g(l) + 256 * 1024);
    if (c.bid < 64 || c.bid >= 96) return;
    for (int idx = (c.bid - 64) * 512 + c.tid; idx < NB * 16 * 2 * 64; idx += 32 * 512) {
        const int p = idx & 63, dir = (idx >> 6) & 1, g = (idx >> 7) & 15, b = idx >> 11;
        const float dr = D32[((dir * 16 + g) * 64 + p) * 2], di = D32[((dir * 16 + g) * 64 + p) * 2 + 1];
        float sr = 0.f, si = 0.f;
#pragma unroll 1
        for (int n0 = 0; n0 < 136; n0 += 8) {
            f32x2 lv[8]; size_t rows[8];
#pragma unroll
            for (int q = 0; q < 8; ++q) { const int n = n0 + q; const int cc = dir == 0 ? n : (n < 8 ? 7 - n : 143 - n); rows[q] = (size_t)g * S5R + b * 136 + cc; lv[q] = *(const f32x2*)(L + rows[q] * 256 + dir * 128 + 2 * p); }
#pragma unroll
            for (int q = 0; q < 8; ++q) { *(unsigned*)(A + rows[q] * 768 + 512 + dir * 128 + 2 * p) = pk2(sr, si);
                const float nr = dr * sr - di * si + lv[q][0], ni = dr * si + di * sr + lv[q][1]; sr = nr; si = ni; }
        }
    }
}

namespace gdn {
using f32x16 = __attribute__((ext_vector_type(16))) float;
__device__ __forceinline__ int crow(int r, int hi) { return (r & 3) + 8 * (r >> 2) + 4 * hi; }
__device__ __forceinline__ int chunk_row0(int b, int ck) { return ck < 4 ? TL + b * NCTX + 64 * ck : b * SEQ + 64 * (ck - 4); }
}

__device__ __forceinline__ void ph_gdn_g1(const Ctx& c, int l, int nsteps = 9) {
    using namespace gdn;
    constexpr int XS = 129;
    LAS bf16_t* qs = (LAS bf16_t*)c.lds;
    LAS bf16_t* ks = qs + 4096; LAS bf16_t* vs = ks + 4096;
    LAS float* AT = (LAS float*)(c.lds + 24576);
    LAS float* X = AT + 8192;
    LAS float* bet = X + 2 * 64 * XS;
    LAS float* gg = bet + 128;
    LAS float* gcs = gg + 128;
    LAS float* betp = gcs + 128;
    LAS bf16_t* QKs = (LAS bf16_t*)(betp + 128);
    LAS float* esc = (LAS float*)(QKs + 8192);
    LAS float* eg = esc + 128;
    LAS float* egl = eg + 128;
    constexpr int XTLD = 72;
    LAS bf16_t* XT = (LAS bf16_t*)X;
    const bf16_t* Gq = c.wsp<bf16_t>(WS_G); const float* BA = c.wsp<float>(WS_BA);
    const float* cw = c.in(I_GCONV) + (size_t)l * 5 * 768;
    float* GLp = c.wsp<float>(WS_GL);
#pragma unroll 1
    for (int u = c.bid; u < NGU; u += c.G) {
        int tid = threadIdx.x; asm volatile("" : "+v"(tid));
        const int lane = tid & 63, wave = __builtin_amdgcn_readfirstlane(tid >> 6), r32 = lane & 31, hi = lane >> 5;
        const int ck = u % 68, bh = u / 68, h = bh & 3, b = bh >> 2;
        const int row0 = chunk_row0(b, ck);
        const int segbase = ck < 4 ? TL + b * NCTX : b * SEQ, seglen = ck < 4 ? NCTX : SEQ;
        unsigned char* rec0 = c.ws() + WS_REC0 + (size_t)u * REC_BYTES; unsigned char* rec1 = c.ws() + WS_REC1 + (size_t)u * REC_BYTES;
        { const int i = tid >> 3, part = tid & 7; const int t = row0 - segbase + i;
#pragma unroll
          for (int m = 0; m < 3; ++m) { const int ch = m * 256 + h * 64 + part * 8; float acc[8];
#pragma unroll
              for (int e = 0; e < 8; ++e) acc[e] = 0.f;
#pragma unroll
              for (int j = 0; j < 5; ++j) { const int tt = t + j - 2; const bool ok = tt >= 0 && tt < seglen; const int tc = tt < 0 ? 0 : (tt >= seglen ? seglen - 1 : tt);
                  const bf16x8 x = *(const bf16x8*)(Gq + (size_t)(segbase + tc) * 768 + ch); const float mk = ok ? 1.f : 0.f; const f32x4 w0 = *(const f32x4*)(cw + j * 768 + ch) * mk, w1 = *(const f32x4*)(cw + j * 768 + ch + 4) * mk;
#pragma unroll
                  for (int e = 0; e < 4; ++e) { acc[e] += w0[e] * bf2f((unsigned short)x[e]); acc[4 + e] += w1[e] * bf2f((unsigned short)x[4 + e]); } }
              float ss = 0.f;
#pragma unroll
              for (int e = 0; e < 8; ++e) { acc[e] = siluf(acc[e]); ss += acc[e] * acc[e]; }
              if (m < 2) { ss += __shfl_xor(ss, 1); ss += __shfl_xor(ss, 2); ss += __shfl_xor(ss, 4); const float rr = rsqrtf(ss + EPS) * (m == 0 ? 0.125f : 1.f);
#pragma unroll
                  for (int e = 0; e < 8; ++e) acc[e] *= rr; }
              u32x4 w; w.x = pk2(acc[0], acc[1]); w.y = pk2(acc[2], acc[3]); w.z = pk2(acc[4], acc[5]); w.w = pk2(acc[6], acc[7]);
              *(LAS u32x4*)((m == 0 ? qs : (m == 1 ? ks : vs)) + i * 64 + part * 8) = w; }
          if (part < 2) { const int dir = part; const float xb = BA[(size_t)(row0 + i) * 16 + dir * 4 + h], xa = BA[(size_t)(row0 + i) * 16 + 8 + dir * 4 + h] + c.in(I_GDT)[l * 8 + dir * 4 + h];
              const float sp = xa > 20.f ? xa : (xa < -15.f ? __expf(xa) : __logf(1.f + __expf(xa)));
              bet[dir * 64 + i] = sigmf(xb); gg[dir * 64 + i] = -__expf(c.in(I_GALOG)[l * 8 + dir * 4 + h]) * sp; } }
        __syncthreads();
        if (nsteps < 2) continue;
        if ((wave & 3) == 0) { const int dir = wave >> 2; const int pi = dir ? 63 - lane : lane; float g = gg[dir * 64 + pi];
#pragma unroll
            for (int ofs = 1; ofs < 64; ofs <<= 1) { const float o_ = __shfl_up(g, ofs); if (lane >= ofs) g += o_; }
            const float bp = bet[dir * 64 + pi], e_ = __expf(g), gl_ = __shfl(g, 63);
            gcs[dir * 64 + lane] = g; betp[dir * 64 + lane] = bp; esc[dir * 64 + lane] = bp * e_; eg[dir * 64 + lane] = e_; egl[dir * 64 + lane] = __expf(gl_ - g); }
        __syncthreads();
        { const int mat = wave >> 2, rt = (wave >> 1) & 1, ct = wave & 1; const LAS bf16_t* As = mat ? qs : ks; f32x16 acc = ozero16();
#pragma unroll
          for (int sx = 0; sx < 4; ++sx) { const bf16x8 a = *(const LAS bf16x8*)(As + (32 * rt + r32) * 64 + 16 * sx + 8 * hi), bb = *(const LAS bf16x8*)(ks + (32 * ct + r32) * 64 + 16 * sx + 8 * hi);
              acc = __builtin_amdgcn_mfma_f32_32x32x16_bf16(a, bb, acc, 0, 0, 0); }
#pragma unroll
          for (int dir = 0; dir < 2; ++dir) {
              const int colo = 32 * ct + r32, j = dir ? 63 - colo : colo; const float gj = gcs[dir * 64 + j];
#pragma unroll
              for (int r = 0; r < 16; ++r) { const int rowo = 32 * rt + crow(r, hi), i = dir ? 63 - rowo : rowo; const float gi = gcs[dir * 64 + i];
                  if (mat == 0) { if (j < i) AT[dir * 4096 + i * 64 + j] = betp[dir * 64 + i] * acc[r] * __expf(gi - gj); }
                  else QKs[dir * 4096 + i * 64 + j] = (bf16_t)f2bf(j <= i ? acc[r] * __expf(gi - gj) : 0.f); } } }
        __syncthreads();
        if (nsteps < 3) continue;
        { const LAS u32x4* QK4 = (const LAS u32x4*)QKs;
#pragma unroll
          for (int q = 0; q < 2; ++q) { const int idx = tid + 512 * q, dir = idx >> 9, ch = idx & 511; *(u32x4*)((dir ? rec1 : rec0) + 32768 + ch * 16) = QK4[dir * 512 + ch]; }
#pragma unroll
          for (int q = 0; q < 2; ++q) { const int idx = tid + 512 * q, dir = idx >> 9, i = (idx >> 3) & 63, d8 = (idx & 7) * 8, pi = dir ? 63 - i : i; const float sc = eg[dir * 64 + i];
              const bf16x8 x = *(const LAS bf16x8*)(qs + pi * 64 + d8); u32x4 w;
              w.x = pk2(bf2f((unsigned short)x[0]) * sc, bf2f((unsigned short)x[1]) * sc); w.y = pk2(bf2f((unsigned short)x[2]) * sc, bf2f((unsigned short)x[3]) * sc);
              w.z = pk2(bf2f((unsigned short)x[4]) * sc, bf2f((unsigned short)x[5]) * sc); w.w = pk2(bf2f((unsigned short)x[6]) * sc, bf2f((unsigned short)x[7]) * sc);
              *(u32x4*)((dir ? rec1 : rec0) + 16384 + (i * 64 + d8) * 2) = w; }
#pragma unroll
          for (int q = 0; q < 2; ++q) { const int idx = tid + 512 * q, dir = idx >> 9, d = (idx >> 3) & 63, i8 = (idx & 7) * 8; float v[8];
              const f32x4 s0 = *(const LAS f32x4*)(egl + dir * 64 + i8), s1 = *(const LAS f32x4*)(egl + dir * 64 + i8 + 4);
#pragma unroll
              for (int e = 0; e < 8; ++e) { const int ii = i8 + e, pii = dir ? 63 - ii : ii; v[e] = bf2f(ks[pii * 64 + d]) * (e < 4 ? s0[e & 3] : s1[e & 3]); }
              u32x4 w; w.x = pk2(v[0], v[1]); w.y = pk2(v[2], v[3]); w.z = pk2(v[4], v[5]); w.w = pk2(v[6], v[7]);
              *(u32x4*)((dir ? rec1 : rec0) + 24576 + (d * 64 + i8) * 2) = w; }
          if (tid < 2) GLp[tid * NGU + u] = eg[tid * 64 + 63]; }
        __syncthreads();
        if (nsteps < 4) continue;
        const int dir = wave >> 2;
        LAS bf16_t* Ub = QKs;
        if (tid < 128) { const int d_ = tid >> 6, blk = (tid >> 4) & 3, cc = tid & 15; const LAS float* Ab = AT + d_ * 4096 + (16 * blk) * 64 + 16 * blk; float x[16];
#pragma unroll
            for (int r = 0; r < 16; ++r) x[r] = (r == cc) ? 1.f : 0.f;
#pragma unroll
            for (int r = 1; r < 16; ++r) { f32x4 a[4];
#pragma unroll
                for (int q = 0; q < 4; ++q) if (4 * q < r) a[q] = *(const LAS f32x4*)(Ab + r * 64 + 4 * q);
                float acc = x[r];
#pragma unroll
                for (int c2 = 0; c2 < r; ++c2) acc -= a[c2 >> 2][c2 & 3] * x[c2];
                x[r] = acc; }
            LAS bf16_t* up = Ub + ((d_ * 4 + blk) * 16) * 16 + cc;
#pragma unroll
            for (int r = 0; r < 16; ++r) up[r * 16] = (bf16_t)f2bf(x[r]); }
        __syncthreads();
        { const int fr = lane & 15, g = lane >> 4, dw = wave & 3; const LAS float* A = AT + dir * 4096;
          LAS bf16_t* XTd = XT + dir * 128 * XTLD; const LAS bf16_t* Ud = Ub + dir * 4 * 256;
#pragma unroll
          for (int i = 0; i < 4; ++i) {
#pragma unroll
              for (int tt = 0; tt < 2; ++tt) { const int ct = dw * 2 + tt, col = 16 * ct + fr; f32x4 acc;
                  const LAS bf16_t* src = (ct < 4 ? vs : ks) + (col & 63); const LAS float* scp = (ct < 4 ? betp : esc) + dir * 64;
#pragma unroll
                  for (int r = 0; r < 4; ++r) { const int row = 16 * i + 4 * g + r, pi = dir ? 63 - row : row; acc[r] = scp[row] * bf2f(src[pi * 64]); }
#pragma unroll
                  for (int kk = 0; kk < (i + 1) / 2; ++kk) { const LAS float* ap = A + (16 * i + fr) * 64 + 32 * kk + 8 * g;
                      const f32x4 a0 = *(const LAS f32x4*)ap, a1 = *(const LAS f32x4*)(ap + 4); const bool ok = 32 * kk + 8 * g < 16 * i;
                      u32x4 aw; aw.x = ok ? pk2(-a0[0], -a0[1]) : 0u; aw.y = ok ? pk2(-a0[2], -a0[3]) : 0u; aw.z = ok ? pk2(-a1[0], -a1[1]) : 0u; aw.w = ok ? pk2(-a1[2], -a1[3]) : 0u;
                      u32x4 bw = *(const LAS u32x4*)(XTd + col * XTLD + 32 * kk + 8 * g); if (!ok) bw = (u32x4){0u, 0u, 0u, 0u};
                      const bf16x8 bfr = __builtin_bit_cast(bf16x8, bw);
                      acc = __builtin_amdgcn_mfma_f32_16x16x32_bf16(__builtin_bit_cast(bf16x8, aw), bfr, acc, 0, 0, 0); }
                  const u32x2 uu = *(const LAS u32x2*)(Ud + (i * 16 + fr) * 16 + 4 * g);
                  const u32x4 uw = {uu.x, uu.y, 0u, 0u}, tw = {pk2(acc[0], acc[1]), pk2(acc[2], acc[3]), 0u, 0u};
                  const f32x4 xi = __builtin_amdgcn_mfma_f32_16x16x32_bf16(__builtin_bit_cast(bf16x8, uw), __builtin_bit_cast(bf16x8, tw), ozero4(), 0, 0, 0);
                  { u32x2 xw; xw.x = pk2(xi[0], xi[1]); xw.y = pk2(xi[2], xi[3]); *(LAS u32x2*)(XTd + col * XTLD + 16 * i + 4 * g) = xw; } }
              if (i < 3) __syncthreads(); } }
        __syncthreads();
        if (nsteps < 5) continue;
        { const int ht = tid & 255; unsigned char* rec = dir ? rec1 : rec0; const LAS bf16_t* XTd = XT + dir * 128 * XTLD;
#pragma unroll
          for (int q = 0; q < 2; ++q) { const int idx = ht + 256 * q, dv = idx >> 3, c8 = (idx & 7) * 8; *(u32x4*)(rec + (dv * 64 + c8) * 2) = *(const LAS u32x4*)(XTd + dv * XTLD + c8); }
#pragma unroll
          for (int q = 0; q < 2; ++q) { const int idx = ht + 256 * q, ci = idx >> 3, d8 = (idx & 7) * 8; unsigned v[8];
#pragma unroll
              for (int e = 0; e < 8; ++e) v[e] = (unsigned)XTd[(64 + d8 + e) * XTLD + ci] ^ 0x8000u;
              u32x4 w; w.x = v[0] | (v[1] << 16); w.y = v[2] | (v[3] << 16); w.z = v[4] | (v[5] << 16); w.w = v[6] | (v[7] << 16); *(u32x4*)(rec + 8192 + (ci * 64 + d8) * 2) = w; } }
        __syncthreads();
    }
}
struct G2Ops { bf16x8 A1[4], A2[4]; u32x2 ut[4]; float glast; int row0; };
__device__ __forceinline__ void ph_gdn_g2(const Ctx& c, int l) {
    using namespace gdn;
    LAS bf16_t* ST = (LAS bf16_t*)c.lds;
    LAS bf16_t* VT = ST + 4096;
    bf16_t* GO = c.wsp<bf16_t>(WS_GO); const float* GLp = c.wsp<float>(WS_GL);
    const int tid = c.tid, lane = c.lane, wave = c.wave, r32 = lane & 31, hi = lane >> 5, role = wave >> 2, rt = (wave >> 1) & 1, ct = wave & 1;
#define G2_LOAD(OP, n_) do { const int n__ = (n_); const int ck_ = dir == 0 ? n__ : (n__ < 4 ? 3 - n__ : 71 - n__); const int u_ = bh * 68 + ck_; \
        const unsigned char* rec_ = wsb + (dir ? WS_REC1 : WS_REC0) + (size_t)u_ * REC_BYTES; OP.glast = GLp[dir * NGU + u_]; OP.row0 = chunk_row0(b, ck_); \
        const bf16_t* a1_ = (const bf16_t*)(rec_ + (role ? 16384 : 8192)) + (size_t)(32 * rt + r32) * 64 + 8 * hi; const bf16_t* a2_ = (const bf16_t*)(rec_ + (role ? 32768 : 24576)) + (size_t)(32 * rt + r32) * 64 + 8 * hi; \
        _Pragma("unroll") for (int sx = 0; sx < 4; ++sx) { OP.A1[sx] = *(const bf16x8*)(a1_ + 16 * sx); OP.A2[sx] = *(const bf16x8*)(a2_ + 16 * sx); } \
        const bf16_t* ut_ = (const bf16_t*)rec_ + (size_t)(32 * ct + r32) * 64 + 32 * rt + 4 * hi; \
        _Pragma("unroll") for (int g = 0; g < 4; ++g) OP.ut[g] = *(const u32x2*)(ut_ + 8 * g); } while (0)
#define G2_STEP(OP) do { \
        f32x16 acc = ozero16(); \
        if (role == 0) { _Pragma("unroll") for (int g = 0; g < 4; ++g) { const u32x2 w = OP.ut[g]; acc[4 * g] = __builtin_bit_cast(float, w.x << 16); acc[4 * g + 1] = __builtin_bit_cast(float, w.x & 0xffff0000u); \
            acc[4 * g + 2] = __builtin_bit_cast(float, w.y << 16); acc[4 * g + 3] = __builtin_bit_cast(float, w.y & 0xffff0000u); } } \
        _Pragma("unroll") for (int sx = 0; sx < 4; ++sx) { const bf16x8 bs = *(const LAS bf16x8*)(ST + (32 * ct + r32) * 64 + 16 * sx + 8 * hi); acc = __builtin_amdgcn_mfma_f32_32x32x16_bf16(OP.A1[sx], bs, acc, 0, 0, 0); } \
        if (role == 0) { _Pragma("unroll") for (int g = 0; g < 4; ++g) { u32x2 w; w.x = pk2(acc[4 * g], acc[4 * g + 1]); w.y = pk2(acc[4 * g + 2], acc[4 * g + 3]); *(LAS u32x2*)(VT + (32 * ct + r32) * 64 + 32 * rt + 8 * g + 4 * hi) = w; } } \
        __syncthreads(); \
        if (role == 0) { Sacc = Sacc * OP.glast; \
            _Pragma("unroll") for (int sx = 0; sx < 4; ++sx) { const bf16x8 bv = *(const LAS bf16x8*)(VT + (32 * ct + r32) * 64 + 16 * sx + 8 * hi); Sacc = __builtin_amdgcn_mfma_f32_32x32x16_bf16(OP.A2[sx], bv, Sacc, 0, 0, 0); } \
            _Pragma("unroll") for (int g = 0; g < 4; ++g) { u32x2 w; w.x = pk2(Sacc[4 * g], Sacc[4 * g + 1]); w.y = pk2(Sacc[4 * g + 2], Sacc[4 * g + 3]); *(LAS u32x2*)(ST + (32 * ct + r32) * 64 + 32 * rt + 8 * g + 4 * hi) = w; } \
        } else { \
            _Pragma("unroll") for (int sx = 0; sx < 4; ++sx) { const bf16x8 bv = *(const LAS bf16x8*)(VT + (32 * ct + r32) * 64 + 16 * sx + 8 * hi); acc = __builtin_amdgcn_mfma_f32_32x32x16_bf16(OP.A2[sx], bv, acc, 0, 0, 0); } \
            _Pragma("unroll") for (int r = 0; r < 16; ++r) { const int i = 32 * rt + crow(r, hi); const int pi = dir ? 63 - i : i; GO[((size_t)dir * MT + OP.row0 + pi) * 256 + h * 64 + 32 * ct + r32] = (bf16_t)f2bf(acc[r]); } \
        } \
        __syncthreads(); } while (0)
#pragma unroll 1
    for (int item = c.bid; item < NB * 4 * 2; item += c.G) {
        const int dir = item & 1, bh = item >> 1, h = bh & 3, b = bh >> 2;
        const unsigned char* wsb = c.ws();
        for (int i = tid; i < 2048; i += 512) ((LAS unsigned*)ST)[i] = 0u;
        f32x16 Sacc = ozero16();
        G2Ops opA, opB;
        G2_LOAD(opA, 0);
        __syncthreads();
#pragma unroll 1
        for (int n = 0; n < 68; n += 2) {
            G2_LOAD(opB, n + 1);
            G2_STEP(opA);
            G2_LOAD(opA, n + 2 < 68 ? n + 2 : 67);
            G2_STEP(opB);
        }
    }
#undef G2_LOAD
#undef G2_STEP
}
__device__ __forceinline__ void ph_gdn_finish(const Ctx& c, int l, int nrows) {
    const bf16_t* GO = c.wsp<bf16_t>(WS_GO); const bf16_t* Z = c.wsp<bf16_t>(WS_Z); bf16_t* hb = c.wsp<bf16_t>(WS_HB);
    const float nw = c.in(I_GNORM)[l * 64 + c.lane];
    for (int m = c.gw; m < nrows; m += c.NGW) {
#pragma unroll
        for (int h = 0; h < 4; ++h) { const float os = bf2f(GO[(size_t)m * 256 + h * 64 + c.lane]) + bf2f(GO[((size_t)MT + m) * 256 + h * 64 + c.lane]); const float ms = wave_sum(os * os) * (1.f / 64.f);
            const float z = bf2f(Z[(size_t)m * 256 + h * 64 + c.lane]); hb[(size_t)m * DM + 768 + h * 64 + c.lane] = (bf16_t)f2bf(os * rsqrtf(ms + EPS) * nw * siluf(z)); }
    }
}

__device__ __forceinline__ void ph_norm2(const Ctx& c, int l, int nrows) {
    const float* mods = c.wsp<float>(WS_MODS) + (size_t)l * 9 * 6144;
    bf16_t* hb = c.wsp<bf16_t>(WS_HB); bf16_t* lo = c.wsp<bf16_t>(WS_LO);
    for (int m = c.gw; m < nrows; m += c.NGW) { const int j = m < TL ? m / SEQ : 8;
        const float* xr = m < TL ? c.out() + (size_t)m * DM : c.wsp<float>(WS_XC) + (size_t)(m - TL) * DM;
        norm_mod_row<true>(xr, c.in(I_N2W) + l * DM, mods + j * 6144 + 4 * 1024, mods + j * 6144 + 3 * 1024, hb + (size_t)m * DM, lo + (size_t)m * DM, c.lane); }
}
__device__ __forceinline__ void ph_wr2(const Ctx& c, int l) {
    const float* W = c.in(I_WR) + (size_t)l * 65536; bf16_t* WR2 = c.wsp<bf16_t>(WS_WR2);
    for (int idx = c.bid * 512 + c.tid; idx < 2 * 256 * 128; idx += c.G * 512) { const int k8 = (idx & 127) * 8, n = (idx >> 7) & 255, g = idx >> 15;
        u32x4 w = {0u, 0u, 0u, 0u};
        const int kind = g == 0 ? (n < 64 ? 0 : (n < 128 ? 1 : 2)) : (n < 64 ? 0 : 2);
        if (kind < 2) { float v[8];
#pragma unroll
            for (int e = 0; e < 8; ++e) { const float x = W[(size_t)(k8 + e) * 64 + (n & 63)]; const float h = __builtin_bit_cast(float, f2bf(x) << 16); v[e] = kind == 0 ? x : x - h; }
            w.x = pk2(v[0], v[1]); w.y = pk2(v[2], v[3]); w.z = pk2(v[4], v[5]); w.w = pk2(v[6], v[7]); }
        *(u32x4*)(WR2 + ((size_t)g * 256 + n) * 1024 + k8) = w; }
}
constexpr int TOK_PER_BLK = 136;
constexpr size_t WS_BH = 9 * MiB + 512 * 1024;
__device__ __forceinline__ void ph_topk(const Ctx& c, int l, int nrows) {
    LAS int* hist = (LAS int*)c.lds;
    const float* lg = c.wsp<float>(WS_LOG); const float rbias = c.in(I_RB)[l * 64 + c.lane];
    int* tki = c.wsp<int>(WS_TKI); float* tkw = c.wsp<float>(WS_TKW); int* BH = c.wsp<int>(WS_BH);
    unsigned* cnt = c.wsp<unsigned>(WS_CTL) + CW_CNT + l * 128;
    if (c.tid < 64) hist[c.tid] = 0;
    __syncthreads();
    const int lane = c.lane, t_lo = c.bid * TOK_PER_BLK, t_hi = min(nrows, t_lo + TOK_PER_BLK);
    int mycount = 0;
    for (int t = t_lo + c.wave; t < t_hi; t += 8) {
        const float lgt = lg[(size_t)t * 128 + lane] + lg[(size_t)t * 128 + 64 + lane] + lg[((size_t)MT + t) * 128 + lane];
        const float sc = sigmf(lgt), s = sc + rbias;
        float m1 = s; m1 = fmaxf(m1, __shfl_xor(m1, 1)); m1 = fmaxf(m1, __shfl_xor(m1, 2)); m1 = fmaxf(m1, __shfl_xor(m1, 4));
        const unsigned long long eqm = __ballot(s == m1); const int gbase = lane & ~7; const unsigned gm = (unsigned)(eqm >> gbase) & 0xffu; const int first = gbase + __builtin_ctz(gm);
        float s2 = (lane == first) ? -3.0e38f : s; s2 = fmaxf(s2, __shfl_xor(s2, 1)); s2 = fmaxf(s2, __shfl_xor(s2, 2)); s2 = fmaxf(s2, __shfl_xor(s2, 4));
        const float gs = m1 + s2; const int g = lane >> 3;
        int grank = 0;
#pragma unroll
        for (int g2 = 0; g2 < 8; ++g2) { const float o = __builtin_bit_cast(float, __builtin_amdgcn_readlane(__builtin_bit_cast(int, gs), g2 * 8)); grank += (o > gs || (o == gs && g2 < g)) ? 1 : 0; }
        const float v = grank < 4 ? s : -3.0e38f;
        int rank = 0;
#pragma unroll
        for (int e2 = 0; e2 < 64; ++e2) { const float o = __builtin_bit_cast(float, __builtin_amdgcn_readlane(__builtin_bit_cast(int, v), e2)); rank += (o > v || (o == v && e2 < lane)) ? 1 : 0; }
        const bool chosen = rank < 8 && grank < 4;
        const float w = chosen ? sc : 0.f; const float wsum = wave_sum(w);
        if (chosen) { tki[(size_t)t * 8 + rank] = lane; tkw[(size_t)t * 8 + rank] = w * (2.5f / wsum); ++mycount; }
    }
    if (mycount) __hip_atomic_fetch_add(&hist[lane], mycount, __ATOMIC_RELAXED, __HIP_MEMORY_SCOPE_WORKGROUP);
    __syncthreads();
    if (c.tid < 64) { const int hv = hist[c.tid]; BH[c.bid * 64 + c.tid] = hv; if (hv > 0) atomicAdd(&cnt[c.tid], (unsigned)hv); }
}
__device__ __forceinline__ int moe_tstart(const Ctx& c, int l, int nrows, LAS int* tstart) {
    const unsigned* cnt = c.wsp<unsigned>(WS_CTL) + CW_CNT + l * 128;
    if (c.wave == 0) {
        const int n = (int)__hip_atomic_load(cnt + c.lane, __ATOMIC_RELAXED, __HIP_MEMORY_SCOPE_AGENT); const int t = (n + 255) >> 8; int inc = t;
#pragma unroll
        for (int ofs = 1; ofs < 64; ofs <<= 1) { const int o_ = __shfl_up(inc, ofs); if (c.lane >= ofs) inc += o_; }
        tstart[c.lane] = inc - t;
        if (c.lane == 63) { tstart[64] = inc; tstart[NE1] = inc + ((nrows + 255) >> 8); } }
    __syncthreads();
    return tstart[NE1];
}
__device__ __forceinline__ void ph_lists(const Ctx& c, int l, int nrows) {
    LAS int* tstart = (LAS int*)(c.lds + LDS_MISC - 1024);
    LAS int* base = (LAS int*)c.lds;
    moe_tstart(c, l, nrows, tstart);
    const unsigned* cnt = c.wsp<unsigned>(WS_CTL) + CW_CNT + l * 128; const int* BH = c.wsp<int>(WS_BH);
    const int* tki = c.wsp<int>(WS_TKI); const float* tkw = c.wsp<float>(WS_TKW);
    int* pos = c.wsp<int>(WS_POS); int* ltok = c.wsp<int>(WS_LTOK); float* lgate = c.wsp<float>(WS_LGATE);
    if (c.tid < 64) base[c.tid] = tstart[c.tid] * 256;
    __syncthreads();
    { const int e = c.tid & 63, part = c.tid >> 6; int acc = 0;
#pragma unroll 8
      for (int b2 = part; b2 < c.bid; b2 += 8) acc += BH[b2 * 64 + e];
      if (acc) __hip_atomic_fetch_add(&base[e], acc, __ATOMIC_RELAXED, __HIP_MEMORY_SCOPE_WORKGROUP); }
    __syncthreads();
    const int t_lo = c.bid * TOK_PER_BLK, t_hi = min(nrows, t_lo + TOK_PER_BLK);
    for (int idx = c.tid; idx < (t_hi - t_lo) * 8; idx += 512) { const int t = t_lo + (idx >> 3), k = idx & 7; const int e = tki[(size_t)t * 8 + k];
        const int p = __hip_atomic_fetch_add(&base[e], 1, __ATOMIC_RELAXED, __HIP_MEMORY_SCOPE_WORKGROUP);
        ltok[p] = t; lgate[p] = tkw[(size_t)t * 8 + k]; pos[(size_t)t * 8 + k] = p; }
    for (int t = t_lo + c.tid; t < t_hi; t += 512) { const int ps = tstart[64] * 256 + t; ltok[ps] = t; lgate[ps] = 1.f; }
    for (int e = c.bid; e < NE1; e += c.G) {
        const int n = e < 64 ? (int)__hip_atomic_load(cnt + e, __ATOMIC_RELAXED, __HIP_MEMORY_SCOPE_AGENT) : nrows; const int np = ((n + 255) >> 8) << 8;
        for (int j = n + c.tid; j < np; j += 512) { ltok[tstart[e] * 256 + j] = 0; lgate[tstart[e] * 256 + j] = 0.f; }
    }
}
__device__ __forceinline__ void ph_moe_reduce(const Ctx& c, int l, int q, int nrows) {
    LAS int* tstart = (LAS int*)(c.lds + LDS_MISC - 1024);
    moe_tstart(c, l, nrows, tstart);
    const int sbase = tstart[64] * 256;
    const unsigned char* ws = c.ws(); const int* pos = c.wsp<int>(WS_POS);
    const float* mods = c.wsp<float>(WS_MODS) + (size_t)l * 9 * 6144;
    typedef float f32x2v __attribute__((ext_vector_type(2)));
    int pn_[8];
    if (c.gw < nrows) {
#pragma unroll
        for (int k = 0; k < 8; ++k) pn_[k] = pos[(size_t)c.gw * 8 + k]; }
    for (int m = c.gw; m < nrows; m += c.NGW) {
        const int j = m < TL ? m / SEQ : 8;
        float* xr = (m < TL ? c.out() + (size_t)m * DM : c.wsp<float>(WS_XC) + (size_t)(m - TL) * DM) + 16 * c.lane;
        float* xw = q > 0 ? c.wsp<float>(WS_PROJ) + (size_t)m * DM + 16 * c.lane : xr;
        int pc_[8];
#pragma unroll
        for (int k = 0; k < 8; ++k) pc_[k] = pn_[k];
        if (m + c.NGW < nrows) {
#pragma unroll
            for (int k = 0; k < 8; ++k) pn_[k] = pos[(size_t)(m + c.NGW) * 8 + k]; }
        u32x4 w[9];
#pragma unroll
        for (int k = 0; k < 9; ++k) { const int p = k < 8 ? pc_[k] : sbase + m;
            const unsigned char* pr = p < PAIR_RA ? ws + WS_PAIRA + (size_t)p * 1024 : ws + WS_PAIRB + (size_t)(p - PAIR_RA) * 1024;
            w[k] = *(const u32x4*)(pr + 16 * c.lane); }
        float sacc[16];
#pragma unroll
        for (int e = 0; e < 16; ++e) sacc[e] = 0.f;
#pragma unroll
        for (int k = 0; k < 9; ++k)
#pragma unroll
            for (int d = 0; d < 4; ++d) { const int wd = (int)w[k][d]; const f32x2v lo = __builtin_amdgcn_cvt_pk_f32_fp8(wd, false), hi = __builtin_amdgcn_cvt_pk_f32_fp8(wd, true);
                sacc[4 * d] += lo[0]; sacc[4 * d + 1] += lo[1]; sacc[4 * d + 2] += hi[0]; sacc[4 * d + 3] += hi[1]; }
        const float* gp = mods + j * 6144 + 5 * 1024 + 16 * c.lane;
        f32x4 y[4]; float ss = 0.f;
#pragma unroll
        for (int d = 0; d < 4; ++d) { const f32x4 g = *(const f32x4*)(gp + 4 * d) * (1.f / PAIR_SCALE); const f32x4 sv = {sacc[4 * d], sacc[4 * d + 1], sacc[4 * d + 2], sacc[4 * d + 3]};
            y[d] = *(const f32x4*)(xr + 4 * d) + g * sv; ss += (y[d][0] * y[d][0] + y[d][1] * y[d][1]) + (y[d][2] * y[d][2] + y[d][3] * y[d][3]); }
        if (l == 1) { const float rstd = rsqrtf(wave_sum(ss) * (1.f / DM) + EPS); const float* fw = c.in(I_FNW) + 16 * c.lane;
#pragma unroll
            for (int d = 0; d < 4; ++d) y[d] = y[d] * rstd * *(const f32x4*)(fw + 4 * d); }
#pragma unroll
        for (int d = 0; d < 4; ++d) *(f32x4*)(xw + 4 * d) = y[d];
    }
}
__device__ __forceinline__ void ph_final(const Ctx& c) {
    const float* fw = c.in(I_FNW);
    for (int m = c.gw; m < TL; m += c.NGW) {
        float* xr = c.out() + (size_t)m * DM; f32x4 v[4]; float ss = 0.f;
#pragma unroll
        for (int j = 0; j < 4; ++j) { v[j] = ((const f32x4*)xr)[c.lane + 64 * j]; ss += (v[j][0] * v[j][0] + v[j][1] * v[j][1]) + (v[j][2] * v[j][2] + v[j][3] * v[j][3]); }
        const float rstd = rsqrtf(wave_sum(ss) * (1.f / DM) + EPS);
#pragma unroll
        for (int j = 0; j < 4; ++j) { const f32x4 w = *(const f32x4*)(fw + 4 * c.lane + 256 * j); ((f32x4*)xr)[c.lane + 64 * j] = v[j] * rstd * w; }
    }
}

enum { PH_PRE = 0, PH_B, PH_INP, PH_D, PH_D2, PH_E2, PH_E3, PH_OUTP, PH_N2, PH_N2B, PH_TOPK, PH_LISTS, PH_UP, PH_DOWN, PH_RED, PH_FINAL, PH_COUNT };

__device__ __forceinline__ void ph_ba(const Ctx& c) {
    const bf16_t* A = c.wsp<bf16_t>(WS_HB); const bf16_t* W = c.wsp<bf16_t>(WS_WIN) + (size_t)(NINP - 256) * 1024; float* BA = c.wsp<float>(WS_BA);
    int tid = c.tid; asm volatile("" : "+v"(tid));
    const int lane = tid & 63, fr = lane & 15, g = lane >> 4;
    constexpr int WLD = 1024 + 8;
    LAS bf16_t* Ws = (LAS bf16_t*)c.lds;
    __syncthreads();
#pragma unroll
    for (int q = 0; q < 4; ++q) { const int idx = tid + 512 * q, n = idx >> 7, k8 = (idx & 127) * 8; *(LAS u32x4*)(Ws + n * WLD + k8) = *(const u32x4*)(W + (size_t)n * 1024 + k8); }
    __syncthreads();
    const LAS bf16_t* wp = Ws + fr * WLD + 8 * g;
#pragma unroll 1
    for (int t = c.wave * c.G + c.bid; t < MT / 16; t += c.NGW) {
        const bf16_t* ap = A + (size_t)(t * 16 + fr) * 1024 + 8 * g;
        bf16x8 a[32];
#pragma unroll
        for (int kk = 0; kk < 32; ++kk) a[kk] = *(const bf16x8*)(ap + 32 * kk);
        f32x4 acc = ozero4();
#pragma unroll
        for (int kk = 0; kk < 32; ++kk) { const bf16x8 b = *(const LAS bf16x8*)(wp + 32 * kk); acc = __builtin_amdgcn_mfma_f32_16x16x32_bf16(a[kk], b, acc, 0, 0, 0); }
#pragma unroll
        for (int r = 0; r < 4; ++r) BA[(size_t)(t * 16 + 4 * g + r) * 16 + fr] = acc[r];
    }
    __syncthreads();
}
template <int PH> __device__ __forceinline__ void run_phase(const Ctx& c, int l, int q) {
    const int nrows_out = (l == 0) ? MT : TL;
    if constexpr (PH == PH_PRE) { ph_pre(c); __syncthreads(); ph_s5_prep(c); }
    if constexpr (PH == PH_B) { ph_wprep<0>(c, l); ph_norm1(c, l); }
    if constexpr (PH == PH_INP) {
        pg8::DenseSched<1024> S; S.init(c.wsp<void>(WS_HB), c.wsp<void>(WS_WIN), MT, NINP - 256, c.G, c.bid);
        EpiInProj E{c.ws(), c.wsp<f32x2>(WS_ROPE)};
        pg8::gemm_phase<1024>(c.lds, S, E);
        ph_ba(c);
    }
    if constexpr (PH == PH_D) {
        { GroupSched<512> S; S.A = c.wsp<char>(WS_S5A); S.a_gs = (size_t)S5R * 768 * 2; S.lda = 768; S.Bt = c.wsp<char>(ws_s5f(l)); S.b_gs = (size_t)256 * 512 * 2; S.nM = 5; S.nN = 1; S.nwg = 80; S.G = c.G; S.c = (c.bid + 128) & 255;
          EpiS5L E{c.wsp<float>(WS_S5L)}; pg8::gemm_phase<512>(c.lds, S, E); }
        __syncthreads();
        { int n_ = (DUP_SUB > 0 && DUP_SUB < 100) ? 2 : 1; asm volatile("" : "+s"(n_));
#pragma unroll 1
          for (int r_ = 0; r_ < n_; ++r_) { ph_gdn_g1(c, l, r_ == n_ - 1 ? 9 : DUP_SUB); __syncthreads(); } }
    }
    if constexpr (PH == PH_D2) { ph_gdn_g2(c, l); ph_s5_scan(c, l); __syncthreads(); ph_attn_fast(c, l, q); __syncthreads(); ph_wprep13_dyn(c, l, q);
        if (DUP_SUB == 101) { __syncthreads(); ph_attn_fast(c, l, q + 1); }
        if (DUP_SUB == 102) { __syncthreads(); ph_gdn_g2(c, l); }
        if (DUP_SUB == 103) { __syncthreads(); ph_s5_scan(c, l); } }
    if constexpr (PH == PH_E2) {
        ph_gdn_finish(c, l, nrows_out);
        { GroupSched<768> S; S.A = c.wsp<char>(WS_S5A); S.a_gs = (size_t)S5R * 768 * 2; S.lda = 768; S.Bt = c.wsp<char>(ws_s5m(l)); S.b_gs = (size_t)512 * 768 * 2; S.nM = 5; S.nN = 2; S.nwg = 160; S.G = c.G; S.c = c.bid;
          EpiS5Y E{c.wsp<bf16_t>(WS_ZS)}; pg8::gemm_phase<768>(c.lds, S, E); }
    }
    if constexpr (PH == PH_E3) {
        pg8::DenseSched<256> S; S.init(c.wsp<void>(WS_ZS), c.wsp<void>(ws_s5g(l)), nrows_out, 256, c.G, c.bid);
        EpiGlu E{c.wsp<bf16_t>(WS_ZS), c.wsp<bf16_t>(WS_HB), c.in(I_S5BGLU) + l * 256};
        pg8::gemm_phase<256>(c.lds, S, E);
    }
    if constexpr (PH == PH_OUTP) {
        pg8::DenseSched<1024> S; S.init(c.wsp<void>(WS_HB), c.wsp<void>(WS_WOUT), nrows_out, 1024, c.G, c.bid);
        EpiResid E{l == 0 ? c.in(I_X) : c.out(), l == 0 ? c.in(I_CTX) : c.wsp<float>(WS_XC), c.out(), c.wsp<float>(WS_XC), c.wsp<float>(WS_MODS) + (size_t)l * 9 * 6144, 2};
        pg8::gemm_phase<1024>(c.lds, S, E);
        if (l == 0) ph_wprep2_dyn(c, l, q);
    }
    if constexpr (PH == PH_N2) { ph_wr2(c, l); __syncthreads(); ph_norm2(c, l, nrows_out); }
    if constexpr (PH == PH_N2B) {
        GroupSched<1024> S; S.A = c.wsp<char>(WS_HB); S.a_gs = (size_t)(WS_LO - WS_HB); S.lda = 1024; S.Bt = c.wsp<char>(WS_WR2); S.b_gs = (size_t)256 * 1024 * 2; S.nM = nrows_out / 256; S.nN = 1; S.nwg = 2 * (nrows_out / 256); S.G = c.G; S.c = c.bid;
        EpiLogits E{c.wsp<float>(WS_LOG)}; pg8::gemm_phase<1024>(c.lds, S, E);
    }
    if constexpr (PH == PH_TOPK) { ph_topk(c, l, nrows_out); }
    if constexpr (PH == PH_LISTS) { ph_lists(c, l, nrows_out); }
    if constexpr (PH == PH_UP) {
        LAS int* tstart = (LAS int*)(c.lds + LDS_MISC - 1024);
        const int ntiles = moe_tstart(c, l, nrows_out, tstart);
        pg8::MoeSched<1024, true, true> S; S.A = c.wsp<char>(WS_HB); S.Bt = c.wsp<char>(WS_W13); S.ltok = c.wsp<int>(WS_LTOK); S.tstart = tstart; S.ntiles = ntiles; S.nN = 2; S.nwg = ntiles * 2; S.G = c.G; S.c = c.bid;
        S.bstride_e = (size_t)512 * 1024 * 2; S.bcol0 = 0;
        EpiMoeUp E{c.wsp<bf16_t>(WS_HID), c.wsp<float>(WS_LGATE)};
        pg8::gemm_phase<1024>(c.lds, S, E);
        if (l == 1) ph_wprep2_dyn(c, l, q);
    }
    if constexpr (PH == PH_DOWN) {
        LAS int* tstart = (LAS int*)(c.lds + LDS_MISC - 1024);
        const int ntiles = moe_tstart(c, l, nrows_out, tstart);
        pg8::MoeSched<256, false, true> S; S.A = c.wsp<char>(WS_HID); S.Bt = c.wsp<char>(WS_W2); S.ltok = nullptr; S.tstart = tstart; S.ntiles = ntiles; S.nN = 4; S.nwg = ntiles * 4; S.G = c.G; S.c = c.bid;
        S.bstride_e = (size_t)1024 * 256 * 2; S.bcol0 = 0;
        EpiMoeDown E{c.ws()};
        pg8::gemm_phase<256>(c.lds, S, E);
    }
    if constexpr (PH == PH_RED) { ph_moe_reduce(c, l, q, nrows_out); }
    if constexpr (PH == PH_FINAL) { ph_final(c); }
}

constexpr int LDS_PARAMS = LDS_MISC - 512;
__device__ __forceinline__ void stash_params(unsigned char* lds) {
    const __attribute__((address_space(4))) unsigned* ka = (const __attribute__((address_space(4))) unsigned*)__builtin_amdgcn_kernarg_segment_ptr();
    if (threadIdx.x < sizeof(Params) / 4) ((LAS unsigned*)((LAS unsigned char*)lds + LDS_PARAMS))[threadIdx.x] = ka[threadIdx.x];
    __syncthreads();
}
__device__ __forceinline__ Ctx make_ctx(unsigned char* lds) {
    Ctx c; c.pl = (const LAS unsigned*)((LAS unsigned char*)lds + LDS_PARAMS); c.lds = (LAS unsigned char*)lds; { int t_ = threadIdx.x; asm volatile("" : "+v"(t_)); c.tid = t_; } c.lane = c.tid & 63; c.wave = __builtin_amdgcn_readfirstlane(c.tid >> 6);
    c.G = gridDim.x; c.bid = blockIdx.x; c.gw = c.bid * 8 + c.wave; c.NGW = c.G * 8; return c;
}

template <int PH> __global__ void __launch_bounds__(512, 2) k_phase(Params p, int l, int q) {
    extern __shared__ __attribute__((aligned(16))) unsigned char lds[];
    stash_params(lds);
    const Ctx c = make_ctx(lds);
    run_phase<PH>(c, l, q);
}

#if ONE_LAUNCH
__global__ void __launch_bounds__(512, 2) k_mega(Params p) {
    extern __shared__ __attribute__((aligned(16))) unsigned char lds[];
    volatile LAS unsigned* misc = (volatile LAS unsigned*)((LAS unsigned char*)lds + LDS_MISC);
    if (threadIdx.x < 4) misc[threadIdx.x] = 0u;
    stash_params(lds);
    XcdBarrier bar = xcd_barrier_post((unsigned*)(p.ws + WS_CTL) + CW_BAR, misc);
#define GB() xcd_barrier(bar)
#ifndef REP_MASK
#define REP_MASK 0
#endif
#define RUN(PH, l, q) do { int n_ = ((REP_MASK >> PH) & 1) ? 2 : 1; asm volatile("" : "+s"(n_)); _Pragma("unroll 1") for (int r_ = 0; r_ < n_; ++r_) { if (r_) GB(); const Ctx c_ = make_ctx(lds); run_phase<PH>(c_, l, (q) + (n_ - 1 - r_)); } \
    if ((DUP_MASK >> PH) & 1) { GB(); const Ctx c2_ = make_ctx(lds); run_phase<PH>(c2_, l, (q) + 1); } } while (0)
    RUN(PH_PRE, 0, 0); GB();
#pragma unroll 1
    for (int l = 0; l < 2; ++l) {
        RUN(PH_B, l, 0); GB();
        RUN(PH_INP, l, 0); GB();
        RUN(PH_D, l, 0); GB();
        RUN(PH_D2, l, 0); GB();
        RUN(PH_E2, l, 0); GB();
        RUN(PH_E3, l, 0); GB();
        RUN(PH_OUTP, l, 0); GB();
        RUN(PH_N2, l, 0); GB();
        RUN(PH_N2B, l, 0); GB();
        RUN(PH_TOPK, l, 0); GB();
        RUN(PH_LISTS, l, 0); GB();
        RUN(PH_UP, l, 0); GB();
#pragma unroll 1
        RUN(PH_DOWN, l, 0); GB(); RUN(PH_RED, l, 0); if (l == 0) GB();
    }
#undef GB
#undef RUN
}
#endif


template <int PH> static void launch_phase(const Params& p, int l, int q, int grid, hipStream_t stream) {
    static bool attr = false;
    if (!attr) { (void)hipFuncSetAttribute((const void*)k_phase<PH>, hipFuncAttributeMaxDynamicSharedMemorySize, LDS_BYTES); attr = true; }
    hipLaunchKernelGGL(k_phase<PH>, dim3(grid), dim3(512), LDS_BYTES, stream, p, l, q);
}

extern "C" void kernel_launch(void* const* d_in, const int* in_sizes, int n_in, void* d_out, int out_size, void* d_ws, size_t ws_size, hipStream_t stream) {
    static int grid = 0;
    if (grid == 0) {
        if (n_in != 35 || out_size != TL * DM || ws_size < WS_END || (size_t)WS_END > ws_size) { fprintf(stderr, "kernel_launch: unexpected shapes n_in %d out %d ws %zu (need %zu)\n", n_in, out_size, ws_size, (size_t)WS_END); grid = -1; return; }
        int dev = 0, cus = 0;
        if (hipGetDevice(&dev) != hipSuccess || hipDeviceGetAttribute(&cus, hipDeviceAttributeMultiprocessorCount, dev) != hipSuccess) { grid = -1; return; }
#if ONE_LAUNCH
        (void)hipFuncSetAttribute((const void*)k_mega, hipFuncAttributeMaxDynamicSharedMemorySize, LDS_BYTES);
#endif
        grid = cus;
        if (grid != 256) { fprintf(stderr, "kernel_launch: built for a 256-CU device (got %d)\n", cus); grid = -1; return; }
    }
    if (grid < 0) return;
    (void)hipMemsetAsync((char*)d_ws + WS_CTL, 0, CTL_BYTES, stream);
    Params p{};
    for (int i = 0; i < 35; ++i) p.in[i] = (const float*)d_in[i];
    p.out = (float*)d_out; p.ws = (unsigned char*)d_ws;
#if ONE_LAUNCH
    hipLaunchKernelGGL(k_mega, dim3(grid), dim3(512), LDS_BYTES, stream, p);
#else
    launch_phase<PH_PRE>(p, 0, 0, grid, stream);
    for (int l = 0; l < 2; ++l) {
        launch_phase<PH_B>(p, l, 0, grid, stream);
        launch_phase<PH_INP>(p, l, 0, grid, stream);
        launch_phase<PH_D>(p, l, 0, grid, stream);
        launch_phase<PH_D2>(p, l, 0, grid, stream);
        launch_phase<PH_E2>(p, l, 0, grid, stream);
        launch_phase<PH_E3>(p, l, 0, grid, stream);
        launch_phase<PH_OUTP>(p, l, 0, grid, stream);
        launch_phase<PH_N2>(p, l, 0, grid, stream);
        launch_phase<PH_N2B>(p, l, 0, grid, stream);
        launch_phase<PH_TOPK>(p, l, 0, grid, stream);
        launch_phase<PH_LISTS>(p, l, 0, grid, stream);
        launch_phase<PH_UP>(p, l, 0, grid, stream);
        launch_phase<PH_DOWN>(p, l, 0, grid, stream); launch_phase<PH_RED>(p, l, 0, grid, stream);
    }
#endif
}
```

```cpp
#include <hip/hip_runtime.h>
#include <cstdio>
#include <cstdint>

#define ABL_ZERO_S5 0
#define ABL_ZERO_GDN 0
#define ABL_ZERO_ATT 0
#define ABL_NOCTXKEYS 0
#define ABL_CTXORIG 0
#define DBG_CHECK 0
#ifndef DUP_SUB
#define DUP_SUB 0
#endif
#ifndef ATT_X
#define ATT_X 0
#endif
#ifndef DUP_MASK
#define DUP_MASK 0
#endif
#ifndef ONE_LAUNCH
#define ONE_LAUNCH 1
#endif

#define LAS __attribute__((address_space(3)))
typedef unsigned short bf16_t;
typedef short bf16x8 __attribute__((ext_vector_type(8)));
typedef float f32x4 __attribute__((ext_vector_type(4)));
typedef float f32x2 __attribute__((ext_vector_type(2)));
typedef unsigned u32x4 __attribute__((ext_vector_type(4)));
typedef unsigned u32x2 __attribute__((ext_vector_type(2)));

constexpr int NB = 8, SEQ = 4096, DM = 1024, NCTX = 256;
constexpr int TL = NB * SEQ, TC = NB * NCTX, MT = TL + TC;
constexpr int NIN = 2832, NINP = 3072;
constexpr int NE1 = 65;
constexpr int PAIRS_PAD = 329728;
constexpr float EPS = 1e-6f;

constexpr size_t MiB = 1u << 20;
constexpr size_t WS_CTL = 0, CTL_BYTES = 1 * MiB;
constexpr size_t WS_MODS = 1 * MiB;
constexpr size_t WS_ROPE = 1 * MiB + 512 * 1024;
constexpr size_t WS_WIN = 2 * MiB;
constexpr size_t WS_WOUT = 8 * MiB;
constexpr size_t WS_W2 = 10 * MiB;
constexpr size_t WS_W13 = 43 * MiB;
constexpr size_t WS_HB = 108 * MiB;
constexpr size_t WS_XC = 365 * MiB;
constexpr size_t WS_WR2 = 8 * MiB;
constexpr size_t WS_TKI = 2 * MiB;
constexpr size_t WS_TKW = WS_TKI + 1152 * 1024;
constexpr size_t WS_POS = WS_TKW + 1152 * 1024;
constexpr size_t WS_LTOK = WS_POS + 1152 * 1024;
constexpr size_t WS_LGATE = WS_LTOK + 1344 * 1024;
constexpr size_t WS_PROJ = 204 * MiB;
constexpr size_t WS_Q = WS_PROJ, WS_K = WS_Q + 34 * MiB, WS_V = WS_K + 34 * MiB, WS_U = WS_V + 34 * MiB, WS_G = WS_U + 17 * MiB,
                 WS_Z = WS_G + 51 * MiB, WS_BA = WS_Z + 17 * MiB;
constexpr size_t WS_LOG = WS_PROJ;
constexpr size_t WS_HID = WS_PROJ;
constexpr size_t WS_MIX = 394 * MiB;
constexpr size_t WS_LO = WS_MIX;
constexpr size_t WS_S5A = WS_MIX;
constexpr size_t WS_S5L = WS_S5A + 30 * MiB;
constexpr size_t WS_S5M = WS_S5L + 20 * MiB;
constexpr size_t WS_S5F = WS_S5M + 12 * MiB;
constexpr size_t WS_S5G = WS_S5F + 4 * MiB;
constexpr size_t WS_REC1 = WS_S5G + 1 * MiB;
constexpr size_t WS_GL = WS_REC1 + 85 * MiB;
constexpr size_t WS_GO = WS_GL + 1 * MiB;
constexpr size_t WS_REC0 = WS_W2;
constexpr size_t WS_ZS = WS_U;
constexpr size_t REC_BYTES = 40960; constexpr int NGU = NB * 4 * 68;
static_assert((size_t)NGU * REC_BYTES <= 97 * MiB, "rec");
constexpr size_t WS_PAIRA = WS_W13;
constexpr size_t WS_PAIRB = 373 * MiB;
constexpr int PAIR_RA = 164864;
constexpr size_t WS_S5W1 = WS_GO + 34 * MiB;
constexpr size_t WS_END = WS_S5W1 + 17 * MiB;
constexpr int S5R = 1280, S5RV = 1088;
static_assert(WS_BA + (size_t)MT * 16 * 4 <= WS_MIX, "proj region");
static_assert(WS_HID + (size_t)PAIRS_PAD * 512 <= WS_MIX, "hid region");
static_assert(WS_PAIRA + (size_t)PAIR_RA * 1024 <= WS_HID && WS_PAIRB + (size_t)(PAIRS_PAD - PAIR_RA) * 1024 <= WS_END && WS_XC + 8 * MiB <= WS_PAIRB && WS_LGATE + 1344 * 1024 <= WS_WR2 && WS_HID + (size_t)PAIRS_PAD * 512 <= WS_XC, "pair region");
static_assert(WS_END <= 600 * MiB && WS_S5F == WS_S5M + 12 * MiB && WS_S5G == WS_S5F + 4 * MiB, "ws");
__host__ __device__ constexpr size_t ws_s5m(int l) { return l == 0 ? WS_S5M : WS_S5W1; }
__host__ __device__ constexpr size_t ws_s5f(int l) { return ws_s5m(l) + 12 * MiB; }
__host__ __device__ constexpr size_t ws_s5g(int l) { return ws_s5m(l) + 16 * MiB; }
static_assert(WS_REC1 + 85 * MiB <= WS_GL && WS_W2 + 33 * MiB <= WS_W13 && WS_W13 + 65 * MiB <= WS_HB, "mix");

constexpr int CW_BAR = 4096;
constexpr int CW_CNT = 16384;
constexpr int CW_FILL = 16384 + 256;
constexpr int CW_ATTQ = 16384 + 512;

constexpr int LDS_BYTES = 147456;
constexpr int LDS_MISC = 144 * 1024 - 256;

template <int CTRL> __device__ __forceinline__ float dpp_f(float v) { return __builtin_bit_cast(float, __builtin_amdgcn_update_dpp(0, __builtin_bit_cast(int, v), CTRL, 0xf, 0xf, true)); }
__device__ __forceinline__ float grp8_sum(float v) { v += dpp_f<0xB1>(v); v += dpp_f<0x4E>(v); v += dpp_f<0x141>(v); return v; }
__device__ __forceinline__ float grp16_sum(float v) { v = grp8_sum(v); v += dpp_f<0x140>(v); return v; }
__device__ __forceinline__ float grp8_max(float v) { v = fmaxf(v, dpp_f<0xB1>(v)); v = fmaxf(v, dpp_f<0x4E>(v)); v = fmaxf(v, dpp_f<0x141>(v)); return v; }
__device__ __forceinline__ float rl_f(float v, int lane) { return __builtin_bit_cast(float, __builtin_amdgcn_readlane(__builtin_bit_cast(int, v), lane)); }
__device__ __forceinline__ float grp32_sum(float v) { v = grp16_sum(v); const float lo = rl_f(v, 0) + rl_f(v, 16), hi = rl_f(v, 32) + rl_f(v, 48);
    return __builtin_amdgcn_mbcnt_hi(~0u, __builtin_amdgcn_mbcnt_lo(~0u, 0u)) >= 32u ? hi : lo; }
__device__ __forceinline__ float wave_sum(float v) { v = grp16_sum(v); return (rl_f(v, 0) + rl_f(v, 16)) + (rl_f(v, 32) + rl_f(v, 48)); }
typedef __bf16 hwbf16x2 __attribute__((ext_vector_type(2)));
typedef float hwf32x2 __attribute__((ext_vector_type(2)));
__device__ __forceinline__ unsigned f2bf(float f) { return (unsigned)__builtin_bit_cast(unsigned short, (__bf16)f); }
__device__ __forceinline__ f32x4 bf4_to_f32(unsigned a, unsigned b) { return (f32x4){__builtin_bit_cast(float, a << 16), __builtin_bit_cast(float, a & 0xffff0000u), __builtin_bit_cast(float, b << 16), __builtin_bit_cast(float, b & 0xffff0000u)}; }
__device__ __forceinline__ unsigned pk2(float lo, float hi) { const hwf32x2 v = {lo, hi}; return __builtin_bit_cast(unsigned, __builtin_convertvector(v, hwbf16x2)); }
__device__ __forceinline__ float bf2f(unsigned short b) { return __builtin_bit_cast(float, ((unsigned)b) << 16); }
__device__ __forceinline__ float siluf(float x) { return x * __builtin_amdgcn_rcpf(1.f + __expf(-x)); }
__device__ __forceinline__ float sigmf(float x) { return __builtin_amdgcn_rcpf(1.f + __expf(-x)); }
__device__ __forceinline__ float sigmf_exact(float x) { return 1.f / (1.f + __expf(-x)); }
__device__ __forceinline__ int dimperm(int r) { return 16 * ((r >> 2) & 1) + 4 * (r >> 3) + (r & 3); }
#define LDS_WAIT() asm volatile("s_waitcnt lgkmcnt(0)" ::: "memory")
__device__ __forceinline__ float ozero() { float z; asm volatile("v_mov_b32 %0, 0" : "=v"(z)); return z; }
__device__ __forceinline__ f32x4 ozero4() { const float z = ozero(); return (f32x4){z, z, z, z}; }
typedef float f32x16_t __attribute__((ext_vector_type(16)));
__device__ __forceinline__ f32x16_t ozero16() { const float z = ozero(); return (f32x16_t){z, z, z, z, z, z, z, z, z, z, z, z, z, z, z, z}; }

struct Params {
    const float* in[35];
    float* out;
    unsigned char* ws;
};
enum { I_X = 0, I_C, I_CTX, I_CCTX, I_N1W, I_N2W, I_WMOD, I_BMOD, I_WIN, I_WOUT, I_DALAM, I_DASUB, I_S5LRE, I_S5LIM, I_S5STEP, I_S5BRE, I_S5BIM,
       I_S5CRE, I_S5CIM, I_S5D, I_S5WGLU, I_S5BGLU, I_GCONV, I_GALOG, I_GDT, I_GNORM, I_WR, I_RB, I_W1, I_W3, I_W2, I_WS1, I_WS3, I_WS2, I_FNW };

#define XB_TMO      128
#define XB_XCNT(j)  (256  + 64 * (j))
#define XB_XSUB(j)  (1280 + 64 * (j))
#define XB_XGEN(j)  (2304 + 64 * (j))
#define XB_TOP      3328
#define XB_TOPGEN   3392
#define XCD_BAR_WORDS 3456
#define XB_SPIN_CAP (1u << 22)
__device__ __forceinline__ unsigned xb_ld(unsigned* p)              { return __hip_atomic_load(p, __ATOMIC_RELAXED, __HIP_MEMORY_SCOPE_AGENT); }
__device__ __forceinline__ unsigned xb_add(unsigned* p, unsigned v) { return __hip_atomic_fetch_add(p, v, __ATOMIC_RELAXED, __HIP_MEMORY_SCOPE_AGENT); }
__device__ __forceinline__ unsigned xb_xcc_id() { return (unsigned)__builtin_amdgcn_s_getreg((3 << 11) | 20) & 0xFu; }
#define XB_SPIN(cond, bar) do { unsigned _sp = 0; while (cond) { __builtin_amdgcn_s_sleep(1); \
    if ((++_sp & 255u) == 0u) { if (xb_ld(&(bar)[XB_TMO])) break; if (_sp > XB_SPIN_CAP) { atomicAdd(&(bar)[XB_TMO], 1u); break; } } } } while (0)
struct XcdBarrier { unsigned* bar; unsigned x; volatile LAS unsigned* st; };
__device__ __forceinline__ XcdBarrier xcd_barrier_post(unsigned* bar, volatile LAS unsigned* st) {
    XcdBarrier b; b.bar = bar; b.x = xb_xcc_id(); b.st = st;
    if (threadIdx.x == 0) (void)xb_add(&bar[XB_XCNT(b.x)], 1u);
    return b;
}
__device__ __forceinline__ void xcd_barrier_complete(unsigned* bar, unsigned x, unsigned& nloc, unsigned& nx) {
    const unsigned G = gridDim.x * gridDim.y * gridDim.z;
    unsigned sum, cnt, mine, sp = 0u;
    for (;;) {
        sum = 0u; cnt = 0u; mine = 0u;
#pragma unroll
        for (unsigned j = 0; j < 16; ++j) { const unsigned c = xb_ld(&bar[XB_XCNT(j)]); sum += c; cnt += (c > 0u) ? 1u : 0u; mine = (j == x) ? c : mine; }
        if (sum == G) break;
        __builtin_amdgcn_s_sleep(1);
        if ((++sp & 255u) == 0u) { if (xb_ld(&bar[XB_TMO])) break; if (sp > XB_SPIN_CAP) { atomicAdd(&bar[XB_TMO], 1u); break; } }
    }
    nloc = mine > 0u ? mine : 1u; nx = cnt > 0u ? cnt : 1u;
}
__device__ __forceinline__ void xcd_barrier(const XcdBarrier& b) {
    asm volatile("s_waitcnt vmcnt(0)" ::: "memory");
    __syncthreads();
    if (threadIdx.x == 0) {
        unsigned* bar = b.bar; asm volatile("" : "+s"(bar)); unsigned bx_ = __builtin_amdgcn_readfirstlane(b.x); asm volatile("" : "+s"(bx_));
        __builtin_amdgcn_s_waitcnt(0);
        unsigned nloc = b.st[0], nx = b.st[1];
        if (nloc == 0u) { xcd_barrier_complete(bar, bx_, nloc, nx); b.st[0] = nloc; b.st[1] = nx; }
        const unsigned old = xb_add(&bar[XB_XSUB(bx_)], 1u);
        const unsigned gen = old / nloc;
        if (old + 1u == (gen + 1u) * nloc) {
            __builtin_amdgcn_fence(__ATOMIC_RELEASE, "agent");
            asm volatile("s_waitcnt vmcnt(0)" ::: "memory");
            const unsigned og = xb_add(&bar[XB_TOP], 1u);
            const unsigned tg = og / nx;
            if (og + 1u == (tg + 1u) * nx) xb_add(&bar[XB_TOPGEN], 1u);
            else XB_SPIN(xb_ld(&bar[XB_TOPGEN]) == tg, bar);
            __builtin_amdgcn_fence(__ATOMIC_ACQUIRE, "agent");
            xb_add(&bar[XB_XGEN(bx_)], 1u);
            asm volatile("s_waitcnt vmcnt(0)" ::: "memory");
        } else {
            XB_SPIN(xb_ld(&bar[XB_XGEN(bx_)]) == gen, bar);
            __builtin_amdgcn_fence(__ATOMIC_ACQUIRE, "agent");
            asm volatile("s_waitcnt vmcnt(0)" ::: "memory");
        }
    }
    __syncthreads();
}

namespace pg8 {
constexpr int BM = 256, BK = 64, HALF = 128, HTB = HALF * BK * 2, STAGE_BYTES = 8 * HTB, NXCD = 8, WGM = 8;
__device__ __forceinline__ int lds_byte(int r, int c) { const int st = (r >> 4) * 2 + (c >> 5), rr = r & 15, cc = c & 31, ob = rr * 64 + cc * 2; return st * 1024 + (ob ^ (((ob >> 9) & 1) << 5)); }
__device__ __forceinline__ void stage_rc(int b, int& R, int& C) { const int st = b / 1024, sb = b % 1024, swz = sb ^ (((sb >> 9) & 1) << 5); R = (st >> 1) * 16 + swz / 64; C = (st & 1) * 32 + (swz % 64) / 2; }
__device__ __forceinline__ int perm32(int rho) { const int n = rho >> 4, i = rho & 15; return 8 * (i >> 2) + 4 * n + (i & 3); }
__device__ __forceinline__ unsigned cvt_pk_bf16(float lo, float hi) { unsigned r; asm volatile("v_cvt_pk_bf16_f32 %0, %1, %2" : "=v"(r) : "v"(lo), "v"(hi)); return r; }

struct Unit { int pm, pn, e, row0; };

__device__ __forceinline__ int xcd_remap(int wgid, int nwg) { const int q = nwg / NXCD, r = nwg % NXCD, xcd = wgid % NXCD, off = wgid / NXCD; return (xcd < r ? xcd * (q + 1) : r * (q + 1) + (xcd - r) * q) + off; }

template <int K, class Epi, class Sched, bool ALIGN_EPI = true, bool SP2 = true>
__device__ __forceinline__ void gemm_phase(LAS unsigned char* lds, const Sched& S, const Epi& E) {
    int tid = threadIdx.x; asm volatile("" : "+v"(tid));
    const int wid = __builtin_amdgcn_readfirstlane(tid >> 6), lane = tid & 63, wr = wid >> 2, wc = wid & 3, fr = lane & 15, fq = lane >> 4;
    constexpr int nt = K / BK;
    unsigned voffB[2];
#pragma unroll
    for (int i = 0; i < 2; ++i) { int R, C; stage_rc(tid * 16 + i * 8192, R, C); const int Rb = Epi::PERM ? ((R & ~31) + perm32(R & 31)) : R; voffB[i] = (unsigned)(Rb * K + C) * 2u; }
    constexpr size_t kstep = (size_t)(BK * 2);
    constexpr size_t hstep = (size_t)HALF * K * 2;
    const unsigned ldsw = (unsigned)wid * 1024u;
    const int aoff = lds_byte(wr * 64 + fr, fq * 8), boff = lds_byte(wc * 32 + fr, fq * 8);
#define PG8_SA(b, h) (((b) * 2 + (h)) * HTB)
#define PG8_SB(b, h) ((4 + (b) * 2 + (h)) * HTB)
#define PG8_STAGE2(bufoff, gbase, v0, v1) do { \
        __builtin_amdgcn_global_load_lds((const unsigned*)((const char*)(gbase) + (v0)), (LAS unsigned*)(lds + (bufoff) + ldsw), 16, 0, 0); \
        __builtin_amdgcn_global_load_lds((const unsigned*)((const char*)(gbase) + (v1)), (LAS unsigned*)(lds + (bufoff) + ldsw + 8192), 16, 0, 0); } while (0)
#define PG8_STAGEB(bufoff, gbase) PG8_STAGE2(bufoff, gbase, voffB[0], voffB[1])
#define PG8_LDA(dst, b, h) do { _Pragma("unroll") for (int m = 0; m < 4; ++m) _Pragma("unroll") for (int k = 0; k < 2; ++k) dst[m][k] = *(const LAS bf16x8*)(lds + PG8_SA(b, h) + aoff + m * 2048 + k * 1024); } while (0)
#define PG8_LDB(dst, b, h) do { _Pragma("unroll") for (int n = 0; n < 2; ++n) _Pragma("unroll") for (int k = 0; k < 2; ++k) dst[n][k] = *(const LAS bf16x8*)(lds + PG8_SB(b, h) + boff + n * 2048 + k * 1024); } while (0)
#define PG8_MMA(ai, bj, At, Bt) do { __builtin_amdgcn_s_setprio(1); _Pragma("unroll") for (int m = 0; m < 4; ++m) _Pragma("unroll") for (int n = 0; n < 2; ++n) _Pragma("unroll") for (int k = 0; k < 2; ++k) \
        acc[ai][bj][m][n] = __builtin_amdgcn_mfma_f32_16x16x32_bf16(Bt[n][k], At[m][k], acc[ai][bj][m][n], 0, 0, 0); __builtin_amdgcn_s_setprio(0); } while (0)
#define PG8_WAIT_V(n) asm volatile("s_waitcnt vmcnt(" #n ")" ::: "memory")
#define PG8_WAIT_L(n) asm volatile("s_waitcnt lgkmcnt(" #n ")" ::: "memory")
#define PG8_BAR __builtin_amdgcn_s_barrier()
#define PG8_SCHED __builtin_amdgcn_sched_barrier(0)
    Unit cur, nxt; int ui = 0;
    if (!S.next(0, cur)) return;
    f32x4 acc[2][2][4][2];
    float zero_ = 0.f; asm volatile("" : "+v"(zero_));
#pragma unroll
    for (int a = 0; a < 2; ++a)
#pragma unroll
        for (int b = 0; b < 2; ++b)
#pragma unroll
            for (int m = 0; m < 4; ++m)
#pragma unroll
                for (int n = 0; n < 2; ++n) acc[a][b][m][n] = (f32x4){zero_, zero_, zero_, zero_};
    bf16x8 At[4][2], B0[2][2], B1[2][2];
    unsigned vA[2][2], nvA[2][2];
    S.a_voff(cur, tid, vA);
    const char* cA = S.a_base(cur); const char* cB = S.b_base(cur);
    if constexpr (SP2) {
        PG8_STAGEB(PG8_SB(0, 0), cB); PG8_STAGEB(PG8_SB(0, 1), cB + hstep); PG8_STAGE2(PG8_SA(0, 0), cA, vA[0][0], vA[0][1]); PG8_STAGE2(PG8_SA(0, 1), cA, vA[1][0], vA[1][1]);
        if (wr == 1) PG8_BAR;
        PG8_WAIT_V(2); PG8_BAR;
        PG8_STAGEB(PG8_SB(1, 0), cB + kstep); PG8_STAGE2(PG8_SA(1, 0), cA + kstep, vA[0][0], vA[0][1]); PG8_STAGEB(PG8_SB(1, 1), cB + hstep + kstep);
        PG8_WAIT_V(6); PG8_BAR;
    } else {
        PG8_STAGEB(PG8_SB(0, 0), cB); PG8_STAGE2(PG8_SA(0, 0), cA, vA[0][0], vA[0][1]); PG8_STAGEB(PG8_SB(0, 1), cB + hstep); PG8_STAGE2(PG8_SA(0, 1), cA, vA[1][0], vA[1][1]);
        if (wr == 1) PG8_BAR;
        PG8_WAIT_V(4); PG8_BAR;
        PG8_STAGEB(PG8_SB(1, 0), cB + kstep); PG8_STAGE2(PG8_SA(1, 0), cA + kstep, vA[0][0], vA[0][1]); PG8_STAGEB(PG8_SB(1, 1), cB + hstep + kstep);
        PG8_WAIT_V(6); PG8_BAR;
    }
    for (;;) {
        const bool has_next = S.next(ui + 1, nxt);
        const char* nA = cA; const char* nB = cB;
#pragma unroll
        for (int h = 0; h < 2; ++h)
#pragma unroll
            for (int i = 0; i < 2; ++i) nvA[h][i] = vA[h][i];
        if (has_next) { S.a_voff(nxt, tid, nvA); nA = S.a_base(nxt); nB = S.b_base(nxt); }
        asm volatile(".p2align 6" ::: "memory");
#pragma unroll 1
        for (int t = 0; t < nt; t += 2) {
            const bool last = (t == nt - 2);
            const char* a1 = cA + (size_t)(t + 1) * kstep;
            const char* a2 = last ? nA : cA + (size_t)(t + 2) * kstep; const char* b2 = last ? nB : cB + (size_t)(t + 2) * kstep;
            const char* a3 = a2 + kstep; const char* b3 = b2 + kstep;
            const unsigned s00 = last ? nvA[0][0] : vA[0][0], s01 = last ? nvA[0][1] : vA[0][1], s10 = last ? nvA[1][0] : vA[1][0], s11 = last ? nvA[1][1] : vA[1][1];
            if constexpr (SP2) {
            PG8_LDB(B0, 0, 0); PG8_LDB(B1, 0, 1); PG8_SCHED; PG8_LDA(At, 0, 0); PG8_STAGE2(PG8_SA(1, 1), a1, vA[1][0], vA[1][1]);
            PG8_WAIT_V(8); PG8_WAIT_L(0); PG8_BAR; PG8_MMA(0, 0, At, B0); PG8_MMA(0, 1, At, B1); PG8_BAR; PG8_SCHED;
            PG8_LDA(At, 0, 1); PG8_STAGEB(PG8_SB(0, 0), b2); PG8_STAGEB(PG8_SB(0, 1), b2 + hstep); PG8_STAGE2(PG8_SA(0, 0), a2, s00, s01);
            PG8_WAIT_V(8); PG8_WAIT_L(0); PG8_BAR; PG8_MMA(1, 0, At, B0); PG8_MMA(1, 1, At, B1); PG8_BAR; PG8_SCHED;
            PG8_LDB(B0, 1, 0); PG8_LDB(B1, 1, 1); PG8_SCHED; PG8_LDA(At, 1, 0); PG8_STAGE2(PG8_SA(0, 1), a2, s10, s11);
            PG8_WAIT_V(8); PG8_WAIT_L(0); PG8_BAR; PG8_MMA(0, 0, At, B0); PG8_MMA(0, 1, At, B1); PG8_BAR; PG8_SCHED;
            PG8_LDA(At, 1, 1); PG8_STAGEB(PG8_SB(1, 0), b3); PG8_STAGEB(PG8_SB(1, 1), b3 + hstep); PG8_STAGE2(PG8_SA(1, 0), a3, s00, s01);
            PG8_WAIT_V(8); PG8_WAIT_L(0); PG8_BAR; PG8_MMA(1, 0, At, B0); PG8_MMA(1, 1, At, B1); PG8_BAR; PG8_SCHED;
            } else {
            PG8_LDB(B0, 0, 0); PG8_SCHED; PG8_LDA(At, 0, 0); PG8_STAGE2(PG8_SA(1, 1), a1, vA[1][0], vA[1][1]);
            PG8_WAIT_L(8); PG8_BAR; PG8_WAIT_L(0); PG8_MMA(0, 0, At, B0); PG8_BAR; PG8_SCHED;
            PG8_LDB(B1, 0, 1); PG8_STAGEB(PG8_SB(0, 0), b2);
            PG8_BAR; PG8_WAIT_L(0); PG8_MMA(0, 1, At, B1); PG8_BAR;
            PG8_LDA(At, 0, 1); PG8_STAGE2(PG8_SA(0, 0), a2, s00, s01);
            PG8_BAR; PG8_WAIT_L(0); PG8_MMA(1, 0, At, B0); PG8_BAR; PG8_SCHED;
            PG8_STAGEB(PG8_SB(0, 1), b2 + hstep);
            PG8_WAIT_V(6); PG8_BAR; PG8_MMA(1, 1, At, B1); PG8_BAR;
            PG8_LDB(B0, 1, 0); PG8_SCHED; PG8_LDA(At, 1, 0); PG8_STAGE2(PG8_SA(0, 1), a2, s10, s11);
            PG8_WAIT_L(8); PG8_BAR; PG8_WAIT_L(0); PG8_MMA(0, 0, At, B0); PG8_BAR; PG8_SCHED;
            PG8_LDB(B1, 1, 1); PG8_STAGEB(PG8_SB(1, 0), b3);
            PG8_BAR; PG8_WAIT_L(0); PG8_MMA(0, 1, At, B1); PG8_BAR;
            PG8_LDA(At, 1, 1); PG8_STAGE2(PG8_SA(1, 0), a3, s00, s01);
            PG8_BAR; PG8_WAIT_L(0); PG8_MMA(1, 0, At, B0); PG8_BAR; PG8_SCHED;
            PG8_STAGEB(PG8_SB(1, 1), b3 + hstep);
            PG8_WAIT_V(6); PG8_BAR; PG8_MMA(1, 1, At, B1); PG8_BAR;
            }
        }
        if constexpr (ALIGN_EPI) { if (wr == 0) PG8_BAR; }
        E(acc, cur, wr, wc, fr, fq);
        if (!has_next) break;
        asm volatile("v_mov_b32 %0, 0" : "=v"(zero_));
#pragma unroll
        for (int a = 0; a < 2; ++a)
#pragma unroll
            for (int b = 0; b < 2; ++b)
#pragma unroll
                for (int m = 0; m < 4; ++m)
#pragma unroll
                    for (int n = 0; n < 2; ++n) acc[a][b][m][n] = (f32x4){zero_, zero_, zero_, zero_};
        cur = nxt; cA = nA; cB = nB; ++ui;
#pragma unroll
        for (int h = 0; h < 2; ++h)
#pragma unroll
            for (int i = 0; i < 2; ++i) vA[h][i] = nvA[h][i];
        if constexpr (ALIGN_EPI) { if (wr == 1) PG8_BAR; }
    }
    PG8_WAIT_V(0);
    if constexpr (!ALIGN_EPI) { if (wr == 0) PG8_BAR; }
    PG8_BAR;
#undef PG8_SA
#undef PG8_SB
#undef PG8_STAGE2
#undef PG8_STAGEB
#undef PG8_LDA
#undef PG8_LDB
#undef PG8_MMA
#undef PG8_WAIT_V
#undef PG8_WAIT_L
#undef PG8_BAR
#undef PG8_SCHED
}

template <int K> struct DenseSched {
    const char* A; const char* Bt; int nM, nN, nwg, G, c;
    __device__ __forceinline__ void init(const void* A_, const void* Bt_, int M, int N, int G_, int c_) { A = (const char*)A_; Bt = (const char*)Bt_; nM = M / BM; nN = N / BM; nwg = nM * nN; G = G_; c = c_; }
    __device__ __forceinline__ bool next(int i, Unit& u) const {
        const long L = (long)i * G + c; if (L >= nwg) return false;
        const int wgid = xcd_remap((int)L, nwg);
        const int nig = WGM * nN, gid = wgid / nig, fm = gid * WGM, gsz = (nM - fm) < WGM ? (nM - fm) : WGM;
        u.pm = fm + ((wgid % nig) % gsz); u.pn = (wgid % nig) / gsz; u.e = 0; u.row0 = u.pm * BM; return true;
    }
    __device__ __forceinline__ const char* a_base(const Unit& u) const { return A + (size_t)u.pm * BM * K * 2; }
    __device__ __forceinline__ const char* b_base(const Unit& u) const { return Bt + (size_t)u.pn * BM * K * 2; }
    __device__ __forceinline__ void a_voff(const Unit&, int tid, unsigned (&v)[2][2]) const {
#pragma unroll
        for (int i = 0; i < 2; ++i) { int R, C; stage_rc(tid * 16 + i * 8192, R, C); v[0][i] = (unsigned)(R * K + C) * 2u; v[1][i] = (unsigned)((R + HALF) * K + C) * 2u; }
    }
};
template <int K, bool GATHER, bool SPREAD = false> struct MoeSched {
    const char* A; const char* Bt; const int* ltok; const LAS int* tstart; int ntiles, nN, nwg, G, c; size_t bstride_e; int bcol0;
    __device__ __forceinline__ bool next(int i, Unit& u) const {
        int wgid;
        if (SPREAD) {
            const int xcd = c & 7, off = i * (G >> 3) + (c >> 3); const int Ru = tstart[64] * nN, Su = nwg - Ru;
            const int r0 = (int)((long)xcd * Ru / 8), r1 = (int)((long)(xcd + 1) * Ru / 8), s0 = (int)((long)xcd * Su / 8), s1 = (int)((long)(xcd + 1) * Su / 8);
            if (off < r1 - r0) wgid = r0 + off; else if (off < (r1 - r0) + (s1 - s0)) wgid = Ru + s0 + off - (r1 - r0); else return false;
        } else {
            const long L = (long)i * G + c; if (L >= nwg) return false;
            wgid = xcd_remap((int)L, nwg);
        }
        const int rt = wgid / nN; u.pn = wgid % nN; u.pm = rt; u.row0 = rt * BM;
        int lo = 0, hi = NE1;
        while (hi - lo > 1) { const int mid = (lo + hi) >> 1; if (tstart[mid] <= rt) lo = mid; else hi = mid; }
        u.e = lo; return true;
    }
    __device__ __forceinline__ const char* a_base(const Unit& u) const { return GATHER ? A : A + (size_t)u.row0 * K * 2; }
    __device__ __forceinline__ const char* b_base(const Unit& u) const { return Bt + (size_t)u.e * bstride_e + (size_t)(bcol0 + u.pn * BM) * K * 2; }
    __device__ __forceinline__ void a_voff(const Unit& u, int tid, unsigned (&v)[2][2]) const {
#pragma unroll
        for (int i = 0; i < 2; ++i) { int R, C; stage_rc(tid * 16 + i * 8192, R, C);
            if (GATHER) { const int t0 = ltok[u.row0 + R], t1 = ltok[u.row0 + HALF + R]; v[0][i] = (unsigned)(t0 * K + C) * 2u; v[1][i] = (unsigned)(t1 * K + C) * 2u; }
            else { v[0][i] = (unsigned)(R * K + C) * 2u; v[1][i] = (unsigned)((R + HALF) * K + C) * 2u; } }
    }
};
}
using pg8::Unit;

struct EpiInProj {
    static constexpr bool PERM = true;
    unsigned char* ws; const f32x2* rope;
    __device__ __forceinline__ void operator()(const f32x4 (&acc)[2][2][4][2], const Unit& u, int wr, int wc, int fr, int fq) const {
        const int pn = u.pn; const int row0 = u.pm * 256 + wr * 64 + fr;
        bf16_t* dst; int ld, colt;
        if (pn < 2) { dst = (bf16_t*)(ws + WS_Q); ld = 512; colt = pn * 256; }
        else if (pn < 4) { dst = (bf16_t*)(ws + WS_K); ld = 512; colt = (pn - 2) * 256; }
        else if (pn < 6) { dst = (bf16_t*)(ws + WS_V); ld = 512; colt = (pn - 4) * 256; }
        else if (pn == 6) { dst = nullptr; ld = 0; colt = 0; }
        else if (pn < 10) { dst = (bf16_t*)(ws + WS_G); ld = 768; colt = (pn - 7) * 256; }
        else { dst = (bf16_t*)(ws + WS_Z); ld = 256; colt = 0; }
        const bool rope_on = (pn < 4) && (u.pm < TL / 256);
        const float qs = pn < 2 ? 0.125f * 1.4426950408889634f : 1.f;
        float* BA = (float*)(ws + WS_BA);
#pragma unroll
        for (int ai = 0; ai < 2; ++ai)
#pragma unroll
            for (int m = 0; m < 4; ++m) {
                const int r = row0 + ai * 128 + m * 16;
                if (pn == 6) {
                    int b_, cc_, k_; if (r < TL) { b_ = r >> 12; const int t = r & (SEQ - 1); cc_ = 8 + (t >> 5); k_ = t & 31; } else { const int t = (r - TL) & (NCTX - 1); b_ = (r - TL) >> 8; cc_ = t >> 5; k_ = t & 31; }
#pragma unroll
                    for (int bj = 0; bj < 2; ++bj) { const int ch = bj * 128 + wc * 32 + 8 * fq; const f32x4 v0 = acc[ai][bj][m][0], v1 = acc[ai][bj][m][1];
                        u32x4 w; w.x = pg8::cvt_pk_bf16(v0[0], v0[1]); w.y = pg8::cvt_pk_bf16(v0[2], v0[3]); w.z = pg8::cvt_pk_bf16(v1[0], v1[1]); w.w = pg8::cvt_pk_bf16(v1[2], v1[3]);
                        *(u32x4*)((bf16_t*)(ws + WS_S5A) + ((size_t)(ch >> 4) * S5R + b_ * 136 + cc_) * 768 + k_ * 16 + (ch & 15)) = w; }
                } else if (pn == 11) {
                    if (wc == 0 && fq < 2) { *(f32x4*)(BA + (size_t)r * 16 + 8 * fq) = acc[ai][0][m][0]; *(f32x4*)(BA + (size_t)r * 16 + 8 * fq + 4) = acc[ai][0][m][1]; }
                } else {
                    f32x4 cs0 = {1.f, 0.f, 1.f, 0.f}, cs1 = {1.f, 0.f, 1.f, 0.f};
                    if (rope_on) { const int t = r & (SEQ - 1); const int pos = (wc & 1) ? (t & 63) : (t >> 6); const f32x4* rp = (const f32x4*)(rope + pos * 16 + 4 * fq); cs0 = rp[0]; cs1 = rp[1]; }
#pragma unroll
                    for (int bj = 0; bj < 2; ++bj) {
                        f32x4 v0 = acc[ai][bj][m][0], v1 = acc[ai][bj][m][1];
                        if (rope_on) {
                            const f32x4 c = {cs0[0], cs0[2], cs1[0], cs1[2]}, s = {cs0[1], cs0[3], cs1[1], cs1[3]};
                            const f32x4 x1 = v0, x2 = v1; v0 = x1 * c - x2 * s; v1 = x1 * s + x2 * c;
                        }
                        v0 = v0 * qs; v1 = v1 * qs;
                        u32x4 w; w.x = pg8::cvt_pk_bf16(v0[0], v0[1]); w.y = pg8::cvt_pk_bf16(v0[2], v0[3]); w.z = pg8::cvt_pk_bf16(v1[0], v1[1]); w.w = pg8::cvt_pk_bf16(v1[2], v1[3]);
                        *(u32x4*)(dst + (size_t)r * ld + colt + bj * 128 + wc * 32 + 8 * fq) = w;
                    }
                }
            }
    }
};
struct EpiResid {
    static constexpr bool PERM = true;
    const float* xin_lat; const float* xin_ctx; float* xo_lat; float* xo_ctx; const float* mod; int gidx; bool in_bf;
    __device__ __forceinline__ void operator()(const f32x4 (&acc)[2][2][4][2], const Unit& u, int wr, int wc, int fr, int fq) const {
        const bool lat = u.pm < TL / 256;
        const int j = lat ? (u.pm >> 4) : 8  ;
        const int col = u.pn * 256 + wc * 32 + 8 * fq;
        const float* gv = mod + j * 6144 + gidx * 1024 + col;
        const float* src = (lat ? xin_lat + (size_t)u.pm * 256 * DM : xin_ctx + (size_t)(u.pm - TL / 256) * 256 * DM) + (size_t)(wr * 64 + fr) * DM;
        float* dst = (lat ? xo_lat + (size_t)u.pm * 256 * DM : xo_ctx + (size_t)(u.pm - TL / 256) * 256 * DM) + (size_t)(wr * 64 + fr) * DM;
        f32x4 g[2][2];
#pragma unroll
        for (int bj = 0; bj < 2; ++bj)
#pragma unroll
            for (int n = 0; n < 2; ++n) g[bj][n] = *(const f32x4*)(gv + bj * 128 + n * 4);
#pragma unroll
        for (int ai = 0; ai < 2; ++ai)
#pragma unroll
            for (int mh = 0; mh < 2; ++mh) {
                f32x4 x[2][2][2];
#pragma unroll
                for (int m2 = 0; m2 < 2; ++m2)
#pragma unroll
                    for (int bj = 0; bj < 2; ++bj) { const float* rp = src + (size_t)(ai * 128 + (2 * mh + m2) * 16) * DM; const int cc = col + bj * 128;
                        if (in_bf) { const u32x4 t = *(const u32x4*)((const bf16_t*)rp + cc); x[m2][bj][0] = bf4_to_f32(t.x, t.y); x[m2][bj][1] = bf4_to_f32(t.z, t.w); }
                        else { x[m2][bj][0] = __builtin_nontemporal_load((const f32x4*)(rp + cc)); x[m2][bj][1] = __builtin_nontemporal_load((const f32x4*)(rp + cc + 4)); } }
#pragma unroll
                for (int m2 = 0; m2 < 2; ++m2)
#pragma unroll
                    for (int bj = 0; bj < 2; ++bj) { const f32x4 y0 = x[m2][bj][0] + g[bj][0] * acc[ai][bj][2 * mh + m2][0], y1 = x[m2][bj][1] + g[bj][1] * acc[ai][bj][2 * mh + m2][1];
                        u32x4 o; o.x = pk2(y0[0], y0[1]); o.y = pk2(y0[2], y0[3]); o.z = pk2(y1[0], y1[1]); o.w = pk2(y1[2], y1[3]);
                        *(u32x4*)((bf16_t*)(dst + (size_t)(ai * 128 + (2 * mh + m2) * 16) * DM) + col + bj * 128) = o; }
            }
    }
};
struct EpiMoeUp {
    static constexpr bool PERM = true;
    bf16_t* hid; const float* lgate;
    __device__ __forceinline__ void operator()(const f32x4 (&acc)[2][2][4][2], const Unit& u, int wr, int wc, int fr, int fq) const {
        float gt[2][4];
#pragma unroll
        for (int ai = 0; ai < 2; ++ai)
#pragma unroll
            for (int m = 0; m < 4; ++m) gt[ai][m] = lgate[u.row0 + wr * 64 + fr + ai * 128 + m * 16];
#pragma unroll
        for (int ai = 0; ai < 2; ++ai)
#pragma unroll
            for (int m = 0; m < 4; ++m) {
                const int r = u.row0 + wr * 64 + fr + ai * 128 + m * 16;
                const f32x4 a0 = acc[ai][0][m][0], a1 = acc[ai][0][m][1]; f32x4 e0 = a0 * -1.4426950408889634f, e1 = a1 * -1.4426950408889634f;
#pragma unroll
                for (int j = 0; j < 4; ++j) { e0[j] = __builtin_amdgcn_exp2f(e0[j]); e1[j] = __builtin_amdgcn_exp2f(e1[j]); }
                e0 = e0 + 1.f; e1 = e1 + 1.f;
#pragma unroll
                for (int j = 0; j < 4; ++j) { e0[j] = __builtin_amdgcn_rcpf(e0[j]); e1[j] = __builtin_amdgcn_rcpf(e1[j]); }
                const f32x4 h0 = (a0 * e0) * (acc[ai][1][m][0] * gt[ai][m]), h1 = (a1 * e1) * (acc[ai][1][m][1] * gt[ai][m]);
                u32x4 w; w.x = pg8::cvt_pk_bf16(h0[0], h0[1]); w.y = pg8::cvt_pk_bf16(h0[2], h0[3]); w.z = pg8::cvt_pk_bf16(h1[0], h1[1]); w.w = pg8::cvt_pk_bf16(h1[2], h1[3]);
                *(u32x4*)(hid + (size_t)r * 256 + u.pn * 128 + wc * 32 + 8 * fq) = w;
            }
    }
};
constexpr float PAIR_SCALE = 8.f;
struct EpiMoeDown {
    static constexpr bool PERM = true;
    unsigned char* ws;
    __device__ __forceinline__ void operator()(const f32x4 (&acc)[2][2][4][2], const Unit& u, int wr, int wc, int fr, int fq) const {
        unsigned char* base = u.row0 < PAIR_RA ? ws + WS_PAIRA + (size_t)u.row0 * 1024 : ws + WS_PAIRB + (size_t)(u.row0 - PAIR_RA) * 1024;
        const int odd = fq & 1;
#pragma unroll
        for (int ai = 0; ai < 2; ++ai)
#pragma unroll
            for (int mp = 0; mp < 2; ++mp) {
                const int r = wr * 64 + fr + ai * 128 + (2 * mp + odd) * 16;
#pragma unroll
                for (int bj = 0; bj < 2; ++bj) {
                    unsigned x[2], y[2];
#pragma unroll
                    for (int h = 0; h < 2; ++h) { const f32x4 va = acc[ai][bj][2 * mp][h] * PAIR_SCALE, vb = acc[ai][bj][2 * mp + 1][h] * PAIR_SCALE;
                        int wa = __builtin_amdgcn_cvt_pk_fp8_f32(va[0], va[1], 0, false); wa = __builtin_amdgcn_cvt_pk_fp8_f32(va[2], va[3], wa, true);
                        int wb = __builtin_amdgcn_cvt_pk_fp8_f32(vb[0], vb[1], 0, false); wb = __builtin_amdgcn_cvt_pk_fp8_f32(vb[2], vb[3], wb, true);
                        x[h] = (unsigned)wa; y[h] = (unsigned)wb; }
                    auto s0 = __builtin_amdgcn_permlane16_swap(x[0], y[0], false, false); auto s1 = __builtin_amdgcn_permlane16_swap(x[1], y[1], false, false);
                    const u32x4 w = {s0[0], s1[0], s0[1], s1[1]};
                    *(u32x4*)(base + (size_t)r * 1024 + u.pn * 256 + bj * 128 + wc * 32 + 8 * (fq & ~1)) = w;
                }
            }
    }
};

template <int K> struct GroupSched {
    const char* A; size_t a_gs; int lda; const char* Bt; size_t b_gs; int nM, nN, nwg, G, c;
    __device__ __forceinline__ bool next(int i, Unit& u) const {
        const long L = (long)i * G + c; if (L >= nwg) return false;
        const int wgid = pg8::xcd_remap((int)L, nwg); const int per = nM * nN, g = wgid / per, rem = wgid % per;
        u.e = g; u.pn = rem % nN; u.pm = rem / nN; u.row0 = u.pm * 256; return true;
    }
    __device__ __forceinline__ const char* a_base(const Unit& u) const { return A + (size_t)u.e * a_gs + (size_t)u.pm * 256 * lda * 2; }
    __device__ __forceinline__ const char* b_base(const Unit& u) const { return Bt + (size_t)u.e * b_gs + (size_t)u.pn * 256 * K * 2; }
    __device__ __forceinline__ void a_voff(const Unit&, int tid, unsigned (&v)[2][2]) const {
#pragma unroll
        for (int i = 0; i < 2; ++i) { int R, C; pg8::stage_rc(tid * 16 + i * 8192, R, C); v[0][i] = (unsigned)(R * lda + C) * 2u; v[1][i] = (unsigned)((R + 128) * lda + C) * 2u; }
    }
};
struct EpiLogits {
    static constexpr bool PERM = false;
    float* LOG;
    __device__ __forceinline__ void operator()(const f32x4 (&acc)[2][2][4][2], const Unit& u, int wr, int wc, int fr, int fq) const {
#pragma unroll
        for (int ai = 0; ai < 2; ++ai)
#pragma unroll
            for (int m = 0; m < 4; ++m) { const int r = u.row0 + wr * 64 + fr + ai * 128 + m * 16; float* rowp = LOG + ((size_t)u.e * MT + r) * 128;
#pragma unroll
                for (int n = 0; n < 2; ++n) *(f32x4*)(rowp + wc * 32 + n * 16 + 4 * fq) = acc[ai][0][m][n]; }
    }
};
struct EpiS5L {
    static constexpr bool PERM = false;
    float* L;
    __device__ __forceinline__ void operator()(const f32x4 (&acc)[2][2][4][2], const Unit& u, int wr, int wc, int fr, int fq) const {
#pragma unroll
        for (int ai = 0; ai < 2; ++ai)
#pragma unroll
            for (int m = 0; m < 4; ++m) { const int r = u.row0 + wr * 64 + fr + ai * 128 + m * 16; float* rowp = L + ((size_t)u.e * S5R + r) * 256;
#pragma unroll
                for (int bj = 0; bj < 2; ++bj)
#pragma unroll
                    for (int n = 0; n < 2; ++n) *(f32x4*)(rowp + bj * 128 + wc * 32 + n * 16 + 4 * fq) = acc[ai][bj][m][n]; }
    }
};
__device__ __forceinline__ float gelu_tanh(float x) { const float t = 0.7978845608028654f * (x + 0.044715f * x * x * x); const float th = 1.f - 2.f * __builtin_amdgcn_rcpf(1.f + __expf(2.f * t)); return 0.5f * x * (1.f + th); }
struct EpiS5Y {
    static constexpr bool PERM = true;
    bf16_t* Zs;
    __device__ __forceinline__ void operator()(const f32x4 (&acc)[2][2][4][2], const Unit& u, int wr, int wc, int fr, int fq) const {
#pragma unroll
        for (int ai = 0; ai < 2; ++ai)
#pragma unroll
            for (int m = 0; m < 4; ++m) { const int r = u.row0 + wr * 64 + fr + ai * 128 + m * 16;
                if (r < S5RV) { const int b_ = r / 136, cc_ = r % 136; const int tok0 = cc_ < 8 ? TL + b_ * NCTX + cc_ * 32 : b_ * SEQ + (cc_ - 8) * 32;
#pragma unroll
                    for (int bj = 0; bj < 2; ++bj) { const int n = u.pn * 256 + bj * 128 + wc * 32 + 8 * fq; const f32x4 v0 = acc[ai][bj][m][0], v1 = acc[ai][bj][m][1];
                        u32x4 w; w.x = pg8::cvt_pk_bf16(gelu_tanh(v0[0]), gelu_tanh(v0[1])); w.y = pg8::cvt_pk_bf16(gelu_tanh(v0[2]), gelu_tanh(v0[3]));
                        w.z = pg8::cvt_pk_bf16(gelu_tanh(v1[0]), gelu_tanh(v1[1])); w.w = pg8::cvt_pk_bf16(gelu_tanh(v1[2]), gelu_tanh(v1[3]));
                        *(u32x4*)(Zs + (size_t)(tok0 + (n >> 4)) * 256 + u.e * 16 + (n & 15)) = w; } } }
    }
};
struct EpiGlu {
    static constexpr bool PERM = true;
    const bf16_t* Zs; bf16_t* hb; const float* bg;
    __device__ __forceinline__ void operator()(const f32x4 (&acc)[2][2][4][2], const Unit& u, int wr, int wc, int fr, int fq) const {
        f32x4 b0[2], b1[2];
#pragma unroll
        for (int bj = 0; bj < 2; ++bj) { const int col = bj * 128 + wc * 32 + 8 * fq; b0[bj] = *(const f32x4*)(bg + col); b1[bj] = *(const f32x4*)(bg + col + 4); }
#pragma unroll
        for (int ai = 0; ai < 2; ++ai) {
            u32x4 zz[4][2];
#pragma unroll
            for (int m = 0; m < 4; ++m)
#pragma unroll
                for (int bj = 0; bj < 2; ++bj) zz[m][bj] = *(const u32x4*)(Zs + (size_t)(u.row0 + wr * 64 + fr + ai * 128 + m * 16) * 256 + bj * 128 + wc * 32 + 8 * fq);
#pragma unroll
            for (int m = 0; m < 4; ++m) { const int r = u.row0 + wr * 64 + fr + ai * 128 + m * 16;
#pragma unroll
                for (int bj = 0; bj < 2; ++bj) { const int col = bj * 128 + wc * 32 + 8 * fq; const u32x4 z4 = zz[m][bj];
                    const f32x4 v0 = acc[ai][bj][m][0] + b0[bj], v1 = acc[ai][bj][m][1] + b1[bj];
                    float z[8]; z[0] = __builtin_bit_cast(float, z4.x << 16); z[1] = __builtin_bit_cast(float, z4.x & 0xffff0000u); z[2] = __builtin_bit_cast(float, z4.y << 16); z[3] = __builtin_bit_cast(float, z4.y & 0xffff0000u);
                    z[4] = __builtin_bit_cast(float, z4.z << 16); z[5] = __builtin_bit_cast(float, z4.z & 0xffff0000u); z[6] = __builtin_bit_cast(float, z4.w << 16); z[7] = __builtin_bit_cast(float, z4.w & 0xffff0000u);
                    u32x4 w; w.x = pg8::cvt_pk_bf16(z[0] * sigmf(v0[0]), z[1] * sigmf(v0[1])); w.y = pg8::cvt_pk_bf16(z[2] * sigmf(v0[2]), z[3] * sigmf(v0[3]));
                    w.z = pg8::cvt_pk_bf16(z[4] * sigmf(v1[0]), z[5] * sigmf(v1[1])); w.w = pg8::cvt_pk_bf16(z[6] * sigmf(v1[2]), z[7] * sigmf(v1[3]));
                    *(u32x4*)(hb + (size_t)r * DM + 512 + col) = w; } } }
    }
};


struct Ctx {
    const LAS unsigned* pl;
    LAS unsigned char* lds; int tid, lane, wave, G, bid, gw, NGW;
    __device__ __forceinline__ const float* ptr(int i) const { unsigned a_ = (unsigned)(size_t)pl; asm volatile("" : "+v"(a_));
        const LAS unsigned* q = (const LAS unsigned*)(size_t)a_; const unsigned lo = __builtin_amdgcn_readfirstlane(q[2 * i]), hi = __builtin_amdgcn_readfirstlane(q[2 * i + 1]); return (const float*)(const __attribute__((address_space(1))) float*)(((unsigned long long)hi << 32) | lo); }
    __device__ __forceinline__ const float* in(int i) const { return ptr(i); }
    __device__ __forceinline__ float* out() const { return (float*)ptr(35); }
    __device__ __forceinline__ unsigned char* ws() const { return (unsigned char*)ptr(36); }
    template <class T> __device__ __forceinline__ T* wsp(size_t off) const { return (T*)(ws() + off); }
};

__device__ __forceinline__ void ph_pre(const Ctx& c) {
    LAS float* act = (LAS float*)c.lds;
    const float* cv = c.in(I_C); const float* cc = c.in(I_CCTX);
    for (int i = c.tid; i < 9216; i += 512) { const int j = i >> 10, k = i & 1023; const float v = j < 8 ? cv[j * 1024 + k] : cc[k]; act[i] = siluf(v); }
    __syncthreads();
    float* mods = c.wsp<float>(WS_MODS);
    LAS float* red = act + 9216;
    for (int item = c.bid; item < 192; item += c.G) {
        const int l = item / 96, n0 = (item % 96) * 64, cg = c.tid & 15, ks = c.tid >> 4;
        f32x4 a[9];
#pragma unroll
        for (int j = 0; j < 9; ++j) a[j] = (f32x4){0.f, 0.f, 0.f, 0.f};
        const float* w = c.in(I_WMOD) + ((size_t)l * 1024 + ks * 32) * 6144 + n0 + 4 * cg;
#pragma unroll 8
        for (int k = 0; k < 32; ++k) { const f32x4 wv = *(const f32x4*)(w + (size_t)k * 6144);
#pragma unroll
            for (int j = 0; j < 9; ++j) a[j] += wv * act[j * 1024 + ks * 32 + k]; }
#pragma unroll
        for (int j = 0; j < 9; ++j) *(LAS f32x4*)(red + (ks * 9 + j) * 64 + 4 * cg) = a[j];
        __syncthreads();
        for (int o = c.tid; o < 576; o += 512) { const int j = o >> 6, n = o & 63; float sacc = 0.f;
#pragma unroll 8
            for (int q = 0; q < 32; ++q) sacc += red[(q * 9 + j) * 64 + n];
            mods[((size_t)l * 9 + j) * 6144 + n0 + n] = sacc + c.in(I_BMOD)[l * 6144 + n0 + n]; }
        __syncthreads();
    }
    if (c.bid == c.G - 1) {
        f32x2* rope = c.wsp<f32x2>(WS_ROPE);
        for (int i = c.tid; i < 1024; i += 512) { const int pos = i >> 4, f = i & 15; const float inv = exp2f(-(float)f * (13.287712379549449f / 16.f)); const float a = (float)pos * inv;
            rope[i] = (f32x2){__cosf(a), __sinf(a)}; }
    }
}

__device__ __forceinline__ void tr_item64(const float* W, int ldw, int ncols, int k0, int n0, bf16_t* WT, int Kdim, int drow0, bool perm, LAS float* scr, int lane) {
    const int lc = 4 * (lane & 15), lr = lane >> 4;
    f32x4 v[16];
#pragma unroll
    for (int i = 0; i < 16; ++i) { const int kk = 4 * i + lr; const int col = n0 + lc;
        v[i] = (col + 3 < ncols) ? *(const f32x4*)(W + (size_t)(k0 + kk) * ldw + col) : (f32x4){col < ncols ? W[(size_t)(k0 + kk) * ldw + col] : 0.f, col + 1 < ncols ? W[(size_t)(k0 + kk) * ldw + col + 1] : 0.f, col + 2 < ncols ? W[(size_t)(k0 + kk) * ldw + col + 2] : 0.f, 0.f}; }
#pragma unroll
    for (int i = 0; i < 16; ++i) { const int kk = 4 * i + lr; LAS float* d = scr + kk * 65 + lc; d[0] = v[i][0]; d[1] = v[i][1]; d[2] = v[i][2]; d[3] = v[i][3]; }
    LDS_WAIT(); asm volatile("" ::: "memory");
    const int cch = lane & 7;
#pragma unroll
    for (int j = 0; j < 8; ++j) { const int n = (lane >> 3) + 8 * j; const int sn = perm ? (n & ~31) + dimperm(n & 31) : n; const LAS float* s = scr + (8 * cch) * 65 + sn;
        u32x4 o; o.x = pk2(s[0 * 65], s[1 * 65]); o.y = pk2(s[2 * 65], s[3 * 65]); o.z = pk2(s[4 * 65], s[5 * 65]); o.w = pk2(s[6 * 65], s[7 * 65]);
        *(u32x4*)(WT + (size_t)(drow0 + n) * Kdim + k0 + 8 * cch) = o; }
    LDS_WAIT(); asm volatile("" ::: "memory");
}
__device__ __forceinline__ void wprep13_item(const Ctx& c, int l, int e, int q, LAS float* scr) {
    const bool is3 = q >= 64; q &= 63; const int kb = q / 4, nb = q % 4, n0 = nb * 64;
    const float* src = e < 64 ? c.in(is3 ? I_W3 : I_W1) + ((size_t)l * 64 + e) * 1024 * 256 : c.in(is3 ? I_WS3 : I_WS1) + (size_t)l * 1024 * 256;
    tr_item64(src, 256, 256, kb * 64, n0, c.wsp<bf16_t>(WS_W13) + (size_t)e * 512 * 1024, 1024, (n0 >> 7) * 256 + (n0 & 127) + (is3 ? 128 : 0), false, scr, c.lane);
}
__device__ __forceinline__ void ph_wprep13_dyn(const Ctx& c, int l, int qsel) {
    LAS float* scr = (LAS float*)(c.lds + c.wave * 16640);
    unsigned* qctr = c.wsp<unsigned>(WS_CTL) + CW_ATTQ + l * 64 + qsel * 32 + 16;
    LAS int* qslot = (LAS int*)(c.lds + 8 * 16640);
    constexpr int NIT = NE1 * 128;
#pragma unroll 1
    for (;;) {
        if (c.tid == 0) qslot[0] = (int)atomicAdd(qctr, 8u);
        __syncthreads();
        const int base = __builtin_amdgcn_readfirstlane(qslot[0]);
        __syncthreads();
        if (base >= NIT) break;
        const int it = base + c.wave;
        if (it < NIT) wprep13_item(c, l, it >> 7, it & 127, scr);
    }
}
__device__ __forceinline__ void ph_wprep2_dyn(const Ctx& c, int l, int qsel) {
    LAS float* scr = (LAS float*)(c.lds + c.wave * 16640);
    unsigned* qctr = c.wsp<unsigned>(WS_CTL) + CW_ATTQ + l * 64 + qsel * 32 + 17;
    LAS int* qslot = (LAS int*)(c.lds + 8 * 16640);
    constexpr int NIT = NE1 * 64;
    __syncthreads();
#pragma unroll 1
    for (;;) {
        if (c.tid == 0) qslot[0] = (int)atomicAdd(qctr, 8u);
        __syncthreads();
        const int base = __builtin_amdgcn_readfirstlane(qslot[0]);
        __syncthreads();
        if (base >= NIT) break;
        const int it = base + c.wave;
        if (it < NIT) { const int e = it >> 6, q = it & 63, kb = q / 16, nb = q % 16;
            const float* src = e < 64 ? c.in(I_W2) + ((size_t)l * 64 + e) * 256 * 1024 : c.in(I_WS2) + (size_t)l * 256 * 1024;
            tr_item64(src, 1024, 1024, kb * 64, nb * 64, c.wsp<bf16_t>(WS_W2) + (size_t)e * 1024 * 256, 256, nb * 64, false, scr, c.lane); }
    }
}
template <int PART> __device__ __forceinline__ void ph_wprep(const Ctx& c, int l) {
    LAS float* scr = (LAS float*)(c.lds + c.wave * 16640);
    constexpr int I_IN = 16 * 48, I_OUT = 16 * 16, I_EXP = 192;
    constexpr int NITEMS = PART == 0 ? I_IN + I_OUT : (PART == 1 ? NE1 * I_EXP : NE1 * 64);
    for (int it = c.gw; it < NITEMS; it += c.NGW) {
        int r = PART == 0 ? it : (PART == 1 ? it + I_IN + I_OUT : (it >> 6) * I_EXP + 128 + (it & 63) + I_IN + I_OUT);
        if (r < I_IN) { const int kb = r / 48, nb = r % 48; tr_item64(c.in(I_WIN) + (size_t)l * 1024 * NIN, NIN, NIN, kb * 64, nb * 64, c.wsp<bf16_t>(WS_WIN), 1024, nb * 64, nb * 64 < 1024, scr, c.lane); continue; }
        r -= I_IN;
        if (r < I_OUT) { const int kb = r / 16, nb = r % 16; tr_item64(c.in(I_WOUT) + (size_t)l * 1024 * 1024, 1024, 1024, kb * 64, nb * 64, c.wsp<bf16_t>(WS_WOUT), 1024, nb * 64, false, scr, c.lane); continue; }
        r -= I_OUT;
        const int e = r / I_EXP; int q = r % I_EXP;
        if (q < 128) wprep13_item(c, l, e, q, scr);
        else {
            q -= 128; const int kb = q / 16, nb = q % 16;
            const float* src = e < 64 ? c.in(I_W2) + ((size_t)l * 64 + e) * 256 * 1024 : c.in(I_WS2) + (size_t)l * 256 * 1024;
            tr_item64(src, 1024, 1024, kb * 64, nb * 64, c.wsp<bf16_t>(WS_W2) + (size_t)e * 1024 * 256, 256, nb * 64, false, scr, c.lane);
        }
    }
}

__device__ __forceinline__ void norm_row_load(const float* xrow, f32x4 (&v)[4], int lane, bool bf);
template <bool LOPART> __device__ __forceinline__ void norm_row_finish(const f32x4 (&v)[4], const float* nw, const float* sc, const float* sh, bf16_t* orow, bf16_t* lorow, int lane);
template <bool LOPART> __device__ __forceinline__ void norm_mod_row(const float* xrow, const float* nw, const float* sc, const float* sh, bf16_t* orow, bf16_t* lorow, int lane, bool bf) {
    f32x4 v[4];
    norm_row_load(xrow, v, lane, bf);
    norm_row_finish<LOPART>(v, nw, sc, sh, orow, lorow, lane);
}
__device__ __forceinline__ void norm_row_load(const float* xrow, f32x4 (&v)[4], int lane, bool bf) {
    if (bf) { const u32x4 a = *(const u32x4*)((const bf16_t*)xrow + 8 * lane), b = *(const u32x4*)((const bf16_t*)xrow + 512 + 8 * lane);
        v[0] = bf4_to_f32(a.x, a.y); v[1] = bf4_to_f32(a.z, a.w); v[2] = bf4_to_f32(b.x, b.y); v[3] = bf4_to_f32(b.z, b.w); }
    else {
#pragma unroll
        for (int j = 0; j < 4; ++j) v[j] = *(const f32x4*)(xrow + 8 * lane + 512 * (j >> 1) + 4 * (j & 1)); }
}
template <bool LOPART> __device__ __forceinline__ void norm_row_finish(const f32x4 (&v)[4], const float* nw, const float* sc, const float* sh, bf16_t* orow, bf16_t* lorow, int lane) {
    float ss = 0.f;
#pragma unroll
    for (int j = 0; j < 4; ++j) ss += (v[j][0] * v[j][0] + v[j][1] * v[j][1]) + (v[j][2] * v[j][2] + v[j][3] * v[j][3]);
    ss = wave_sum(ss);
    const float rstd = rsqrtf(ss * (1.f / DM) + EPS);
#pragma unroll
    for (int jj = 0; jj < 2; ++jj) { u32x4 o, lo;
#pragma unroll
        for (int q = 0; q < 2; ++q) { const int col = 8 * lane + 512 * jj + 4 * q;
            const f32x4 w = *(const f32x4*)(nw + col), a = *(const f32x4*)(sc + col), s = *(const f32x4*)(sh + col);
            const f32x4 y = (v[2 * jj + q] * rstd) * w * (a + 1.f) + s;
            const unsigned ox = pk2(y[0], y[1]), oy = pk2(y[2], y[3]);
            if (q == 0) { o.x = ox; o.y = oy; } else { o.z = ox; o.w = oy; }
            if (LOPART) { const float r0 = y[0] - __builtin_bit_cast(float, ox << 16), r1 = y[1] - __builtin_bit_cast(float, ox & 0xffff0000u), r2 = y[2] - __builtin_bit_cast(float, oy << 16), r3 = y[3] - __builtin_bit_cast(float, oy & 0xffff0000u);
                const unsigned lx = pk2(r0, r1), ly = pk2(r2, r3); if (q == 0) { lo.x = lx; lo.y = ly; } else { lo.z = lx; lo.w = ly; } } }
        *(u32x4*)(orow + 8 * lane + 512 * jj) = o;
        if (LOPART) *(u32x4*)(lorow + 8 * lane + 512 * jj) = lo; }
}
__device__ __forceinline__ const float* xrow_ptr(const Ctx& c, int l, int m) {
    if (m < TL) return (l == 0 ? c.in(I_X) : c.out()) + (size_t)m * DM;
    return ((l == 0 || ABL_CTXORIG) ? c.in(I_CTX) : c.wsp<float>(WS_XC)) + (size_t)(m - TL) * DM;
}
__device__ __forceinline__ void ph_norm1(const Ctx& c, int l) {
    const float* mods = c.wsp<float>(WS_MODS) + (size_t)l * 9 * 6144;
    bf16_t* hb = c.wsp<bf16_t>(WS_HB);
    for (int m = c.gw; m < MT; m += c.NGW) {
        const int j = m < TL ? m / SEQ : 8;
        norm_mod_row<false>(xrow_ptr(c, l, m), c.in(I_N1W) + l * DM, mods + j * 6144 + 1 * 1024, mods + j * 6144 + 0 * 1024, hb + (size_t)m * DM, nullptr, c.lane, l != 0);
    }
}


namespace fa {
using f32x16 = __attribute__((ext_vector_type(16))) float;
using s16x4 = __attribute__((ext_vector_type(4))) short;
constexpr int SHM_V = 64 * 128 * 2, SHM_K = 64 * 128 * 2;
constexpr float THR = 8.f, C = 1.4426950408889634f;
#define FA_KSWZ(row, colB) ((row) * 256 + ((colB) ^ (((row) & 15) << 4)))
#define FA_SBAR() __builtin_amdgcn_sched_barrier(0)
__device__ __forceinline__ int crow(int r, int hi) { return (r & 3) + 8 * (r >> 2) + 4 * hi; }
__device__ __forceinline__ unsigned cvtpk(float lo, float hi) { unsigned r; asm volatile("v_cvt_pk_bf16_f32 %0, %1, %2" : "=v"(r) : "v"(lo), "v"(hi)); return r; }
template <int BASE> __device__ __forceinline__ bf16x8 pk8(const f32x16& P) {
    u32x4 w = {cvtpk(P[BASE + 0], P[BASE + 1]), cvtpk(P[BASE + 2], P[BASE + 3]), cvtpk(P[BASE + 4], P[BASE + 5]), cvtpk(P[BASE + 6], P[BASE + 7])};
    return *reinterpret_cast<bf16x8*>(&w);
}
__device__ __forceinline__ void partialSM(f32x16& p0, f32x16& p1, float& m_reg, float& mn, float& alpha) {
    float pmax = p0[0];
#pragma unroll
    for (int r = 1; r < 16; ++r) pmax = fmaxf(pmax, p0[r]);
#pragma unroll
    for (int r = 0; r < 16; ++r) pmax = fmaxf(pmax, p1[r]);
    { auto rr = __builtin_amdgcn_permlane32_swap(__float_as_uint(pmax), __float_as_uint(pmax), false, false); pmax = fmaxf(__uint_as_float(rr[0]), __uint_as_float(rr[1])); }
    if (__builtin_expect(__all(pmax - m_reg <= THR), 1)) { mn = m_reg; alpha = 1.f; }
    else { mn = fmaxf(m_reg, pmax); alpha = __builtin_amdgcn_exp2f((m_reg - mn) * C); m_reg = mn; }
    const float mnC = -mn * C;
#pragma unroll
    for (int r = 0; r < 16; ++r) p0[r] = fmaf(p0[r], C, mnC);
#pragma unroll
    for (int r = 0; r < 16; ++r) p1[r] = fmaf(p1[r], C, mnC);
#pragma unroll
    for (int r = 0; r < 16; ++r) p0[r] = __builtin_amdgcn_exp2f(p0[r]);
}
__device__ __forceinline__ void finishSM(f32x16& p0, f32x16& p1, float alpha, float& l_reg, bf16x8& pa0, bf16x8& pa1, bf16x8& pa2, bf16x8& pa3) {
#pragma unroll
    for (int r = 0; r < 16; ++r) p1[r] = __builtin_amdgcn_exp2f(p1[r]);
#if ATT_X == 1
#pragma unroll
    for (int r = 0; r < 16; ++r) { float t_; asm volatile("v_exp_f32 %0, %1" : "=v"(t_) : "v"(p1[r])); asm volatile("v_exp_f32 %0, %1" : "=v"(t_) : "v"(p0[r])); }
#endif
    float ps = 0;
#pragma unroll
    for (int r = 0; r < 16; ++r) ps += p0[r];
#pragma unroll
    for (int r = 0; r < 16; ++r) ps += p1[r];
    { auto rr = __builtin_amdgcn_permlane32_swap(__float_as_uint(ps), __float_as_uint(ps), false, false); ps = __uint_as_float(rr[0]) + __uint_as_float(rr[1]); }
    l_reg = l_reg * alpha + ps;
#define FA_PK4(P, BASE, OUT) do { unsigned a0 = cvtpk(P[BASE + 0], P[BASE + 1]), a1 = cvtpk(P[BASE + 2], P[BASE + 3]);   \
    unsigned b0 = cvtpk(P[BASE + 4], P[BASE + 5]), b1 = cvtpk(P[BASE + 6], P[BASE + 7]);                              \
    auto r0 = __builtin_amdgcn_permlane32_swap(a0, b0, false, false); auto r1 = __builtin_amdgcn_permlane32_swap(a1, b1, false, false); \
    u32x4 w = {r0[0], r1[0], r0[1], r1[1]}; OUT = *reinterpret_cast<bf16x8*>(&w); } while (0)
    FA_PK4(p0, 0, pa0); FA_PK4(p0, 8, pa1); FA_PK4(p1, 0, pa2); FA_PK4(p1, 8, pa3);
#undef FA_PK4
}
__device__ __forceinline__ void qkt(f32x16& p0, f32x16& p1, const LAS char* Ks, const bf16x8 (&qr)[4], int r32, int hi, int mcol) {
    p0 = ozero16(); p1 = p0;
#pragma unroll
    for (int d0 = 0; d0 < 4; ++d0) { const int cb = (mcol + d0 * 16 + hi * 8) * 2;
        const bf16x8 b0 = *reinterpret_cast<const LAS bf16x8*>(Ks + FA_KSWZ(r32, cb));
        const bf16x8 b1 = *reinterpret_cast<const LAS bf16x8*>(Ks + FA_KSWZ(32 + r32, cb));
        p0 = __builtin_amdgcn_mfma_f32_32x32x16_bf16(b0, qr[d0], p0, 0, 0, 0);
        p1 = __builtin_amdgcn_mfma_f32_32x32x16_bf16(b1, qr[d0], p1, 0, 0, 0); }
}
__device__ __forceinline__ void qkt_load(bf16x8 (&kf)[8], const LAS char* Ks, int r32, int hi, int mcol) {
#pragma unroll
    for (int d0 = 0; d0 < 4; ++d0) { const int cb = (mcol + d0 * 16 + hi * 8) * 2;
        kf[2 * d0] = *reinterpret_cast<const LAS bf16x8*>(Ks + FA_KSWZ(r32, cb));
        kf[2 * d0 + 1] = *reinterpret_cast<const LAS bf16x8*>(Ks + FA_KSWZ(32 + r32, cb)); }
}
__device__ __forceinline__ void qkt_mma(f32x16& p0, f32x16& p1, const bf16x8 (&kf)[8], const bf16x8 (&qr)[4], const f32x16& z) {
    p0 = __builtin_amdgcn_mfma_f32_32x32x16_bf16(kf[0], qr[0], z, 0, 0, 0);
    p1 = __builtin_amdgcn_mfma_f32_32x32x16_bf16(kf[1], qr[0], z, 0, 0, 0);
#pragma unroll
    for (int d0 = 1; d0 < 4; ++d0) {
        p0 = __builtin_amdgcn_mfma_f32_32x32x16_bf16(kf[2 * d0], qr[d0], p0, 0, 0, 0);
        p1 = __builtin_amdgcn_mfma_f32_32x32x16_bf16(kf[2 * d0 + 1], qr[d0], p1, 0, 0, 0); }
#if ATT_X == 2
    { f32x16 d_;
#pragma unroll
      for (int i = 0; i < 8; ++i) asm volatile("v_mfma_f32_32x32x16_bf16 %0, %1, %2, 0" : "=v"(d_) : "v"(kf[i]), "v"(qr[i & 3])); }
#endif
}
__device__ __forceinline__ int v_st(int k, int c) { const int kk = (k & ~0xC) | ((k & 4) << 1) | ((k & 8) >> 1); return ((kk >> 3) * 4 + (c >> 5)) * 512 + ((kk & 7) * 32 + (c & 31)) * 2; }
__device__ __forceinline__ int v_rd_base(int lane) { return ((lane & 3) << 3) | (((lane >> 2) & 3) << 6) | (((lane >> 4) & 1) << 5) | (((lane >> 5) & 1) << 8); }
constexpr int v_rd_off(int d0, int ks, int half) { return d0 * 512 + ks * 4096 + half * 2048; }
template <int OFF> __device__ __forceinline__ s16x4 tr_read(int vb) { s16x4 r; asm volatile("ds_read_b64_tr_b16 %0, %1 offset:%2" : "=&v"(r) : "v"(vb), "i"(OFF) : "memory"); return r; }
template <int D0> __device__ __forceinline__ void pv_one(f32x16& od, int vb, bf16x8 pa0, bf16x8 pa1, bf16x8 pa2, bf16x8 pa3) {
    const s16x4 l0 = tr_read<v_rd_off(D0, 0, 0)>(vb), h0 = tr_read<v_rd_off(D0, 0, 1)>(vb), l1 = tr_read<v_rd_off(D0, 1, 0)>(vb), h1 = tr_read<v_rd_off(D0, 1, 1)>(vb);
    const s16x4 l2 = tr_read<v_rd_off(D0, 2, 0)>(vb), h2 = tr_read<v_rd_off(D0, 2, 1)>(vb), l3 = tr_read<v_rd_off(D0, 3, 0)>(vb), h3 = tr_read<v_rd_off(D0, 3, 1)>(vb);
    asm volatile("s_waitcnt lgkmcnt(0)" ::: "memory"); FA_SBAR();
#define FA_PK(L, H) (bf16x8){L[0], L[1], L[2], L[3], H[0], H[1], H[2], H[3]}
    od = __builtin_amdgcn_mfma_f32_32x32x16_bf16(pa0, FA_PK(l0, h0), od, 0, 0, 0);
    od = __builtin_amdgcn_mfma_f32_32x32x16_bf16(pa1, FA_PK(l1, h1), od, 0, 0, 0);
    od = __builtin_amdgcn_mfma_f32_32x32x16_bf16(pa2, FA_PK(l2, h2), od, 0, 0, 0);
    od = __builtin_amdgcn_mfma_f32_32x32x16_bf16(pa3, FA_PK(l3, h3), od, 0, 0, 0);
#undef FA_PK
}
__device__ __forceinline__ void pv_d0(f32x16 (&o)[4], int vb, bf16x8 pa0, bf16x8 pa1, bf16x8 pa2, bf16x8 pa3) {
    pv_one<0>(o[0], vb, pa0, pa1, pa2, pa3); pv_one<1>(o[1], vb, pa0, pa1, pa2, pa3); pv_one<2>(o[2], vb, pa0, pa1, pa2, pa3); pv_one<3>(o[3], vb, pa0, pa1, pa2, pa3);
}
__device__ __forceinline__ void attn_unit(const bf16_t* Q, const bf16_t* K, const bf16_t* V, bf16_t* O, int qrow0, int h, int klat0, int nlat, int kctx0, int NT,
                                          float lam, float oscale, const float* subln, LAS char* lds) {
    int tid = threadIdx.x; asm volatile("" : "+v"(tid));
    const int wid = __builtin_amdgcn_readfirstlane(tid >> 6), lane = tid & 63, r32 = lane & 31, hi = lane >> 5, map = wid >> 2, wq = wid & 3;
    LAS char* V_lds = lds; LAS char* K_lds = lds + 4 * SHM_V;
    LAS float* wsc = (LAS float*)(lds + 4 * SHM_V + 4 * SHM_K) + wid * 64; LAS float* li_l = wsc; LAS float* al_l = wsc + 32;
    float l_reg = 0; f32x16 o[4]; { const f32x16 z16 = ozero16(); o[0] = z16; o[1] = z16; o[2] = z16; o[3] = z16; } bf16x8 qr[4];
    { const bf16_t* Qw = Q + (size_t)(qrow0 + wq * 32 + r32) * 512 + h * 128 + map * 64 + hi * 8;
#pragma unroll
      for (int d0 = 0; d0 < 4; ++d0) qr[d0] = *reinterpret_cast<const bf16x8*>(Qw + d0 * 16); }
    unsigned kofs[2], vofs[2];
#pragma unroll
    for (int i = 0; i < 2; ++i) { const int p = 2 * wid + i, row = 4 * p + (lane >> 4); kofs[i] = (unsigned)(row * 1024 + ((16 * (lane & 15)) ^ ((row & 15) << 4)));
        const int sub = 2 * p + (lane >> 5), k = (sub >> 2) * 8 + ((lane & 31) >> 2), cc = (sub & 3) * 32 + (lane & 3) * 8;
        vofs[i] = (unsigned)(k * 1024 + cc * 2); }
    const char* Kg = (const char*)K + h * 256; const char* Vg = (const char*)V + h * 256;
    const int vrb = (int)(size_t)V_lds + v_rd_base(lane);
    const int mcol = map * 64;
    const unsigned offL = (unsigned)klat0 * 1024u, offC = (unsigned)(kctx0 - 64 * nlat) * 1024u;
#define FA_TOFF(t) (((t) < nlat ? offL : offC) + (unsigned)(t) * 65536u)
#define FA_DMA(G, D) __builtin_amdgcn_global_load_lds((const unsigned*)(G), (LAS unsigned*)(D), 16, 0, 0)
#define FA_ISSUE_K(t) do { const int t_ = (t); const char* g_ = Kg + FA_TOFF(t_); asm volatile("" : "+s"(g_)); LAS char* d_ = K_lds + (t_ & 3) * SHM_K + wid * 2048; FA_DMA(g_ + kofs[0], d_); FA_DMA(g_ + kofs[1], d_ + 1024); } while (0)
#define FA_ISSUE_V(t) do { const int t_ = (t); const char* g_ = Vg + FA_TOFF(t_); asm volatile("" : "+s"(g_)); LAS char* d_ = V_lds + (t_ & 3) * SHM_V + wid * 2048; FA_DMA(g_ + vofs[0], d_); FA_DMA(g_ + vofs[1], d_ + 1024); } while (0)
#define FA_TOP(N) do { asm volatile("s_waitcnt vmcnt(" #N ")" ::: "memory"); __builtin_amdgcn_s_barrier(); asm volatile("" ::: "memory"); FA_SBAR(); } while (0)
#define FA_RESC(a) do { if (__any((a) < 1.f)) { if (hi == 0) al_l[r32] = (a); asm volatile("s_waitcnt lgkmcnt(0)" ::: "memory"); \
    _Pragma("unroll") for (int d = 0; d < 4; ++d) _Pragma("unroll") for (int r = 0; r < 16; ++r) o[d][r] *= al_l[crow(r, hi)]; } } while (0)
    typedef float f32x2 __attribute__((ext_vector_type(2)));
    f32x16 p0, p1, negm; float al = 1.f, pm; bf16x8 pa[4], kf[8]; s16x4 vl[2][4], vh[2][4]; f32x2 sA, sB;
#define FA_PK(L, H) (bf16x8){L[0], L[1], L[2], L[3], H[0], H[1], H[2], H[3]}
#define FA_MM(D0, KS, SET) o[D0] = __builtin_amdgcn_mfma_f32_32x32x16_bf16(pa[KS], FA_PK(vl[SET][KS], vh[SET][KS]), o[D0], 0, 0, 0)
#define FA_VRD(D0, SET) do { vl[SET][0] = tr_read<v_rd_off(D0, 0, 0)>(vb_); vh[SET][0] = tr_read<v_rd_off(D0, 0, 1)>(vb_); vl[SET][1] = tr_read<v_rd_off(D0, 1, 0)>(vb_); vh[SET][1] = tr_read<v_rd_off(D0, 1, 1)>(vb_); \
    vl[SET][2] = tr_read<v_rd_off(D0, 2, 0)>(vb_); vh[SET][2] = tr_read<v_rd_off(D0, 2, 1)>(vb_); vl[SET][3] = tr_read<v_rd_off(D0, 3, 0)>(vb_); vh[SET][3] = tr_read<v_rd_off(D0, 3, 1)>(vb_); } while (0)
#define FA_LWAIT() do { asm volatile("s_waitcnt lgkmcnt(0)" ::: "memory"); FA_SBAR(); } while (0)
#define FA_MAX0() do { pm = p0[0]; _Pragma("unroll") for (int r = 1; r < 16; ++r) pm = fmaxf(pm, p0[r]); } while (0)
#define FA_MAX1() do { _Pragma("unroll") for (int r = 0; r < 16; ++r) pm = fmaxf(pm, p1[r]); auto rr_ = __builtin_amdgcn_permlane32_swap(__float_as_uint(pm), __float_as_uint(pm), false, false); \
    pm = fmaxf(__uint_as_float(rr_[0]), __uint_as_float(rr_[1])); } while (0)
#define FA_CHK() do { if (__builtin_expect(__all(pm <= THR * C), 1)) { al = 1.f; } else { const float d_ = fmaxf(pm, 0.f); al = __builtin_amdgcn_exp2f(-d_); \
    _Pragma("unroll") for (int r = 0; r < 16; ++r) { negm[r] -= d_; p0[r] -= d_; p1[r] -= d_; } } } while (0)
#define FA_EXP(P, A, B) do { _Pragma("unroll") for (int r = A; r < B; ++r) P[r] = __builtin_amdgcn_exp2f(P[r]); } while (0)
#define FA_P2(P, R) (f32x2){P[R], P[(R) + 1]}
#define FA_SUM0() do { sA = FA_P2(p0, 0) + FA_P2(p0, 2); sB = FA_P2(p0, 4) + FA_P2(p0, 6); } while (0)
#define FA_SUM1() do { sA += FA_P2(p0, 8); sB += FA_P2(p0, 10); sA += FA_P2(p0, 12); sB += FA_P2(p0, 14); } while (0)
#define FA_SUM2() do { sA += FA_P2(p1, 0); sB += FA_P2(p1, 2); sA += FA_P2(p1, 4); sB += FA_P2(p1, 6); } while (0)
#define FA_SUM3() do { sA += FA_P2(p1, 8); sB += FA_P2(p1, 10); sA += FA_P2(p1, 12); sB += FA_P2(p1, 14); sA += sB; float ps_ = sA[0] + sA[1]; \
    auto rr_ = __builtin_amdgcn_permlane32_swap(__float_as_uint(ps_), __float_as_uint(ps_), false, false); ps_ = __uint_as_float(rr_[0]) + __uint_as_float(rr_[1]); l_reg = l_reg * al + ps_; } while (0)
    FA_ISSUE_K(0); FA_ISSUE_K(1); FA_ISSUE_V(0); FA_ISSUE_K(2);
    FA_TOP(4);
    FA_ISSUE_K(3); FA_ISSUE_V(1); FA_SBAR();
    { const f32x16 z = {0.f, 0.f, 0.f, 0.f, 0.f, 0.f, 0.f, 0.f, 0.f, 0.f, 0.f, 0.f, 0.f, 0.f, 0.f, 0.f};
      qkt_load(kf, K_lds, r32, hi, mcol); FA_SBAR(); qkt_mma(p0, p1, kf, qr, z); asm volatile("" : "+v"(p0), "+v"(p1)); FA_SBAR(); }
    qkt_load(kf, K_lds + SHM_K, r32, hi, mcol);
    FA_MAX0(); FA_MAX1();
    { const float nm_ = -pm;
#pragma unroll
      for (int r = 0; r < 16; ++r) { negm[r] = nm_; p0[r] += nm_; p1[r] += nm_; } }
    FA_EXP(p0, 0, 16); FA_EXP(p1, 0, 16); FA_SUM0(); FA_SUM1(); FA_SUM2(); FA_SUM3();
    pa[0] = pk8<0>(p0); pa[1] = pk8<8>(p0); pa[2] = pk8<0>(p1); pa[3] = pk8<8>(p1); FA_SBAR();
    asm volatile(".p2align 6" ::: "memory");
#pragma unroll 1
    for (int j = 1; j < NT; ++j) {
        FA_TOP(4);
        const int vb_ = vrb + ((j - 1) & 3) * SHM_V;
        qkt_mma(p0, p1, kf, qr, negm); asm volatile("" : "+v"(p0), "+v"(p1)); FA_SBAR();
        FA_VRD(0, 0);
        { const int tk = (j + 3 < NT) ? j + 3 : NT - 1, tv = (j + 1 < NT) ? j + 1 : NT - 1; FA_ISSUE_K(tk); FA_ISSUE_V(tv); } FA_SBAR();
        FA_LWAIT();
        FA_MM(0, 0, 0); FA_VRD(1, 1); FA_SBAR();
        FA_MM(0, 1, 0); FA_MAX0(); FA_SBAR();
        FA_MM(0, 2, 0); FA_MAX1(); FA_SBAR();
        FA_MM(0, 3, 0); FA_CHK(); FA_EXP(p0, 0, 2); FA_SBAR();
        FA_LWAIT();
        FA_MM(1, 0, 1); FA_VRD(2, 0); FA_EXP(p0, 2, 4); FA_SBAR();
        FA_MM(1, 1, 1); FA_EXP(p0, 4, 7); FA_SBAR();
        FA_MM(1, 2, 1); FA_EXP(p0, 7, 10); FA_SBAR();
        FA_MM(1, 3, 1); FA_EXP(p0, 10, 13); FA_SBAR();
        FA_LWAIT();
        FA_MM(2, 0, 0); FA_VRD(3, 1); FA_EXP(p0, 13, 16); FA_SBAR();
        FA_MM(2, 1, 0); FA_EXP(p1, 0, 3); FA_SUM0(); FA_SBAR();
        FA_MM(2, 2, 0); FA_EXP(p1, 3, 6); FA_SUM1(); FA_SBAR();
        FA_MM(2, 3, 0); FA_EXP(p1, 6, 8); FA_SBAR();
        FA_LWAIT();
        FA_MM(3, 0, 1); FA_EXP(p1, 8, 10); pa[0] = pk8<0>(p0); FA_SBAR();
        FA_MM(3, 1, 1); FA_EXP(p1, 10, 12); pa[1] = pk8<8>(p0); FA_SBAR();
        FA_MM(3, 2, 1); FA_EXP(p1, 12, 14); FA_SUM2(); pa[2] = pk8<0>(p1); FA_SBAR();
        FA_MM(3, 3, 1); FA_EXP(p1, 14, 16); FA_SBAR();
        FA_SUM3(); pa[3] = pk8<8>(p1); FA_SBAR();
        qkt_load(kf, K_lds + ((j + 1) & 3) * SHM_K, r32, hi, mcol); FA_SBAR();
        FA_RESC(al); FA_SBAR();
    }
    FA_TOP(0);
    { const int vb_ = vrb + ((NT - 1) & 3) * SHM_V;
      FA_VRD(0, 0); FA_LWAIT(); FA_MM(0, 0, 0); FA_VRD(1, 1); FA_MM(0, 1, 0); FA_MM(0, 2, 0); FA_MM(0, 3, 0); FA_LWAIT();
      FA_MM(1, 0, 1); FA_VRD(2, 0); FA_MM(1, 1, 1); FA_MM(1, 2, 1); FA_MM(1, 3, 1); FA_LWAIT();
      FA_MM(2, 0, 0); FA_VRD(3, 1); FA_MM(2, 1, 0); FA_MM(2, 2, 0); FA_MM(2, 3, 0); FA_LWAIT();
      FA_MM(3, 0, 1); FA_MM(3, 1, 1); FA_MM(3, 2, 1); FA_MM(3, 3, 1); }
#undef FA_PK
#undef FA_MM
#undef FA_VRD
#undef FA_LWAIT
#undef FA_MAX0
#undef FA_MAX1
#undef FA_CHK
#undef FA_EXP
#undef FA_P2
#undef FA_SUM0
#undef FA_SUM1
#undef FA_SUM2
#undef FA_SUM3
#undef FA_TOFF
#undef FA_TOP
#undef FA_ISSUE_K
#undef FA_ISSUE_V
#undef FA_DMA
    if (hi == 0) li_l[r32] = l_reg; asm volatile("s_waitcnt lgkmcnt(0)" ::: "memory");
    float rli[16];
#pragma unroll
    for (int r = 0; r < 16; ++r) rli[r] = __builtin_amdgcn_rcpf(li_l[crow(r, hi)]);
    __syncthreads();
    LAS float* EX = (LAS float*)lds;
    if (map == 1) {
#pragma unroll
        for (int d0 = 0; d0 < 4; ++d0)
#pragma unroll
            for (int r = 0; r < 16; ++r) EX[(wq * 32 + crow(r, hi)) * 128 + d0 * 32 + r32] = o[d0][r] * rli[r];
    }
    __syncthreads();
    if (map == 0) {
        float ss[16];
#pragma unroll
        for (int r = 0; r < 16; ++r) ss[r] = 0.f;
#pragma unroll
        for (int d0 = 0; d0 < 4; ++d0)
#pragma unroll
            for (int r = 0; r < 16; ++r) { const float v = o[d0][r] * rli[r] - lam * EX[(wq * 32 + crow(r, hi)) * 128 + d0 * 32 + r32]; o[d0][r] = v; ss[r] += v * v; }
#pragma unroll
        for (int r = 0; r < 16; ++r) {
            ss[r] = grp32_sum(ss[r]);
            ss[r] = rsqrtf(ss[r] * (1.f / 128.f) + EPS) * oscale; }
#pragma unroll
        for (int d0 = 0; d0 < 4; ++d0) { const float sw = subln[d0 * 32 + r32];
#pragma unroll
            for (int r = 0; r < 16; ++r) O[(size_t)(qrow0 + wq * 32 + crow(r, hi)) * DM + h * 128 + d0 * 32 + r32] = (bf16_t)f2bf(o[d0][r] * ss[r] * sw); }
    }
    __syncthreads();
#undef FA_RESC
}
}
__device__ __forceinline__ void ph_attn_fast(const Ctx& c, int l, int qsel = 0) {
    const bf16_t* Q = c.wsp<bf16_t>(WS_Q); const bf16_t* Kb = c.wsp<bf16_t>(WS_K); const bf16_t* Vb = c.wsp<bf16_t>(WS_V); bf16_t* hb = c.wsp<bf16_t>(WS_HB);
    int lo_ = l; asm volatile("" : "+s"(lo_));
    const float lam_init = 0.8f - 0.6f * __expf(-0.3f * (float)lo_);
    LAS float* lamp = (LAS float*)(c.lds + 4 * fa::SHM_V + 4 * fa::SHM_K + 8 * 256);
    if (c.wave == 0) { const float* dl = c.in(I_DALAM) + l * 256; const float s1 = wave_sum(dl[c.lane] * dl[64 + c.lane]), s2 = wave_sum(dl[128 + c.lane] * dl[192 + c.lane]);
        if (c.lane == 0) lamp[0] = __expf(s1) - __expf(s2) + lam_init; }
    __syncthreads();
    const float lam = lamp[0];
    const float* subln = c.in(I_DASUB) + l * 128;
    const int nq = 128 + (l == 0 ? 8 : 0);
    unsigned* qctr = c.wsp<unsigned>(WS_CTL) + CW_ATTQ + l * 64 + qsel * 32;
    LAS int* qslot = (LAS int*)(c.lds + 4 * fa::SHM_V + 4 * fa::SHM_K + 8 * 256 + 64);
    const int xcd = (int)(blockIdx.x & 7);
    int qcur = 0;
#pragma unroll 1
    for (;;) {
        if (c.tid == 0) { int it = -1, s_ = qcur;
#pragma unroll 1
            for (; s_ < 8; ++s_) { const int q = (xcd + s_) & 7; const int v = (int)atomicAdd(qctr + q, 1u); if (v < nq) { it = q * 256 + v; break; } }
            qslot[0] = it; qslot[1] = s_; }
        __syncthreads();
        const int item = __builtin_amdgcn_readfirstlane(qslot[0]); qcur = __builtin_amdgcn_readfirstlane(qslot[1]);
        __syncthreads();
        if (item < 0) break;
        const int q = item >> 8, idx = item & 255;
        int b, h, qrow0, nlat;
        if (idx < 128) { const int bh = q * 4 + (idx >> 5); b = bh >> 2; h = bh & 3; qrow0 = b * SEQ + (idx & 31) * 128; nlat = SEQ / 64; }
        else { const int it = idx - 128, bh = q * 4 + (it >> 1); b = bh >> 2; h = bh & 3; qrow0 = TL + b * NCTX + (it & 1) * 128; nlat = 0; }
        fa::attn_unit(Q, Kb, Vb, hb, qrow0, h, b * SEQ, nlat, TL + b * NCTX, nlat + NCTX / 64, lam, 1.f - lam_init, subln, (LAS char*)c.lds);
    }
}


__device__ __forceinline__ void ph_s5_prep(const Ctx& c) {
    LAS float* PW = (LAS float*)c.lds;
    LAS float* BB = PW + 2 * 64 * 33 * 2;
    LAS float* CC = BB + 2 * 64 * 16 * 2;
    LAS float* KL = CC + 2 * 16 * 64 * 2;
    LAS float* FF = KL + 63 * 256;
    const int tid = c.tid;
#pragma unroll 1
    for (int item = c.bid; item < 256; item += c.G) {
        const int l = item >> 7, g = (item >> 3) & 15, part = item & 7;
        bf16_t* Mt = c.wsp<bf16_t>(ws_s5m(l)); bf16_t* Ft = c.wsp<bf16_t>(ws_s5f(l)); float* D32 = (float*)(c.ws() + ws_s5g(l) + 256 * 1024);
        if (tid < 128) { const int dir = tid >> 6, p = tid & 63; const int pi = ((l * 2 + dir) * 16 + g) * 64 + p;
            const float lr = c.in(I_S5LRE)[pi], li = c.in(I_S5LIM)[pi], step = __expf(c.in(I_S5STEP)[(l * 2 + dir) * 16 + g]);
            const float mag = __expf(lr * step); const float are = mag * __cosf(li * step), aim = mag * __sinf(li * step);
            const float den = lr * lr + li * li, nr = are - 1.f, ni = aim; FF[tid * 2] = (nr * lr + ni * li) / den; FF[tid * 2 + 1] = (ni * lr - nr * li) / den;
            float pr = 1.f, pim = 0.f; LAS float* pw = PW + (dir * 64 + p) * 66;
            for (int m = 0; m <= 32; ++m) { pw[2 * m] = pr; pw[2 * m + 1] = pim; const float nr2 = pr * are - pim * aim, ni2 = pr * aim + pim * are; pr = nr2; pim = ni2; }
            if (part == 0) { D32[((dir * 16 + g) * 64 + p) * 2] = pw[64]; D32[((dir * 16 + g) * 64 + p) * 2 + 1] = pw[65]; } }
        __syncthreads();
        for (int idx = tid; idx < 2048; idx += 512) { const int dir = idx >> 10, rem = idx & 1023;
            const size_t base = ((size_t)(l * 2 + dir) * 16 + g) * 1024 + rem; const float br = c.in(I_S5BRE)[base], bi = c.in(I_S5BIM)[base]; const int p = rem >> 4;
            const float fre = FF[(dir * 64 + p) * 2], fim = FF[(dir * 64 + p) * 2 + 1];
            BB[(dir * 1024 + rem) * 2] = fre * br - fim * bi; BB[(dir * 1024 + rem) * 2 + 1] = fre * bi + fim * br;
            CC[(dir * 1024 + rem) * 2] = c.in(I_S5CRE)[base]; CC[(dir * 1024 + rem) * 2 + 1] = c.in(I_S5CIM)[base]; }
        __syncthreads();
        const int lg_lo = 4 * part, nlg = 35;
        for (int idx = tid; idx < nlg * 64; idx += 512) { const int h4 = (idx & 3) * 4, t_ = idx >> 2, lg = lg_lo + t_ % nlg, ho = t_ / nlg, lag = lg - 31; f32x4 acc = {0.f, 0.f, 0.f, 0.f};
#pragma unroll 1
            for (int dir = 0; dir < 2; ++dir) { if ((dir == 0 && lag < 0) || (dir == 1 && lag > 0)) continue; const int m = lag < 0 ? -lag : lag;
#pragma unroll 4
                for (int p = 0; p < 64; ++p) { const float cr = CC[((dir * 16 + ho) * 64 + p) * 2], ci = CC[((dir * 16 + ho) * 64 + p) * 2 + 1], pr = PW[(dir * 64 + p) * 66 + 2 * m], pi2 = PW[(dir * 64 + p) * 66 + 2 * m + 1];
                    const float gr = cr * pr - ci * pi2, gi = cr * pi2 + ci * pr;
                    const f32x4 b0 = *(const LAS f32x4*)(BB + ((dir * 64 + p) * 16 + h4) * 2), b1 = *(const LAS f32x4*)(BB + ((dir * 64 + p) * 16 + h4 + 2) * 2);
                    acc[0] += gr * b0[0] - gi * b0[1]; acc[1] += gr * b0[2] - gi * b0[3]; acc[2] += gr * b1[0] - gi * b1[1]; acc[3] += gr * b1[2] - gi * b1[3]; } }
            if (lag == 0 && ho >= h4 && ho < h4 + 4) { const float dv = c.in(I_S5D)[l * 256 + g * 16 + ho];
#pragma unroll
                for (int e = 0; e < 4; ++e) if (ho == h4 + e) acc[e] += dv; }
            *(LAS f32x4*)(KL + lg * 256 + ho * 16 + h4) = acc; }
        __syncthreads();
        for (int idx = tid; idx < 64 * 96; idx += 512) { const int n = part * 64 + idx / 96, k8 = (idx % 96) * 8, ko = n >> 4, ho = n & 15; float v[8];
            if (k8 < 512) { const int ki = k8 >> 4, h0 = k8 & 15;
#pragma unroll
                for (int e = 0; e < 8; ++e) v[e] = KL[((ko - ki + 31) * 16 + ho) * 16 + h0 + e]; }
            else { const int q = k8 - 512, dir = q >> 7, p0 = (q & 127) >> 1; const int ex = dir == 0 ? ko + 1 : 32 - ko;
#pragma unroll
                for (int e = 0; e < 4; ++e) { const int p = p0 + e; const float cr = CC[((dir * 16 + ho) * 64 + p) * 2], ci = CC[((dir * 16 + ho) * 64 + p) * 2 + 1], pr = PW[(dir * 64 + p) * 66 + 2 * ex], pi2 = PW[(dir * 64 + p) * 66 + 2 * ex + 1];
                    v[2 * e] = cr * pr - ci * pi2; v[2 * e + 1] = -(cr * pi2 + ci * pr); } }
            u32x4 w; w.x = pk2(v[0], v[1]); w.y = pk2(v[2], v[3]); w.z = pk2(v[4], v[5]); w.w = pk2(v[6], v[7]);
            *(u32x4*)(Mt + ((size_t)g * 512 + n) * 768 + k8) = w; }
        for (int idx = tid; idx < 32 * 64; idx += 512) { const int r = part * 32 + (idx >> 6), k8 = (idx & 63) * 8, dir = r >> 7, p = (r & 127) >> 1, cpart = r & 1, ki = k8 >> 4, h0 = k8 & 15; const int ex = dir == 0 ? 31 - ki : ki;
            const float pr = PW[(dir * 64 + p) * 66 + 2 * ex], pi2 = PW[(dir * 64 + p) * 66 + 2 * ex + 1]; float v[8];
#pragma unroll
            for (int e = 0; e < 8; ++e) { const float br = BB[((dir * 64 + p) * 16 + h0 + e) * 2], bi = BB[((dir * 64 + p) * 16 + h0 + e) * 2 + 1]; v[e] = cpart == 0 ? pr * br - pi2 * bi : pr * bi + pi2 * br; }
            u32x4 w; w.x = pk2(v[0], v[1]); w.y = pk2(v[2], v[3]); w.z = pk2(v[4], v[5]); w.w = pk2(v[6], v[7]);
            *(u32x4*)(Ft + ((size_t)g * 256 + r) * 512 + k8) = w; }
        __syncthreads();
    }
    { LAS float* scr = (LAS float*)(c.lds + c.wave * 16640);
      for (int it = c.gw; it < 32; it += c.NGW) { const int l = it >> 4, kb = (it >> 2) & 3, nb = it & 3; tr_item64(c.in(I_S5WGLU) + (size_t)l * 65536, 256, 256, kb * 64, nb * 64, c.wsp<bf16_t>(ws_s5g(l)), 256, nb * 64, false, scr, c.lane); } }
}
__device__ __forceinline__ void ph_s5_scan(const Ctx& c, int l) {
    bf16_t* A = c.wsp<bf16_t>(WS_S5A); const float* L = c.wsp<float>(WS_S5L); const float* D32 = (const float*)(c.ws() + ws_s5g(l) + 256 * 1024);
    if (c.bid < 64 || c.bid >= 96) return;
    for (int idx = (c.bid - 64) * 512 + c.tid; idx < NB * 16 * 2 * 64; idx += 32 * 512) {
        const int p = idx & 63, dir = (idx >> 6) & 1, g = (idx >> 7) & 15, b = idx >> 11;
        const float dr = D32[((dir * 16 + g) * 64 + p) * 2], di = D32[((dir * 16 + g) * 64 + p) * 2 + 1];
        float sr = 0.f, si = 0.f;
#pragma unroll 1
        for (int n0 = 0; n0 < 136; n0 += 8) {
            f32x2 lv[8]; size_t rows[8];
#pragma unroll
            for (int q = 0; q < 8; ++q) { const int n = n0 + q; const int cc = dir == 0 ? n : (n < 8 ? 7 - n : 143 - n); rows[q] = (size_t)g * S5R + b * 136 + cc; lv[q] = *(const f32x2*)(L + rows[q] * 256 + dir * 128 + 2 * p); }
#pragma unroll
            for (int q = 0; q < 8; ++q) { *(unsigned*)(A + rows[q] * 768 + 512 + dir * 128 + 2 * p) = pk2(sr, si);
                const float nr = dr * sr - di * si + lv[q][0], ni = dr * si + di * sr + lv[q][1]; sr = nr; si = ni; }
        }
    }
}

namespace gdn {
using f32x16 = __attribute__((ext_vector_type(16))) float;
__device__ __forceinline__ int crow(int r, int hi) { return (r & 3) + 8 * (r >> 2) + 4 * hi; }
__device__ __forceinline__ int chunk_row0(int b, int ck) { return ck < 4 ? TL + b * NCTX + 64 * ck : b * SEQ + 64 * (ck - 4); }
}

__device__ __forceinline__ void ph_gdn_g1(const Ctx& c, int l, int nsteps = 9) {
    using namespace gdn;
    constexpr int XS = 129;
    LAS bf16_t* qs = (LAS bf16_t*)c.lds;
    LAS bf16_t* ks = qs + 4096; LAS bf16_t* vs = ks + 4096;
    LAS float* AT = (LAS float*)(c.lds + 24576);
    LAS float* X = AT + 8192;
    LAS float* bet = X + 2 * 64 * XS;
    LAS float* gg = bet + 128;
    LAS float* gcs = gg + 128;
    LAS float* betp = gcs + 128;
    LAS bf16_t* QKs = (LAS bf16_t*)(betp + 128);
    LAS float* esc = (LAS float*)(QKs + 8192);
    LAS float* eg = esc + 128;
    LAS float* egl = eg + 128;
    constexpr int XTLD = 72;
    LAS bf16_t* XT = (LAS bf16_t*)X;
    const bf16_t* Gq = c.wsp<bf16_t>(WS_G); const float* BA = c.wsp<float>(WS_BA);
    const float* cw = c.in(I_GCONV) + (size_t)l * 5 * 768;
    LAS float* cwl = (LAS float*)((LAS unsigned char*)X + 40960);
    for (int i = c.tid; i < 5 * 768 / 4; i += 512) *(LAS f32x4*)(cwl + 4 * i) = *(const f32x4*)(cw + 4 * i);
    __syncthreads();
    float* GLp = c.wsp<float>(WS_GL);
    bf16x8 xin[15];
#define G1_LOADX(UU, TID) do { const int ck_ = (UU) % 68, bh_ = (UU) / 68, h_ = bh_ & 3, b_ = bh_ >> 2; const int row0_ = chunk_row0(b_, ck_); \
    const int segbase_ = ck_ < 4 ? TL + b_ * NCTX : b_ * SEQ, seglen_ = ck_ < 4 ? NCTX : SEQ, t_ = row0_ - segbase_ + ((TID) >> 3); \
    _Pragma("unroll") for (int m_ = 0; m_ < 3; ++m_) _Pragma("unroll") for (int j_ = 0; j_ < 5; ++j_) { const int tt_ = t_ + j_ - 2, tc_ = tt_ < 0 ? 0 : (tt_ >= seglen_ ? seglen_ - 1 : tt_); \
        xin[m_ * 5 + j_] = *(const bf16x8*)(Gq + (size_t)(segbase_ + tc_) * 768 + m_ * 256 + h_ * 64 + ((TID) & 7) * 8); } } while (0)
    if (c.bid < NGU) { int t0_ = threadIdx.x; asm volatile("" : "+v"(t0_)); G1_LOADX(c.bid, t0_); }
#pragma unroll 1
    for (int u = c.bid; u < NGU; u += c.G) {
        int tid = threadIdx.x; asm volatile("" : "+v"(tid));
        const int lane = tid & 63, wave = __builtin_amdgcn_readfirstlane(tid >> 6), r32 = lane & 31, hi = lane >> 5;
        const int ck = u % 68, bh = u / 68, h = bh & 3, b = bh >> 2;
        const int row0 = chunk_row0(b, ck);
        const int segbase = ck < 4 ? TL + b * NCTX : b * SEQ, seglen = ck < 4 ? NCTX : SEQ;
        unsigned char* rec0 = c.ws() + WS_REC0 + (size_t)u * REC_BYTES; unsigned char* rec1 = c.ws() + WS_REC1 + (size_t)u * REC_BYTES;
        { const int i = tid >> 3, part = tid & 7; const int t = row0 - segbase + i;
#pragma unroll
          for (int m = 0; m < 3; ++m) { const int ch = m * 256 + h * 64 + part * 8; float acc[8];
#pragma unroll
              for (int e = 0; e < 8; ++e) acc[e] = 0.f;
#pragma unroll
              for (int j = 0; j < 5; ++j) { const int tt = t + j - 2; const bool ok = tt >= 0 && tt < seglen;
                  const bf16x8 x = xin[m * 5 + j]; const float mk = ok ? 1.f : 0.f; const f32x4 w0 = *(const LAS f32x4*)(cwl + j * 768 + ch) * mk, w1 = *(const LAS f32x4*)(cwl + j * 768 + ch + 4) * mk;
#pragma unroll
                  for (int e = 0; e < 4; ++e) { acc[e] += w0[e] * bf2f((unsigned short)x[e]); acc[4 + e] += w1[e] * bf2f((unsigned short)x[4 + e]); } }
              float ss = 0.f;
#pragma unroll
              for (int e = 0; e < 8; ++e) { acc[e] = siluf(acc[e]); ss += acc[e] * acc[e]; }
              if (m < 2) { ss = grp8_sum(ss); const float rr = rsqrtf(ss + EPS) * (m == 0 ? 0.125f : 1.f);
#pragma unroll
                  for (int e = 0; e < 8; ++e) acc[e] *= rr; }
              u32x4 w; w.x = pk2(acc[0], acc[1]); w.y = pk2(acc[2], acc[3]); w.z = pk2(acc[4], acc[5]); w.w = pk2(acc[6], acc[7]);
              *(LAS u32x4*)((m == 0 ? qs : (m == 1 ? ks : vs)) + i * 64 + part * 8) = w; }
          if (part < 2) { const int dir = part; const float xb = BA[(size_t)(row0 + i) * 16 + dir * 4 + h], xa = BA[(size_t)(row0 + i) * 16 + 8 + dir * 4 + h] + c.in(I_GDT)[l * 8 + dir * 4 + h];
              const float sp = xa > 20.f ? xa : (xa < -15.f ? __expf(xa) : __logf(1.f + __expf(xa)));
              bet[dir * 64 + i] = sigmf(xb); gg[dir * 64 + i] = -__expf(c.in(I_GALOG)[l * 8 + dir * 4 + h]) * sp; } }
        __syncthreads();
        if (u + c.G < NGU) G1_LOADX(u + c.G, tid);
        if (nsteps < 2) continue;
        if ((wave & 3) == 0) { const int dir = wave >> 2; const int pi = dir ? 63 - lane : lane; float g = gg[dir * 64 + pi];
#pragma unroll
            for (int ofs = 1; ofs < 64; ofs <<= 1) { const float o_ = __shfl_up(g, ofs); if (lane >= ofs) g += o_; }
            const float bp = bet[dir * 64 + pi], e_ = __expf(g), gl_ = __shfl(g, 63);
            gcs[dir * 64 + lane] = g; betp[dir * 64 + lane] = bp; esc[dir * 64 + lane] = bp * e_; eg[dir * 64 + lane] = e_; egl[dir * 64 + lane] = __expf(gl_ - g); }
        { const int mat = wave >> 2, rt = (wave >> 1) & 1, ct = wave & 1; const LAS bf16_t* As = mat ? qs : ks; f32x16 acc = ozero16();
#pragma unroll
          for (int sx = 0; sx < 4; ++sx) { const bf16x8 a = *(const LAS bf16x8*)(As + (32 * rt + r32) * 64 + 16 * sx + 8 * hi), bb = *(const LAS bf16x8*)(ks + (32 * ct + r32) * 64 + 16 * sx + 8 * hi);
              acc = __builtin_amdgcn_mfma_f32_32x32x16_bf16(a, bb, acc, 0, 0, 0); }
          __syncthreads();
#pragma unroll
          for (int dir = 0; dir < 2; ++dir) {
              const int colo = 32 * ct + r32, j = dir ? 63 - colo : colo; const float gj = gcs[dir * 64 + j];
#pragma unroll
              for (int r = 0; r < 16; ++r) { const int rowo = 32 * rt + crow(r, hi), i = dir ? 63 - rowo : rowo; const float gi = gcs[dir * 64 + i];
                  if (mat == 0) { if (j < i) AT[dir * 4096 + i * 64 + j] = betp[dir * 64 + i] * acc[r] * __expf(gi - gj); }
                  else QKs[dir * 4096 + i * 64 + j] = (bf16_t)f2bf(j <= i ? acc[r] * __expf(gi - gj) : 0.f); } } }
        __syncthreads();
        if (nsteps < 3) continue;
        LAS bf16_t* Ub = XT + 2 * 128 * XTLD;
        if (tid < 384) { const LAS u32x4* QK4 = (const LAS u32x4*)QKs;
#pragma unroll 1
          for (int idx = tid; idx < 1024; idx += 384) { const int dir = idx >> 9, ch = idx & 511; *(u32x4*)((dir ? rec1 : rec0) + 32768 + ch * 16) = QK4[dir * 512 + ch]; }
#pragma unroll 1
          for (int idx = tid; idx < 1024; idx += 384) { const int dir = idx >> 9, i = (idx >> 3) & 63, d8 = (idx & 7) * 8, pi = dir ? 63 - i : i; const float sc = eg[dir * 64 + i];
              const bf16x8 x = *(const LAS bf16x8*)(qs + pi * 64 + d8); u32x4 w;
              w.x = pk2(bf2f((unsigned short)x[0]) * sc, bf2f((unsigned short)x[1]) * sc); w.y = pk2(bf2f((unsigned short)x[2]) * sc, bf2f((unsigned short)x[3]) * sc);
              w.z = pk2(bf2f((unsigned short)x[4]) * sc, bf2f((unsigned short)x[5]) * sc); w.w = pk2(bf2f((unsigned short)x[6]) * sc, bf2f((unsigned short)x[7]) * sc);
              *(u32x4*)((dir ? rec1 : rec0) + 16384 + (i * 64 + d8) * 2) = w; }
#pragma unroll 1
          for (int idx = tid; idx < 1024; idx += 384) { const int dir = idx >> 9, d = (idx >> 3) & 63, i8 = (idx & 7) * 8; float v[8];
              const f32x4 s0 = *(const LAS f32x4*)(egl + dir * 64 + i8), s1 = *(const LAS f32x4*)(egl + dir * 64 + i8 + 4);
#pragma unroll
              for (int e = 0; e < 8; ++e) { const int ii = i8 + e, pii = dir ? 63 - ii : ii; v[e] = bf2f(ks[pii * 64 + d]) * (e < 4 ? s0[e & 3] : s1[e & 3]); }
              u32x4 w; w.x = pk2(v[0], v[1]); w.y = pk2(v[2], v[3]); w.z = pk2(v[4], v[5]); w.w = pk2(v[6], v[7]);
              *(u32x4*)((dir ? rec1 : rec0) + 24576 + (d * 64 + i8) * 2) = w; }
          if (tid < 2) GLp[tid * NGU + u] = eg[tid * 64 + 63]; }
        else { const int t2 = tid - 384, d_ = t2 >> 6, blk = (t2 >> 4) & 3, cc = t2 & 15; const LAS float* Ab = AT + d_ * 4096 + (16 * blk) * 64 + 16 * blk; float x[16];
#pragma unroll
            for (int r = 0; r < 16; ++r) x[r] = (r == cc) ? 1.f : 0.f;
#pragma unroll
            for (int r = 1; r < 16; ++r) { f32x4 a[4];
#pragma unroll
                for (int q = 0; q < 4; ++q) if (4 * q < r) a[q] = *(const LAS f32x4*)(Ab + r * 64 + 4 * q);
                float acc = x[r];
#pragma unroll
                for (int c2 = 0; c2 < r; ++c2) acc -= a[c2 >> 2][c2 & 3] * x[c2];
                x[r] = acc; }
            LAS bf16_t* up = Ub + ((d_ * 4 + blk) * 16) * 16 + cc;
#pragma unroll
            for (int r = 0; r < 16; ++r) up[r * 16] = (bf16_t)f2bf(x[r]); }
        __syncthreads();
        if (nsteps < 4) continue;
        const int dir = wave >> 2;
        { const int fr = lane & 15, g = lane >> 4, dw = wave & 3; const LAS float* A = AT + dir * 4096;
          LAS bf16_t* XTd = XT + dir * 128 * XTLD; const LAS bf16_t* Ud = Ub + dir * 4 * 256;
#pragma unroll
          for (int i = 0; i < 4; ++i) {
#pragma unroll
              for (int tt = 0; tt < 2; ++tt) { const int ct = dw * 2 + tt, col = 16 * ct + fr; f32x4 acc;
                  const LAS bf16_t* src = (ct < 4 ? vs : ks) + (col & 63); const LAS float* scp = (ct < 4 ? betp : esc) + dir * 64;
#pragma unroll
                  for (int r = 0; r < 4; ++r) { const int row = 16 * i + 4 * g + r, pi = dir ? 63 - row : row; acc[r] = scp[row] * bf2f(src[pi * 64]); }
#pragma unroll
                  for (int kk = 0; kk < (i + 1) / 2; ++kk) { const LAS float* ap = A + (16 * i + fr) * 64 + 32 * kk + 8 * g;
                      const f32x4 a0 = *(const LAS f32x4*)ap, a1 = *(const LAS f32x4*)(ap + 4); const bool ok = 32 * kk + 8 * g < 16 * i;
                      u32x4 aw; aw.x = ok ? pk2(-a0[0], -a0[1]) : 0u; aw.y = ok ? pk2(-a0[2], -a0[3]) : 0u; aw.z = ok ? pk2(-a1[0], -a1[1]) : 0u; aw.w = ok ? pk2(-a1[2], -a1[3]) : 0u;
                      u32x4 bw = *(const LAS u32x4*)(XTd + col * XTLD + 32 * kk + 8 * g); if (!ok) bw = (u32x4){0u, 0u, 0u, 0u};
                      const bf16x8 bfr = __builtin_bit_cast(bf16x8, bw);
                      acc = __builtin_amdgcn_mfma_f32_16x16x32_bf16(__builtin_bit_cast(bf16x8, aw), bfr, acc, 0, 0, 0); }
                  const u32x2 uu = *(const LAS u32x2*)(Ud + (i * 16 + fr) * 16 + 4 * g);
                  const u32x4 uw = {uu.x, uu.y, 0u, 0u}, tw = {pk2(acc[0], acc[1]), pk2(acc[2], acc[3]), 0u, 0u};
                  const f32x4 xi = __builtin_amdgcn_mfma_f32_16x16x32_bf16(__builtin_bit_cast(bf16x8, uw), __builtin_bit_cast(bf16x8, tw), ozero4(), 0, 0, 0);
                  { u32x2 xw; xw.x = pk2(xi[0], xi[1]); xw.y = pk2(xi[2], xi[3]); *(LAS u32x2*)(XTd + col * XTLD + 16 * i + 4 * g) = xw; } }
              if (i < 3) __syncthreads(); } }
        __syncthreads();
        if (nsteps < 5) continue;
        { const int ht = tid & 255; unsigned char* rec = dir ? rec1 : rec0; const LAS bf16_t* XTd = XT + dir * 128 * XTLD;
#pragma unroll
          for (int q = 0; q < 2; ++q) { const int idx = ht + 256 * q, dv = idx >> 3, c8 = (idx & 7) * 8; *(u32x4*)(rec + (dv * 64 + c8) * 2) = *(const LAS u32x4*)(XTd + dv * XTLD + c8); }
#pragma unroll
          for (int q = 0; q < 2; ++q) { const int idx = ht + 256 * q, ci = idx >> 3, d8 = (idx & 7) * 8; unsigned v[8];
#pragma unroll
              for (int e = 0; e < 8; ++e) v[e] = (unsigned)XTd[(64 + d8 + e) * XTLD + ci] ^ 0x8000u;
              u32x4 w; w.x = v[0] | (v[1] << 16); w.y = v[2] | (v[3] << 16); w.z = v[4] | (v[5] << 16); w.w = v[6] | (v[7] << 16); *(u32x4*)(rec + 8192 + (ci * 64 + d8) * 2) = w; } }
    }
}
struct G2Ops { bf16x8 A1[4], A2[4]; u32x2 ut[4]; float glast; int row0; };
__device__ __forceinline__ void ph_gdn_g2(const Ctx& c, int l) {
    using namespace gdn;
    LAS bf16_t* ST = (LAS bf16_t*)c.lds;
    LAS bf16_t* VT = ST + 4096;
    bf16_t* GO = c.wsp<bf16_t>(WS_GO); const float* GLp = c.wsp<float>(WS_GL);
    const int tid = c.tid, lane = c.lane, wave = c.wave, r32 = lane & 31, hi = lane >> 5, role = wave >> 2, rt = (wave >> 1) & 1, ct = wave & 1;
#define G2_LOAD(OP, n_) do { const int n__ = (n_); const int ck_ = dir == 0 ? n__ : (n__ < 4 ? 3 - n__ : 71 - n__); const int u_ = bh * 68 + ck_; \
        const unsigned char* rec_ = wsb + (dir ? WS_REC1 : WS_REC0) + (size_t)u_ * REC_BYTES; OP.glast = GLp[dir * NGU + u_]; OP.row0 = chunk_row0(b, ck_); \
        const bf16_t* a1_ = (const bf16_t*)(rec_ + (role ? 16384 : 8192)) + (size_t)(32 * rt + r32) * 64 + 8 * hi; const bf16_t* a2_ = (const bf16_t*)(rec_ + (role ? 32768 : 24576)) + (size_t)(32 * rt + r32) * 64 + 8 * hi; \
        _Pragma("unroll") for (int sx = 0; sx < 4; ++sx) { OP.A1[sx] = *(const bf16x8*)(a1_ + 16 * sx); OP.A2[sx] = *(const bf16x8*)(a2_ + 16 * sx); } \
        const bf16_t* ut_ = (const bf16_t*)rec_ + (size_t)(32 * ct + r32) * 64 + 32 * rt + 4 * hi; \
        _Pragma("unroll") for (int g = 0; g < 4; ++g) OP.ut[g] = *(const u32x2*)(ut_ + 8 * g); } while (0)
#define G2_STEP(OP) do { \
        f32x16 acc = ozero16(); \
        if (role == 0) { _Pragma("unroll") for (int g = 0; g < 4; ++g) { const u32x2 w = OP.ut[g]; acc[4 * g] = __builtin_bit_cast(float, w.x << 16); acc[4 * g + 1] = __builtin_bit_cast(float, w.x & 0xffff0000u); \
            acc[4 * g + 2] = __builtin_bit_cast(float, w.y << 16); acc[4 * g + 3] = __builtin_bit_cast(float, w.y & 0xffff0000u); } } \
        _Pragma("unroll") for (int sx = 0; sx < 4; ++sx) { const bf16x8 bs = *(const LAS bf16x8*)(ST + (32 * ct + r32) * 64 + 16 * sx + 8 * hi); acc = __builtin_amdgcn_mfma_f32_32x32x16_bf16(OP.A1[sx], bs, acc, 0, 0, 0); } \
        if (role == 0) { _Pragma("unroll") for (int g = 0; g < 4; ++g) { u32x2 w; w.x = pk2(acc[4 * g], acc[4 * g + 1]); w.y = pk2(acc[4 * g + 2], acc[4 * g + 3]); *(LAS u32x2*)(VT + (32 * ct + r32) * 64 + 32 * rt + 8 * g + 4 * hi) = w; } } \
        __syncthreads(); \
        if (role == 0) { Sacc = Sacc * OP.glast; \
            _Pragma("unroll") for (int sx = 0; sx < 4; ++sx) { const bf16x8 bv = *(const LAS bf16x8*)(VT + (32 * ct + r32) * 64 + 16 * sx + 8 * hi); Sacc = __builtin_amdgcn_mfma_f32_32x32x16_bf16(OP.A2[sx], bv, Sacc, 0, 0, 0); } \
            _Pragma("unroll") for (int g = 0; g < 4; ++g) { u32x2 w; w.x = pk2(Sacc[4 * g], Sacc[4 * g + 1]); w.y = pk2(Sacc[4 * g + 2], Sacc[4 * g + 3]); *(LAS u32x2*)(ST + (32 * ct + r32) * 64 + 32 * rt + 8 * g + 4 * hi) = w; } \
        } else { \
            _Pragma("unroll") for (int sx = 0; sx < 4; ++sx) { const bf16x8 bv = *(const LAS bf16x8*)(VT + (32 * ct + r32) * 64 + 16 * sx + 8 * hi); acc = __builtin_amdgcn_mfma_f32_32x32x16_bf16(OP.A2[sx], bv, acc, 0, 0, 0); } \
            _Pragma("unroll") for (int r = 0; r < 16; ++r) { const int i = 32 * rt + crow(r, hi); const int pi = dir ? 63 - i : i; GO[((size_t)dir * MT + OP.row0 + pi) * 256 + h * 64 + 32 * ct + r32] = (bf16_t)f2bf(acc[r]); } \
        } \
        __syncthreads(); } while (0)
#pragma unroll 1
    for (int item = c.bid; item < NB * 4 * 2; item += c.G) {
        const int dir = item & 1, bh = item >> 1, h = bh & 3, b = bh >> 2;
        const unsigned char* wsb = c.ws();
        for (int i = tid; i < 2048; i += 512) ((LAS unsigned*)ST)[i] = 0u;
        f32x16 Sacc = ozero16();
        G2Ops opA, opB, opC;
        G2_LOAD(opA, 0); G2_LOAD(opB, 1);
        __syncthreads();
#pragma unroll 1
        for (int n = 0; n < 66; n += 3) {
            G2_LOAD(opC, n + 2);
            G2_STEP(opA);
            G2_LOAD(opA, n + 3);
            G2_STEP(opB);
            G2_LOAD(opB, n + 4 < 68 ? n + 4 : 67);
            G2_STEP(opC);
        }
        G2_STEP(opA);
        G2_STEP(opB);
    }
#undef G2_LOAD
#undef G2_STEP
}
__device__ __forceinline__ void ph_gdn_finish(const Ctx& c, int l, int nrows) {
    const bf16_t* GO = c.wsp<bf16_t>(WS_GO); const bf16_t* Z = c.wsp<bf16_t>(WS_Z); bf16_t* hb = c.wsp<bf16_t>(WS_HB);
    const int col = 4 * c.lane;
    const f32x4 nw = *(const f32x4*)(c.in(I_GNORM) + l * 64 + (col & 63));
    for (int m0 = c.gw * 4; m0 < nrows; m0 += c.NGW * 4) {
        u32x2 gf[4], gb[4], zz[4];
#pragma unroll
        for (int q = 0; q < 4; ++q) { const int m = m0 + q < nrows ? m0 + q : nrows - 1;
            gf[q] = *(const u32x2*)(GO + (size_t)m * 256 + col); gb[q] = *(const u32x2*)(GO + ((size_t)MT + m) * 256 + col); zz[q] = *(const u32x2*)(Z + (size_t)m * 256 + col); }
#pragma unroll
        for (int q = 0; q < 4; ++q) { const int m = m0 + q; if (m >= nrows) break;
            f32x4 os; os[0] = bf2f((unsigned short)(gf[q].x & 0xffffu)) + bf2f((unsigned short)(gb[q].x & 0xffffu)); os[1] = bf2f((unsigned short)(gf[q].x >> 16)) + bf2f((unsigned short)(gb[q].x >> 16));
            os[2] = bf2f((unsigned short)(gf[q].y & 0xffffu)) + bf2f((unsigned short)(gb[q].y & 0xffffu)); os[3] = bf2f((unsigned short)(gf[q].y >> 16)) + bf2f((unsigned short)(gb[q].y >> 16));
            float ss = (os[0] * os[0] + os[1] * os[1]) + (os[2] * os[2] + os[3] * os[3]);
            ss = grp16_sum(ss);
            const float rs = rsqrtf(ss * (1.f / 64.f) + EPS);
            const float z0 = bf2f((unsigned short)(zz[q].x & 0xffffu)), z1 = bf2f((unsigned short)(zz[q].x >> 16)), z2 = bf2f((unsigned short)(zz[q].y & 0xffffu)), z3 = bf2f((unsigned short)(zz[q].y >> 16));
            u32x2 o; o.x = pk2(os[0] * rs * nw[0] * siluf(z0), os[1] * rs * nw[1] * siluf(z1)); o.y = pk2(os[2] * rs * nw[2] * siluf(z2), os[3] * rs * nw[3] * siluf(z3));
            *(u32x2*)(hb + (size_t)m * DM + 768 + col) = o; }
    }
}

__device__ __forceinline__ void ph_norm2(const Ctx& c, int l, int nrows) {
    const float* mods = c.wsp<float>(WS_MODS) + (size_t)l * 9 * 6144;
    bf16_t* hb = c.wsp<bf16_t>(WS_HB);
    const float* xlat = c.out(); const float* xctx = c.wsp<float>(WS_XC); const float* n2w = c.in(I_N2W) + l * DM;
    for (int m = c.gw; m < nrows; m += 2 * c.NGW) {
        const int m2 = m + c.NGW < nrows ? m + c.NGW : m;
        const float* xr = m < TL ? xlat + (size_t)m * DM : xctx + (size_t)(m - TL) * DM;
        const float* xr2 = m2 < TL ? xlat + (size_t)m2 * DM : xctx + (size_t)(m2 - TL) * DM;
        f32x4 va[4], vb[4]; norm_row_load(xr, va, c.lane, true); norm_row_load(xr2, vb, c.lane, true);
        { const int j = m < TL ? m / SEQ : 8; norm_row_finish<false>(va, n2w, mods + j * 6144 + 4 * 1024, mods + j * 6144 + 3 * 1024, hb + (size_t)m * DM, nullptr, c.lane); }
        if (m2 != m) { const int j = m2 < TL ? m2 / SEQ : 8; norm_row_finish<false>(vb, n2w, mods + j * 6144 + 4 * 1024, mods + j * 6144 + 3 * 1024, hb + (size_t)m2 * DM, nullptr, c.lane); } }
}
__device__ __forceinline__ void ph_wr2(const Ctx& c, int l) {
    const float* W = c.in(I_WR) + (size_t)l * 65536; bf16_t* WR2 = c.wsp<bf16_t>(WS_WR2);
    for (int idx = c.bid * 512 + c.tid; idx < 256 * 128; idx += c.G * 512) { const int k8 = (idx & 127) * 8, n = (idx >> 7) & 255, g = idx >> 15;
        u32x4 w = {0u, 0u, 0u, 0u};
        const int kind = g == 0 ? (n < 64 ? 0 : (n < 128 ? 1 : 2)) : (n < 64 ? 0 : 2);
        if (kind < 2) { float v[8];
#pragma unroll
            for (int e = 0; e < 8; ++e) { const float x = W[(size_t)(k8 + e) * 64 + (n & 63)]; const float h = __builtin_bit_cast(float, f2bf(x) << 16); v[e] = kind == 0 ? x : x - h; }
            w.x = pk2(v[0], v[1]); w.y = pk2(v[2], v[3]); w.z = pk2(v[4], v[5]); w.w = pk2(v[6], v[7]); }
        *(u32x4*)(WR2 + ((size_t)g * 256 + n) * 1024 + k8) = w; }
}
constexpr int TOK_PER_BLK = 136;
constexpr size_t WS_BH = 9 * MiB + 512 * 1024;
__device__ __forceinline__ void ph_topk(const Ctx& c, int l, int nrows) {
    LAS int* hist = (LAS int*)c.lds;
    const float* lg = c.wsp<float>(WS_LOG); const float rbias = c.in(I_RB)[l * 64 + c.lane];
    int* tki = c.wsp<int>(WS_TKI); float* tkw = c.wsp<float>(WS_TKW); int* BH = c.wsp<int>(WS_BH);
    unsigned* cnt = c.wsp<unsigned>(WS_CTL) + CW_CNT + l * 128;
    if (c.tid < 64) hist[c.tid] = 0;
    __syncthreads();
    const int lane = c.lane, t_lo = c.bid * TOK_PER_BLK, t_hi = min(nrows, t_lo + TOK_PER_BLK);
    int mycount = 0;
#define TK_LOAD(DST, K0) do { _Pragma("unroll") for (int q_ = 0; q_ < 4; ++q_) { int t_ = t_lo + c.wave + 8 * ((K0) + q_); t_ = t_ < t_hi ? t_ : t_hi - 1; \
        DST[q_] = lg[(size_t)t_ * 128 + lane] + lg[(size_t)t_ * 128 + 64 + lane]; } } while (0)
    float cur[4], nxt[4];
    if (t_lo < t_hi) TK_LOAD(cur, 0);
#pragma unroll 1
    for (int k0 = 0; t_lo + c.wave + 8 * k0 < t_hi; k0 += 4) {
        if (t_lo + c.wave + 8 * (k0 + 4) < t_hi) TK_LOAD(nxt, k0 + 4);
#pragma unroll
        for (int q = 0; q < 4; ++q) { const int t = t_lo + c.wave + 8 * (k0 + q); if (t >= t_hi) break;
        const float lgt = cur[q];
        const float sc = sigmf_exact(lgt), s = sc + rbias;
        const float m1 = grp8_max(s);
        const unsigned long long eqm = __ballot(s == m1); const int gbase = lane & ~7; const unsigned gm = (unsigned)(eqm >> gbase) & 0xffu; const int first = gbase + __builtin_ctz(gm);
        const float s2 = grp8_max((lane == first) ? -3.0e38f : s);
        const float gs = m1 + s2; const int g = lane >> 3;
        int grank = 0;
#pragma unroll
        for (int g2 = 0; g2 < 8; ++g2) { const float o = __builtin_bit_cast(float, __builtin_amdgcn_readlane(__builtin_bit_cast(int, gs), g2 * 8)); grank += (o > gs || (o == gs && g2 < g)) ? 1 : 0; }
        const float v = grank < 4 ? s : -3.0e38f;
        int rank = 0;
#pragma unroll
        for (int e2 = 0; e2 < 64; ++e2) { const float o = __builtin_bit_cast(float, __builtin_amdgcn_readlane(__builtin_bit_cast(int, v), e2)); rank += (o > v || (o == v && e2 < lane)) ? 1 : 0; }
        const bool chosen = rank < 8 && grank < 4;
        const float w = chosen ? sc : 0.f; const float wsum = wave_sum(w);
        if (chosen) { tki[(size_t)t * 8 + rank] = lane; tkw[(size_t)t * 8 + rank] = w * (2.5f / wsum); ++mycount; }
            }
#pragma unroll
        for (int q = 0; q < 4; ++q) cur[q] = nxt[q];
    }
#undef TK_LOAD
    if (mycount) __hip_atomic_fetch_add(&hist[lane], mycount, __ATOMIC_RELAXED, __HIP_MEMORY_SCOPE_WORKGROUP);
    __syncthreads();
    if (c.tid < 64) { const int hv = hist[c.tid]; BH[c.bid * 64 + c.tid] = hv; if (hv > 0) atomicAdd(&cnt[c.tid], (unsigned)hv); }
}
__device__ __forceinline__ int moe_tstart(const Ctx& c, int l, int nrows, LAS int* tstart) {
    const unsigned* cnt = c.wsp<unsigned>(WS_CTL) + CW_CNT + l * 128;
    if (c.wave == 0) {
        const int n = (int)__hip_atomic_load(cnt + c.lane, __ATOMIC_RELAXED, __HIP_MEMORY_SCOPE_AGENT); const int t = (n + 255) >> 8; int inc = t;
#pragma unroll
        for (int ofs = 1; ofs < 64; ofs <<= 1) { const int o_ = __shfl_up(inc, ofs); if (c.lane >= ofs) inc += o_; }
        tstart[c.lane] = inc - t;
        if (c.lane == 63) { tstart[64] = inc; tstart[NE1] = inc + ((nrows + 255) >> 8); } }
    __syncthreads();
    return tstart[NE1];
}
__device__ __forceinline__ void ph_lists(const Ctx& c, int l, int nrows) {
    LAS int* tstart = (LAS int*)(c.lds + LDS_MISC - 1024);
    LAS int* base = (LAS int*)c.lds;
    moe_tstart(c, l, nrows, tstart);
    const unsigned* cnt = c.wsp<unsigned>(WS_CTL) + CW_CNT + l * 128; const int* BH = c.wsp<int>(WS_BH);
    const int* tki = c.wsp<int>(WS_TKI); const float* tkw = c.wsp<float>(WS_TKW);
    int* pos = c.wsp<int>(WS_POS); int* ltok = c.wsp<int>(WS_LTOK); float* lgate = c.wsp<float>(WS_LGATE);
    if (c.tid < 64) base[c.tid] = tstart[c.tid] * 256;
    __syncthreads();
    { const int e = c.tid & 63, part = c.tid >> 6; int acc = 0;
#pragma unroll 8
      for (int b2 = part; b2 < c.bid; b2 += 8) acc += BH[b2 * 64 + e];
      if (acc) __hip_atomic_fetch_add(&base[e], acc, __ATOMIC_RELAXED, __HIP_MEMORY_SCOPE_WORKGROUP); }
    __syncthreads();
    const int t_lo = c.bid * TOK_PER_BLK, t_hi = min(nrows, t_lo + TOK_PER_BLK);
    for (int idx = c.tid; idx < (t_hi - t_lo) * 8; idx += 512) { const int t = t_lo + (idx >> 3), k = idx & 7; const int e = tki[(size_t)t * 8 + k];
        const int p = __hip_atomic_fetch_add(&base[e], 1, __ATOMIC_RELAXED, __HIP_MEMORY_SCOPE_WORKGROUP);
        ltok[p] = t; lgate[p] = tkw[(size_t)t * 8 + k]; pos[(size_t)t * 8 + k] = p; }
    for (int t = t_lo + c.tid; t < t_hi; t += 512) { const int ps = tstart[64] * 256 + t; ltok[ps] = t; lgate[ps] = 1.f; }
    for (int e = c.bid; e < NE1; e += c.G) {
        const int n = e < 64 ? (int)__hip_atomic_load(cnt + e, __ATOMIC_RELAXED, __HIP_MEMORY_SCOPE_AGENT) : nrows; const int np = ((n + 255) >> 8) << 8;
        for (int j = n + c.tid; j < np; j += 512) { ltok[tstart[e] * 256 + j] = 0; lgate[tstart[e] * 256 + j] = 0.f; }
    }
}
__device__ __forceinline__ void ph_moe_reduce(const Ctx& c, int l, int q, int nrows) {
    LAS int* tstart = (LAS int*)(c.lds + LDS_MISC - 1024);
    moe_tstart(c, l, nrows, tstart);
    const int sbase = tstart[64] * 256;
    const unsigned char* ws = c.ws(); const int* pos = c.wsp<int>(WS_POS);
    const float* mods = c.wsp<float>(WS_MODS) + (size_t)l * 9 * 6144;
    typedef float f32x2v __attribute__((ext_vector_type(2)));
    float* xlat_ = c.out(); float* xctx_ = c.wsp<float>(WS_XC); const float* fnw_ = c.in(I_FNW);
    int pn_[8];
    if (c.gw < nrows) {
#pragma unroll
        for (int k = 0; k < 8; ++k) pn_[k] = pos[(size_t)c.gw * 8 + k]; }
    for (int m = c.gw; m < nrows; m += c.NGW) {
        const int j = m < TL ? m / SEQ : 8;
        float* xs = m < TL ? xlat_ + (size_t)m * DM : xctx_ + (size_t)(m - TL) * DM;
        const u32x4 xa = *(const u32x4*)((const bf16_t*)xs + 16 * c.lane), xb = *(const u32x4*)((const bf16_t*)xs + 16 * c.lane + 8);
        int pc_[8];
#pragma unroll
        for (int k = 0; k < 8; ++k) pc_[k] = pn_[k];
        if (m + c.NGW < nrows) {
#pragma unroll
            for (int k = 0; k < 8; ++k) pn_[k] = pos[(size_t)(m + c.NGW) * 8 + k]; }
        u32x4 w[9];
#pragma unroll
        for (int k = 0; k < 9; ++k) { const int p = k < 8 ? pc_[k] : sbase + m;
            const unsigned char* pr = p < PAIR_RA ? ws + WS_PAIRA + (size_t)p * 1024 : ws + WS_PAIRB + (size_t)(p - PAIR_RA) * 1024;
            w[k] = __builtin_nontemporal_load((const u32x4*)(pr + 16 * c.lane)); }
        float sacc[16];
#pragma unroll
        for (int e = 0; e < 16; ++e) sacc[e] = 0.f;
#pragma unroll
        for (int k = 0; k < 9; ++k)
#pragma unroll
            for (int d = 0; d < 4; ++d) { const int wd = (int)w[k][d]; const f32x2v lo = __builtin_amdgcn_cvt_pk_f32_fp8(wd, false), hi = __builtin_amdgcn_cvt_pk_f32_fp8(wd, true);
                sacc[4 * d] += lo[0]; sacc[4 * d + 1] += lo[1]; sacc[4 * d + 2] += hi[0]; sacc[4 * d + 3] += hi[1]; }
        const float* gp = mods + j * 6144 + 5 * 1024 + 16 * c.lane;
        f32x4 y[4]; float ss = 0.f;
#pragma unroll
        for (int d = 0; d < 4; ++d) { const f32x4 g = *(const f32x4*)(gp + 4 * d) * (1.f / PAIR_SCALE); const f32x4 sv = {sacc[4 * d], sacc[4 * d + 1], sacc[4 * d + 2], sacc[4 * d + 3]};
            const f32x4 xv = d == 0 ? bf4_to_f32(xa.x, xa.y) : d == 1 ? bf4_to_f32(xa.z, xa.w) : d == 2 ? bf4_to_f32(xb.x, xb.y) : bf4_to_f32(xb.z, xb.w);
            y[d] = xv + g * sv; ss += (y[d][0] * y[d][0] + y[d][1] * y[d][1]) + (y[d][2] * y[d][2] + y[d][3] * y[d][3]); }
        if (l == 1) { const float rstd = rsqrtf(wave_sum(ss) * (1.f / DM) + EPS); const float* fw = fnw_ + 16 * c.lane;
#pragma unroll
            for (int d = 0; d < 4; ++d) y[d] = y[d] * rstd * *(const f32x4*)(fw + 4 * d); }
        if (l == 1) {
#pragma unroll
            for (int d = 0; d < 4; ++d) *(f32x4*)(xs + 16 * c.lane + 4 * d) = y[d]; }
        else { u32x4 oa, ob; oa.x = pk2(y[0][0], y[0][1]); oa.y = pk2(y[0][2], y[0][3]); oa.z = pk2(y[1][0], y[1][1]); oa.w = pk2(y[1][2], y[1][3]);
            ob.x = pk2(y[2][0], y[2][1]); ob.y = pk2(y[2][2], y[2][3]); ob.z = pk2(y[3][0], y[3][1]); ob.w = pk2(y[3][2], y[3][3]);
            *(u32x4*)((bf16_t*)xs + 16 * c.lane) = oa; *(u32x4*)((bf16_t*)xs + 16 * c.lane + 8) = ob; }
    }
}
__device__ __forceinline__ void ph_final(const Ctx& c) {
    const float* fw = c.in(I_FNW);
    for (int m = c.gw; m < TL; m += c.NGW) {
        float* xr = c.out() + (size_t)m * DM; f32x4 v[4]; float ss = 0.f;
#pragma unroll
        for (int j = 0; j < 4; ++j) { v[j] = ((const f32x4*)xr)[c.lane + 64 * j]; ss += (v[j][0] * v[j][0] + v[j][1] * v[j][1]) + (v[j][2] * v[j][2] + v[j][3] * v[j][3]); }
        const float rstd = rsqrtf(wave_sum(ss) * (1.f / DM) + EPS);
#pragma unroll
        for (int j = 0; j < 4; ++j) { const f32x4 w = *(const f32x4*)(fw + 4 * c.lane + 256 * j); ((f32x4*)xr)[c.lane + 64 * j] = v[j] * rstd * w; }
    }
}

enum { PH_PRE = 0, PH_B, PH_INP, PH_D, PH_D2, PH_E2, PH_E3, PH_OUTP, PH_N2, PH_N2B, PH_TOPK, PH_LISTS, PH_UP, PH_DOWN, PH_RED, PH_FINAL, PH_COUNT };

__device__ __forceinline__ void ph_ba(const Ctx& c) {
    const bf16_t* A = c.wsp<bf16_t>(WS_HB); const bf16_t* W = c.wsp<bf16_t>(WS_WIN) + (size_t)(NINP - 256) * 1024; float* BA = c.wsp<float>(WS_BA);
    int tid = c.tid; asm volatile("" : "+v"(tid));
    const int lane = tid & 63, fr = lane & 15, g = lane >> 4;
    constexpr int WLD = 1024 + 8;
    LAS bf16_t* Ws = (LAS bf16_t*)c.lds;
    __syncthreads();
#pragma unroll
    for (int q = 0; q < 4; ++q) { const int idx = tid + 512 * q, n = idx >> 7, k8 = (idx & 127) * 8; *(LAS u32x4*)(Ws + n * WLD + k8) = *(const u32x4*)(W + (size_t)n * 1024 + k8); }
    __syncthreads();
    const LAS bf16_t* wp = Ws + fr * WLD + 8 * g;
#pragma unroll 1
    for (int t = c.wave * c.G + c.bid; t < MT / 16; t += c.NGW) {
        const bf16_t* ap = A + (size_t)(t * 16 + fr) * 1024 + 8 * g;
        bf16x8 a[32];
#pragma unroll
        for (int kk = 0; kk < 32; ++kk) a[kk] = *(const bf16x8*)(ap + 32 * kk);
        f32x4 acc = ozero4();
#pragma unroll
        for (int kk = 0; kk < 32; ++kk) { const bf16x8 b = *(const LAS bf16x8*)(wp + 32 * kk); acc = __builtin_amdgcn_mfma_f32_16x16x32_bf16(a[kk], b, acc, 0, 0, 0); }
#pragma unroll
        for (int r = 0; r < 4; ++r) BA[(size_t)(t * 16 + 4 * g + r) * 16 + fr] = acc[r];
    }
    __syncthreads();
}
template <int PH> __device__ __forceinline__ void run_phase(const Ctx& c, int l, int q) {
    const int nrows_out = (l == 0) ? MT : TL;
    if constexpr (PH == PH_PRE) { ph_pre(c); __syncthreads(); ph_s5_prep(c); }
    if constexpr (PH == PH_B) {
        LAS int* rowctr = (LAS int*)(c.lds + 8 * 16640);
        if (c.tid == 0) rowctr[0] = 0;
        __syncthreads();
        { Ctx cw = c; cw.gw = c.wave * c.G + c.bid; ph_wprep<0>(cw, l); }
        const float* mods = c.wsp<float>(WS_MODS) + (size_t)l * 9 * 6144; bf16_t* hb = c.wsp<bf16_t>(WS_HB);
        const float* xlat = xrow_ptr(c, l, 0); const float* xctx = xrow_ptr(c, l, TL); const float* n1w = c.in(I_N1W) + l * DM;
#pragma unroll 1
        for (;;) { int k = 0; if (c.lane == 0) k = __hip_atomic_fetch_add(rowctr, 2, __ATOMIC_RELAXED, __HIP_MEMORY_SCOPE_WORKGROUP);
            k = __builtin_amdgcn_readfirstlane(k); if (k >= MT / 256) break;
            const int m = c.bid + 256 * k, m2 = c.bid + 256 * (k + 1);
            f32x4 va[4], vb[4]; norm_row_load(m < TL ? xlat + (size_t)m * DM : xctx + (size_t)(m - TL) * DM, va, c.lane, l != 0); norm_row_load(m2 < TL ? xlat + (size_t)m2 * DM : xctx + (size_t)(m2 - TL) * DM, vb, c.lane, l != 0);
            { const int j = m < TL ? m / SEQ : 8; norm_row_finish<false>(va, n1w, mods + j * 6144 + 1 * 1024, mods + j * 6144 + 0 * 1024, hb + (size_t)m * DM, nullptr, c.lane); }
            { const int j = m2 < TL ? m2 / SEQ : 8; norm_row_finish<false>(vb, n1w, mods + j * 6144 + 1 * 1024, mods + j * 6144 + 0 * 1024, hb + (size_t)m2 * DM, nullptr, c.lane); } }
    }
    if constexpr (PH == PH_INP) {
        pg8::DenseSched<1024> S; S.init(c.wsp<void>(WS_HB), c.wsp<void>(WS_WIN), MT, NINP - 256, c.G, c.bid);
        EpiInProj E{c.ws(), c.wsp<f32x2>(WS_ROPE)};
        pg8::gemm_phase<1024>(c.lds, S, E);
        ph_ba(c);
    }
    if constexpr (PH == PH_D) {
        { GroupSched<512> S; S.A = c.wsp<char>(WS_S5A); S.a_gs = (size_t)S5R * 768 * 2; S.lda = 768; S.Bt = c.wsp<char>(ws_s5f(l)); S.b_gs = (size_t)256 * 512 * 2; S.nM = 5; S.nN = 1; S.nwg = 80; S.G = c.G; S.c = (c.bid + 128) & 255;
          EpiS5L E{c.wsp<float>(WS_S5L)}; pg8::gemm_phase<512>(c.lds, S, E); }
        __syncthreads();
        { int n_ = (DUP_SUB > 0 && DUP_SUB < 100) ? 2 : 1; asm volatile("" : "+s"(n_));
#pragma unroll 1
          for (int r_ = 0; r_ < n_; ++r_) { ph_gdn_g1(c, l, r_ == n_ - 1 ? 9 : DUP_SUB); __syncthreads(); } }
    }
    if constexpr (PH == PH_D2) { ph_gdn_g2(c, l); ph_s5_scan(c, l); __syncthreads(); ph_attn_fast(c, l, q); __syncthreads(); ph_wprep13_dyn(c, l, q);
        if (DUP_SUB == 101) { __syncthreads(); ph_attn_fast(c, l, q + 1); }
        if (DUP_SUB == 102) { __syncthreads(); ph_gdn_g2(c, l); }
        if (DUP_SUB == 103) { __syncthreads(); ph_s5_scan(c, l); } }
    if constexpr (PH == PH_E2) {
        ph_gdn_finish(c, l, nrows_out);
        { GroupSched<768> S; S.A = c.wsp<char>(WS_S5A); S.a_gs = (size_t)S5R * 768 * 2; S.lda = 768; S.Bt = c.wsp<char>(ws_s5m(l)); S.b_gs = (size_t)512 * 768 * 2; S.nM = 5; S.nN = 2; S.nwg = 160; S.G = c.G; S.c = c.bid;
          EpiS5Y E{c.wsp<bf16_t>(WS_ZS)}; pg8::gemm_phase<768>(c.lds, S, E); }
    }
    if constexpr (PH == PH_E3) {
        pg8::DenseSched<256> S; S.init(c.wsp<void>(WS_ZS), c.wsp<void>(ws_s5g(l)), nrows_out, 256, c.G, c.bid);
        EpiGlu E{c.wsp<bf16_t>(WS_ZS), c.wsp<bf16_t>(WS_HB), c.in(I_S5BGLU) + l * 256};
        pg8::gemm_phase<256>(c.lds, S, E);
    }
    if constexpr (PH == PH_OUTP) {
        pg8::DenseSched<1024> S; S.init(c.wsp<void>(WS_HB), c.wsp<void>(WS_WOUT), nrows_out, 1024, c.G, c.bid);
        EpiResid E{l == 0 ? c.in(I_X) : c.out(), l == 0 ? c.in(I_CTX) : c.wsp<float>(WS_XC), c.out(), c.wsp<float>(WS_XC), c.wsp<float>(WS_MODS) + (size_t)l * 9 * 6144, 2, l != 0};
        pg8::gemm_phase<1024>(c.lds, S, E);
        if (l == 0) ph_wprep2_dyn(c, l, q);
    }
    if constexpr (PH == PH_N2) { ph_wr2(c, l); __syncthreads(); ph_norm2(c, l, nrows_out); }
    if constexpr (PH == PH_N2B) {
        GroupSched<1024> S; S.A = c.wsp<char>(WS_HB); S.a_gs = (size_t)(WS_LO - WS_HB); S.lda = 1024; S.Bt = c.wsp<char>(WS_WR2); S.b_gs = (size_t)256 * 1024 * 2; S.nM = nrows_out / 256; S.nN = 1; S.nwg = nrows_out / 256; S.G = c.G; S.c = c.bid;
        EpiLogits E{c.wsp<float>(WS_LOG)}; pg8::gemm_phase<1024>(c.lds, S, E);
    }
    if constexpr (PH == PH_TOPK) { ph_topk(c, l, nrows_out); }
    if constexpr (PH == PH_LISTS) { ph_lists(c, l, nrows_out); }
    if constexpr (PH == PH_UP) {
        LAS int* tstart = (LAS int*)(c.lds + LDS_MISC - 1024);
        const int ntiles = moe_tstart(c, l, nrows_out, tstart);
        pg8::MoeSched<1024, true, true> S; S.A = c.wsp<char>(WS_HB); S.Bt = c.wsp<char>(WS_W13); S.ltok = c.wsp<int>(WS_LTOK); S.tstart = tstart; S.ntiles = ntiles; S.nN = 2; S.nwg = ntiles * 2; S.G = c.G; S.c = c.bid;
        S.bstride_e = (size_t)512 * 1024 * 2; S.bcol0 = 0;
        EpiMoeUp E{c.wsp<bf16_t>(WS_HID), c.wsp<float>(WS_LGATE)};
        pg8::gemm_phase<1024>(c.lds, S, E);
        if (l == 1) ph_wprep2_dyn(c, l, q);
    }
    if constexpr (PH == PH_DOWN) {
        LAS int* tstart = (LAS int*)(c.lds + LDS_MISC - 1024);
        const int ntiles = moe_tstart(c, l, nrows_out, tstart);
        pg8::MoeSched<256, false, true> S; S.A = c.wsp<char>(WS_HID); S.Bt = c.wsp<char>(WS_W2); S.ltok = nullptr; S.tstart = tstart; S.ntiles = ntiles; S.nN = 4; S.nwg = ntiles * 4; S.G = c.G; S.c = c.bid;
        S.bstride_e = (size_t)1024 * 256 * 2; S.bcol0 = 0;
        EpiMoeDown E{c.ws()};
        pg8::gemm_phase<256>(c.lds, S, E);
    }
    if constexpr (PH == PH_RED) { ph_moe_reduce(c, l, q, nrows_out); }
    if constexpr (PH == PH_FINAL) { ph_final(c); }
}

constexpr int LDS_PARAMS = LDS_MISC - 512;
__device__ __forceinline__ void stash_params(unsigned char* lds) {
    const __attribute__((address_space(4))) unsigned* ka = (const __attribute__((address_space(4))) unsigned*)__builtin_amdgcn_kernarg_segment_ptr();
    if (threadIdx.x < sizeof(Params) / 4) ((LAS unsigned*)((LAS unsigned char*)lds + LDS_PARAMS))[threadIdx.x] = ka[threadIdx.x];
    __syncthreads();
}
__device__ __forceinline__ Ctx make_ctx(unsigned char* lds) {
    Ctx c; c.pl = (const LAS unsigned*)((LAS unsigned char*)lds + LDS_PARAMS); c.lds = (LAS unsigned char*)lds; { int t_ = threadIdx.x; asm volatile("" : "+v"(t_)); c.tid = t_; } c.lane = c.tid & 63; c.wave = __builtin_amdgcn_readfirstlane(c.tid >> 6);
    c.G = gridDim.x; c.bid = blockIdx.x; c.gw = c.bid * 8 + c.wave; c.NGW = c.G * 8; return c;
}

template <int PH> __global__ void __launch_bounds__(512, 2) k_phase(Params p, int l, int q) {
    extern __shared__ __attribute__((aligned(16))) unsigned char lds[];
    stash_params(lds);
    const Ctx c = make_ctx(lds);
    run_phase<PH>(c, l, q);
}

#if ONE_LAUNCH
__global__ void __launch_bounds__(512, 2) k_mega(Params p) {
    extern __shared__ __attribute__((aligned(16))) unsigned char lds[];
    volatile LAS unsigned* misc = (volatile LAS unsigned*)((LAS unsigned char*)lds + LDS_MISC);
    if (threadIdx.x < 4) misc[threadIdx.x] = 0u;
    stash_params(lds);
    XcdBarrier bar = xcd_barrier_post((unsigned*)(p.ws + WS_CTL) + CW_BAR, misc);
#define GB() xcd_barrier(bar)
#ifndef REP_MASK
#define REP_MASK 0
#endif
#define RUN(PH, l, q) do { int n_ = ((REP_MASK >> PH) & 1) ? 2 : 1; asm volatile("" : "+s"(n_)); _Pragma("unroll 1") for (int r_ = 0; r_ < n_; ++r_) { if (r_) GB(); const Ctx c_ = make_ctx(lds); run_phase<PH>(c_, l, (q) + (n_ - 1 - r_)); } \
    if ((DUP_MASK >> PH) & 1) { GB(); const Ctx c2_ = make_ctx(lds); run_phase<PH>(c2_, l, (q) + 1); } } while (0)
    RUN(PH_PRE, 0, 0); GB();
#pragma unroll 1
    for (int l = 0; l < 2; ++l) {
        RUN(PH_B, l, 0); GB();
        RUN(PH_INP, l, 0); GB();
        RUN(PH_D, l, 0); GB();
        RUN(PH_D2, l, 0); GB();
        RUN(PH_E2, l, 0); GB();
        RUN(PH_E3, l, 0); GB();
        RUN(PH_OUTP, l, 0); GB();
        RUN(PH_N2, l, 0); GB();
        RUN(PH_N2B, l, 0); GB();
        RUN(PH_TOPK, l, 0); GB();
        RUN(PH_LISTS, l, 0); GB();
        RUN(PH_UP, l, 0); GB();
#pragma unroll 1
        RUN(PH_DOWN, l, 0); GB(); RUN(PH_RED, l, 0); if (l == 0) GB();
    }
#undef GB
#undef RUN
}
#endif


template <int PH> static void launch_phase(const Params& p, int l, int q, int grid, hipStream_t stream) {
    static bool attr = false;
    if (!attr) { (void)hipFuncSetAttribute((const void*)k_phase<PH>, hipFuncAttributeMaxDynamicSharedMemorySize, LDS_BYTES); attr = true; }
    hipLaunchKernelGGL(k_phase<PH>, dim3(grid), dim3(512), LDS_BYTES, stream, p, l, q);
}

extern "C" void kernel_launch(void* const* d_in, const int* in_sizes, int n_in, void* d_out, int out_size, void* d_ws, size_t ws_size, hipStream_t stream) {
    static int grid = 0;
    if (grid == 0) {
        if (n_in != 35 || out_size != TL * DM || ws_size < WS_END || (size_t)WS_END > ws_size) { fprintf(stderr, "kernel_launch: unexpected shapes n_in %d out %d ws %zu (need %zu)\n", n_in, out_size, ws_size, (size_t)WS_END); grid = -1; return; }
        int dev = 0, cus = 0;
        if (hipGetDevice(&dev) != hipSuccess || hipDeviceGetAttribute(&cus, hipDeviceAttributeMultiprocessorCount, dev) != hipSuccess) { grid = -1; return; }
#if ONE_LAUNCH
        (void)hipFuncSetAttribute((const void*)k_mega, hipFuncAttributeMaxDynamicSharedMemorySize, LDS_BYTES);
#endif
        grid = cus;
        if (grid != 256) { fprintf(stderr, "kernel_launch: built for a 256-CU device (got %d)\n", cus); grid = -1; return; }
    }
    if (grid < 0) return;
    (void)hipMemsetAsync((char*)d_ws + WS_CTL, 0, CTL_BYTES, stream);
    Params p{};
    for (int i = 0; i < 35; ++i) p.in[i] = (const float*)d_in[i];
    p.out = (float*)d_out; p.ws = (unsigned char*)d_ws;
#if ONE_LAUNCH
    hipLaunchKernelGGL(k_mega, dim3(grid), dim3(512), LDS_BYTES, stream, p);
#else
    launch_phase<PH_PRE>(p, 0, 0, grid, stream);
    for (int l = 0; l < 2; ++l) {
        launch_phase<PH_B>(p, l, 0, grid, stream);
        launch_phase<PH_INP>(p, l, 0, grid, stream);
        launch_phase<PH_D>(p, l, 0, grid, stream);
        launch_phase<PH_D2>(p, l, 0, grid, stream);
        launch_phase<PH_E2>(p, l, 0, grid, stream);
        launch_phase<PH_E3>(p, l, 0, grid, stream);
        launch_phase<PH_OUTP>(p, l, 0, grid, stream);
        launch_phase<PH_N2>(p, l, 0, grid, stream);
        launch_phase<PH_N2B>(p, l, 0, grid, stream);
        launch_phase<PH_TOPK>(p, l, 0, grid, stream);
        launch_phase<PH_LISTS>(p, l, 0, grid, stream);
        launch_phase<PH_UP>(p, l, 0, grid, stream);
        launch_phase<PH_DOWN>(p, l, 0, grid, stream); launch_phase<PH_RED>(p, l, 0, grid, stream);
    }
#endif
}
```
